# Optimizing an MI355X kernel written in HIP

```python
import math
import jax, jax.numpy as jnp
from jax import lax
import numpy as np

D_MODEL = 1024
BATCH = 2
SEQ = 8192
DEPTH = 2

HEAD_DIM = 64
GRID_W = 64
RMS_EPS = 1e-6
NEG = -1e30
A_PATTERNS = ((128, 1), (512, 4), (2048, 16))
A_GROUPS = 3
A_HEADS = 4
A_W = A_GROUPS * A_HEADS * HEAD_DIM
A_OUT = A_HEADS * HEAD_DIM
B_HEADS = 8
B_W = B_HEADS * HEAD_DIM
B_WIN_ROWS = 8
B_WIN_COLS = 16
B_QCOLS = 16
B_KCOLS = 32
C_Q_HEADS = 8
C_KV_HEADS = 2
C_QW = C_Q_HEADS * HEAD_DIM
C_KVW = C_KV_HEADS * HEAD_DIM
C_QBLOCK = 128
ROPE_THETA = 10000.0
ROPE_AXIS_DIM = HEAD_DIM // 2
T5_BUCKETS = 32
T5_MAX_DIST = 1024
N_BRANCH = 3
GATE_W = N_BRANCH * D_MODEL
IN_SIZES = (A_W, A_W, A_W, B_W, B_W, B_W, C_QW, C_KVW, C_KVW, GATE_W)
IN_W = sum(IN_SIZES)
D_FF = math.ceil(8 * D_MODEL / 3 / 256) * 256

kernel_name = "hybrid_dilated_natten_gqa_gated_encoder"


def rms_norm(x, g):
    xf = x.astype(jnp.float32)
    y = xf * lax.rsqrt(jnp.mean(xf * xf, axis=-1, keepdims=True) + RMS_EPS)
    return (y * g.astype(jnp.float32)).astype(x.dtype)


def t5_bucket(rel):
    half = T5_BUCKETS // 2
    max_exact = half // 2
    ret = jnp.where(rel > 0, half, 0)
    n = jnp.abs(rel)
    nf = jnp.maximum(n, 1).astype(jnp.float32)
    large = max_exact + (jnp.log(nf / max_exact) / math.log(T5_MAX_DIST / max_exact)
                         * (half - max_exact)).astype(jnp.int32)
    large = jnp.minimum(large, half - 1)
    return ret + jnp.where(n < max_exact, n, large)


def t5_dilated_bias(table_g, window, rate):
    R = window // (2 * rate)
    i = jnp.arange(R)[:, None]
    j = jnp.arange(3 * R)[None, :]
    rel = (j - R - i) * rate
    return jnp.transpose(table_g[t5_bucket(rel)], (2, 0, 1)).astype(jnp.float32)


def dilated_window_attn(q, k, v, bias, window, rate):
    B, S, H, hd = q.shape
    R = window // (2 * rate)
    L = S // rate
    nb = -(-L // R)
    Lp = nb * R

    def to_sub(t):
        t = t.reshape(B, L, rate, H, hd).transpose(0, 2, 1, 3, 4)
        return jnp.pad(t, ((0, 0), (0, 0), (0, Lp - L), (0, 0), (0, 0)))

    def key_blocks(t):
        tp = jnp.pad(to_sub(t), ((0, 0), (0, 0), (R, R), (0, 0), (0, 0)))
        tp = tp.reshape(B, rate, nb + 2, R, H, hd)
        return jnp.concatenate([tp[:, :, :-2], tp[:, :, 1:-1], tp[:, :, 2:]], axis=3)

    qs = to_sub(q).reshape(B, rate, nb, R, H, hd)
    kb, vb = key_blocks(k), key_blocks(v)
    s = jnp.einsum('brnqhd,brnkhd->brnhqk', qs, kb,
                   preferred_element_type=jnp.float32) * (hd ** -0.5) + bias
    i = jnp.arange(R)[:, None]
    j = jnp.arange(3 * R)[None, :]
    in_win = jnp.abs(j - R - i) <= R
    kpos = jnp.arange(nb)[:, None] * R + jnp.arange(3 * R)[None, :] - R
    valid = (kpos >= 0) & (kpos < L)
    mask = in_win[None, :, :] & valid[:, None, :]
    s = jnp.where(mask[:, None], s, NEG)
    m = jnp.max(s, axis=-1, keepdims=True)
    e = jnp.exp(s - m)
    den = jnp.sum(e, axis=-1, keepdims=True)
    p = (e / den).astype(v.dtype)
    lse = (m + jnp.log(den))[..., 0]
    o = jnp.einsum('brnhqk,brnkhd->brnqhd', p, vb)
    o = o.reshape(B, rate, Lp, H, hd)[:, :, :L].transpose(0, 2, 1, 3, 4).reshape(B, S, H, hd)
    lse = lse.transpose(0, 1, 2, 4, 3).reshape(B, rate, Lp, H)[:, :, :L]
    lse = lse.transpose(0, 2, 1, 3).reshape(B, S, H)
    return o, lse


def neighbourhood_attn(q, k, v, rpb):
    B, S, H, hd = q.shape
    rows = S // GRID_W
    kh = min(B_WIN_ROWS, rows)
    qg = q.reshape(B, rows, GRID_W, H, hd)
    kg = k.reshape(B, rows, GRID_W, H, hd)
    vg = v.reshape(B, rows, GRID_W, H, hd)
    n_cb = GRID_W // B_QCOLS
    mb = jnp.arange(n_cb)
    cs = jnp.clip(mb * B_QCOLS - B_WIN_COLS // 2, 0, GRID_W - B_KCOLS)
    kcol = cs[:, None] + jnp.arange(B_KCOLS)[None, :]
    qcol = mb[:, None] * B_QCOLS + jnp.arange(B_QCOLS)[None, :]
    c0 = jnp.clip(qcol - B_WIN_COLS // 2, 0, GRID_W - B_WIN_COLS)
    col_ok = (kcol[:, None, :] >= c0[..., None]) & (kcol[:, None, :] < c0[..., None] + B_WIN_COLS)
    dc_idx = jnp.clip(kcol[:, None, :] - qcol[..., None] + B_WIN_COLS - 1, 0, 2 * B_WIN_COLS - 2)
    scale = hd ** -0.5

    def one_row(i):
        rs = jnp.clip(i - kh // 2, 0, rows - kh)
        kr = lax.dynamic_slice_in_dim(kg, rs, kh, axis=1)[:, :, kcol]
        vr = lax.dynamic_slice_in_dim(vg, rs, kh, axis=1)[:, :, kcol]
        qr = lax.dynamic_index_in_dim(qg, i, axis=1, keepdims=False).reshape(B, n_cb, B_QCOLS, H, hd)
        s = jnp.einsum('bmqhd,bamchd->bhmqac', qr, kr, preferred_element_type=jnp.float32) * scale
        dr_idx = rs + jnp.arange(kh) - i + B_WIN_ROWS - 1
        bias = rpb[:, dr_idx[None, None, :, None], dc_idx[:, :, None, :]]
        s = jnp.where(col_ok[:, :, None, :], s + bias.astype(jnp.float32), NEG)
        p = jax.nn.softmax(s.reshape(B, H, n_cb, B_QCOLS, kh * B_KCOLS), axis=-1)
        p = p.reshape(B, H, n_cb, B_QCOLS, kh, B_KCOLS).astype(v.dtype)
        o = jnp.einsum('bhmqac,bamchd->bmqhd', p, vr)
        return o.reshape(B, GRID_W, H, hd)

    o = lax.map(one_row, jnp.arange(rows))
    return o.transpose(1, 0, 2, 3, 4).reshape(B, S, H, hd)


def axial_rope_tables(S):
    t = jnp.arange(S)
    inv = ROPE_THETA ** (-jnp.arange(0, ROPE_AXIS_DIM, 2, dtype=jnp.float32) / ROPE_AXIS_DIM)
    ang_r = (t // GRID_W).astype(jnp.float32)[:, None] * inv[None, :]
    ang_c = (t % GRID_W).astype(jnp.float32)[:, None] * inv[None, :]
    return jnp.cos(ang_r), jnp.sin(ang_r), jnp.cos(ang_c), jnp.sin(ang_c)


def rotate(x, cos, sin):
    x1, x2 = jnp.split(x, 2, axis=-1)
    c = cos[None, :, None, :]
    s = sin[None, :, None, :]
    return jnp.concatenate([x1 * c - x2 * s, x1 * s + x2 * c], axis=-1)


def apply_axial_rope(x, tabs):
    cos_r, sin_r, cos_c, sin_c = tabs
    xf = x.astype(jnp.float32)
    out = jnp.concatenate([rotate(xf[..., :ROPE_AXIS_DIM], cos_r, sin_r),
                           rotate(xf[..., ROPE_AXIS_DIM:], cos_c, sin_c)], axis=-1)
    return out.astype(x.dtype)


def gqa_blocked(q, k, v):
    B, S, Hq, hd = q.shape
    Hkv = k.shape[2]
    G = Hq // Hkv
    nqb = S // C_QBLOCK
    qb = q.reshape(B, nqb, C_QBLOCK, Hkv, G, hd).transpose(1, 0, 2, 3, 4, 5)
    scale = hd ** -0.5

    def blk(qi):
        s = jnp.einsum('bqkgd,bskd->bkgqs', qi, k, preferred_element_type=jnp.float32) * scale
        p = jax.nn.softmax(s, axis=-1).astype(v.dtype)
        return jnp.einsum('bkgqs,bskd->bqkgd', p, v)

    o = lax.map(blk, qb)
    return o.transpose(1, 0, 2, 3, 4, 5).reshape(B, S, Hq, hd)


def hybrid_layer(x, t5_biases, rope_tabs, g1, w_in, qk_g, rpb, p_a, p_b, p_c, w_o, g2, w_up, w_down):
    B, S, D = x.shape
    h = rms_norm(x, g1)
    z = h @ w_in
    cuts = np.cumsum(IN_SIZES)[:-1].tolist()
    qa, ka, va, qb, kb, vb, qc, kc, vc, zg = jnp.split(z, cuts, axis=-1)
    qa = rms_norm(qa.reshape(B, S, A_GROUPS, A_HEADS, HEAD_DIM), qk_g[0])
    ka = rms_norm(ka.reshape(B, S, A_GROUPS, A_HEADS, HEAD_DIM), qk_g[1])
    va = va.reshape(B, S, A_GROUPS, A_HEADS, HEAD_DIM)
    outs, lses = [], []
    for g, (win, rate) in enumerate(A_PATTERNS):
        o_g, l_g = dilated_window_attn(qa[:, :, g], ka[:, :, g], va[:, :, g], t5_biases[g], win, rate)
        outs.append(o_g)
        lses.append(l_g)
    wts = jax.nn.softmax(jnp.stack(lses, axis=2), axis=2)
    o_a = jnp.sum(wts[..., None].astype(x.dtype) * jnp.stack(outs, axis=2), axis=2).reshape(B, S, A_OUT)
    qb = rms_norm(qb.reshape(B, S, B_HEADS, HEAD_DIM), qk_g[2])
    kb = rms_norm(kb.reshape(B, S, B_HEADS, HEAD_DIM), qk_g[3])
    o_b = neighbourhood_attn(qb, kb, vb.reshape(B, S, B_HEADS, HEAD_DIM), rpb).reshape(B, S, B_W)
    qc = apply_axial_rope(rms_norm(qc.reshape(B, S, C_Q_HEADS, HEAD_DIM), qk_g[4]), rope_tabs)
    kc = apply_axial_rope(rms_norm(kc.reshape(B, S, C_KV_HEADS, HEAD_DIM), qk_g[5]), rope_tabs)
    o_c = gqa_blocked(qc, kc, vc.reshape(B, S, C_KV_HEADS, HEAD_DIM)).reshape(B, S, C_QW)
    gates = jax.nn.sigmoid(zg.reshape(B, S, N_BRANCH, D))
    merged = gates[:, :, 0] * (o_a @ p_a) + gates[:, :, 1] * (o_b @ p_b) + gates[:, :, 2] * (o_c @ p_c)
    x = x + merged @ w_o
    u = rms_norm(x, g2) @ w_up
    a, b = jnp.split(u, 2, axis=-1)
    return x + (jax.nn.silu(a) * b) @ w_down


def setup_inputs(seed: int = 0) -> dict:
    key = jax.random.key(seed)
    ks = jax.random.split(key, 14)
    f32 = jnp.float32
    nrm = lambda k, shape, s: jax.random.normal(k, shape, f32) * s
    return {
        "x": nrm(ks[0], (BATCH, SEQ, D_MODEL), 1.0),
        "rel_bias_table": nrm(ks[1], (T5_BUCKETS, A_GROUPS * A_HEADS), 0.3),
        "norm1": 1.0 + nrm(ks[2], (DEPTH, D_MODEL), 0.05),
        "w_in": nrm(ks[3], (DEPTH, D_MODEL, IN_W), D_MODEL ** -0.5),
        "qk_gain": 1.0 + nrm(ks[4], (DEPTH, 6, HEAD_DIM), 0.05),
        "nat_rpb": nrm(ks[5], (DEPTH, B_HEADS, 2 * B_WIN_ROWS - 1, 2 * B_WIN_COLS - 1), 0.3),
        "w_br_a": nrm(ks[6], (DEPTH, A_OUT, D_MODEL), A_OUT ** -0.5),
        "w_br_b": nrm(ks[7], (DEPTH, B_W, D_MODEL), B_W ** -0.5),
        "w_br_c": nrm(ks[8], (DEPTH, C_QW, D_MODEL), C_QW ** -0.5),
        "w_o": nrm(ks[9], (DEPTH, D_MODEL, D_MODEL), D_MODEL ** -0.5),
        "norm2": 1.0 + nrm(ks[10], (DEPTH, D_MODEL), 0.05),
        "w_up": nrm(ks[11], (DEPTH, D_MODEL, 2 * D_FF), D_MODEL ** -0.5),
        "w_down": nrm(ks[12], (DEPTH, D_FF, D_MODEL), D_FF ** -0.5),
    }


def reference(x, rel_bias_table, norm1, w_in, qk_gain, nat_rpb, w_br_a, w_br_b, w_br_c, w_o,
              norm2, w_up, w_down):
    S = x.shape[1]
    t5_biases = [t5_dilated_bias(rel_bias_table[:, g * A_HEADS:(g + 1) * A_HEADS], win, rate)
                 for g, (win, rate) in enumerate(A_PATTERNS)]
    rope_tabs = axial_rope_tables(S)
    for l in range(DEPTH):
        x = hybrid_layer(x, t5_biases, rope_tabs, norm1[l], w_in[l], qk_gain[l], nat_rpb[l],
                         w_br_a[l], w_br_b[l], w_br_c[l], w_o[l], norm2[l], w_up[l], w_down[l])
    return x
```

```cpp
#include <hip/hip_runtime.h>
#include <hip/hip_bf16.h>
#include <cstdio>
#include <cstdint>

#define LAS __attribute__((address_space(3)))
#define GAS __attribute__((address_space(1)))
typedef unsigned short bf16_t;
typedef short bf16x8 __attribute__((ext_vector_type(8)));
typedef short s16x4 __attribute__((ext_vector_type(4)));
typedef float f32x4 __attribute__((ext_vector_type(4)));
typedef float f32x2 __attribute__((ext_vector_type(2)));
typedef float f32x16 __attribute__((ext_vector_type(16)));
typedef unsigned u32x4 __attribute__((ext_vector_type(4)));
typedef unsigned u32x2 __attribute__((ext_vector_type(2)));

constexpr int BATCH = 2, SEQ = 8192, MTOK = BATCH * SEQ, DM = 1024, DEPTH = 2;
constexpr int ZP = 4608;
constexpr int ZQA = 0, ZKA = 768, ZVA = 1536, ZQB = 2304, ZKB = 2816, ZVB = 3328, ZQC = 3840, ZKC = 4352, ZVC = 4480;
constexpr int ZGATE = 768;
constexpr int INW = 7680, NQKV = 4608, NGATE = 3072;
constexpr int OP = 1280;
constexpr int DFF = 2816;
constexpr float RMS_EPS = 1e-6f;
constexpr float LOG2E = 1.4426950408889634f;
constexpr float C2 = 0.125f * LOG2E;
constexpr float NEGBIG = -1e30f;

constexpr size_t MiB = 1u << 20;
constexpr size_t WS_CTL = 0, CTL_ZERO_BYTES = 64 * 1024;
constexpr size_t WS_SSQ = 1 * MiB;
constexpr size_t WS_WIN = 2 * MiB;
constexpr size_t WS_PCAT = 17 * MiB;
constexpr size_t WS_WO = WS_PCAT + 1024 * 1280 * 2;
constexpr size_t WS_WUP = WS_WO + 2 * MiB;
constexpr size_t WS_WDN = WS_WUP + 11 * MiB;
constexpr size_t WS_XB0 = 38 * MiB;
constexpr size_t WS_BIG = 70 * MiB;
constexpr size_t WS_OBUF = 214 * MiB;
constexpr size_t WS_LSE = 254 * MiB;
constexpr size_t WS_END = 256 * MiB;
static_assert(WS_WDN + (size_t)1024 * 2816 * 2 <= WS_XB0, "weights fit");
constexpr int CW_BAR = 4096;

constexpr int RING_BYTES = 131072;
constexpr int LDSCTL_OFF = RING_BYTES, MISC_OFF = LDSCTL_OFF + 320;
constexpr int STG_OFF = 132096, STG_ROW = 144, STG_WAVE = 16 * STG_ROW;
constexpr int RSTAB_OFF = STG_OFF + 8 * STG_WAVE;
constexpr int LDS_BYTES = 151552;
static_assert(MISC_OFF + 128 <= STG_OFF && RSTAB_OFF + 1024 <= LDS_BYTES, "LDS map");

typedef __bf16 bf16x2_t __attribute__((ext_vector_type(2)));
__device__ __forceinline__ unsigned cvt_pk_bf16(float lo, float hi) { f32x2 v = {lo, hi}; bf16x2_t b = __builtin_convertvector(v, bf16x2_t); return __builtin_bit_cast(unsigned, b); }
__device__ __forceinline__ float bf_lo(unsigned u) { return __uint_as_float(u << 16); }
__device__ __forceinline__ float bf_hi(unsigned u) { return __uint_as_float(u & 0xffff0000u); }
__device__ __forceinline__ float fast_exp2(float x) { return __builtin_amdgcn_exp2f(x); }
__device__ __forceinline__ float fast_rcp(float x) { return __builtin_amdgcn_rcpf(x); }
__device__ __forceinline__ float sigmoidf_(float x) { return fast_rcp(1.0f + fast_exp2(-x * LOG2E)); }

struct RsFill { f32x4 a, b, c, d; };
__device__ __forceinline__ void rs_fill_issue(RsFill& f, const float* ssq, int row0, int nrows, int tid) {
    if (tid < nrows) { const f32x4* p = (const f32x4*)(ssq + (size_t)(row0 + tid) * 16); f.a = p[0]; f.b = p[1]; f.c = p[2]; f.d = p[3]; }
}
__device__ __forceinline__ void rs_fill_finish(const RsFill& f, LAS float* tab, int nrows, int tid) {
    if (tid < nrows) { const float sm = ((f.a.x + f.a.y) + (f.a.z + f.a.w)) + ((f.b.x + f.b.y) + (f.b.z + f.b.w)) + ((f.c.x + f.c.y) + (f.c.z + f.c.w)) + ((f.d.x + f.d.y) + (f.d.z + f.d.w));
        tab[tid] = __builtin_amdgcn_rsqf(sm * (1.0f / 1024.0f) + RMS_EPS); }
}
__device__ __forceinline__ void fill_rs_table(LAS float* tab, const float* ssq, int row0, int nrows, int tid) { RsFill f; rs_fill_issue(f, ssq, row0, nrows, tid); rs_fill_finish(f, tab, nrows, tid); }
namespace pg8 {
constexpr int BM = 256, BK = 64, HALF = 128, HTB = HALF * BK * 2, STAGE_BYTES = 8 * HTB, NXCD = 8, WGM = 8;
__host__ __device__ __forceinline__ int lds_byte(int r, int c) { const int st = (r >> 4) * 2 + (c >> 5), rr = r & 15, cc = c & 31, ob = rr * 64 + cc * 2; return st * 1024 + (ob ^ (((ob >> 9) & 1) << 5)); }
__host__ __device__ __forceinline__ void stage_rc(int b, int& R, int& C) { const int st = b / 1024, sb = b % 1024, swz = sb ^ (((sb >> 9) & 1) << 5); R = (st >> 1) * 16 + swz / 64; C = (st & 1) * 32 + (swz % 64) / 2; }

struct Unit { int pm, pn, seg, rowoff, nai; };
template <int NSEG> struct Order {
    int nM, nN, nwg, G, c, ntk, maxr;
    const char* A; const char* Bt; size_t tstepA, tstepB;
    __device__ __forceinline__ void tile_of(int L, Unit& u) const {
        int wgid = L; { const int q = nwg / NXCD, r = nwg % NXCD, xcd = wgid % NXCD, off = wgid / NXCD; wgid = (xcd < r ? xcd * (q + 1) : r * (q + 1) + (xcd - r) * q) + off; }
        const int nig = WGM * nN, gid = wgid / nig, fm = gid * WGM, gsz = (nM - fm) < WGM ? (nM - fm) : WGM;
        u.pm = fm + ((wgid % nig) % gsz); u.pn = (wgid % nig) / gsz; u.rowoff = 0; u.nai = 2;
    }
    __device__ __forceinline__ bool next(int i, Unit& u) const {
        const int ti = i / NSEG; u.seg = i - ti * NSEG;
        if (ti >= maxr) return false;
        const long L = (long)ti * G + c; if (L >= nwg) return false;
        tile_of((int)L, u); return true;
    }
    static __device__ __forceinline__ int koff(int seg) { return NSEG == 1 ? 0 : (seg == 0 ? 0 : (seg == 1 ? 512 : 1536)); }
    __device__ __forceinline__ const char* aptr(const Unit& u) const { return A + (size_t)u.pm * tstepA + koff(u.seg); }
    __device__ __forceinline__ const char* bptr(const Unit& u) const { return Bt + (size_t)u.pn * tstepB + koff(u.seg); }
    __device__ __forceinline__ int nt(const Unit& u) const { return NSEG == 1 ? ntk : (u.seg == 0 ? 4 : 8); }
};
template <int NSEG> __device__ __forceinline__ Order<NSEG> make_order(const bf16_t* A, int lda, const bf16_t* Bt, int ldb, int M, int N, int K, int G, int c) {
    Order<NSEG> o; o.nM = M / BM; o.nN = N / BM; o.nwg = o.nM * o.nN; o.G = G; o.c = c; o.ntk = K / BK; o.maxr = 1 << 20;
    o.A = (const char*)A; o.Bt = (const char*)Bt; o.tstepA = (size_t)BM * lda * 2; o.tstepB = (size_t)BM * ldb * 2; return o;
}

struct NoPre { __device__ __forceinline__ void operator()() const {} };
template <class Epi, class Ord, class Pre = NoPre>
__device__ __forceinline__ void gemm_phase(LAS unsigned char* lds, const Ord S, const int lda, const int ldb, const Epi E, const char* tailA = nullptr, const char* tailB = nullptr, const Pre pre = Pre()) {
    int tid = threadIdx.x; asm volatile("" : "+v"(tid));
    const int wid = __builtin_amdgcn_readfirstlane(tid >> 6), lane = tid & 63, wr = wid >> 2, wc = wid & 3, fr = lane & 15, fq = lane >> 4;
    unsigned voffA[2], voffB[2];
#pragma unroll
    for (int i = 0; i < 2; ++i) { int R, C; stage_rc(tid * 16 + i * 8192, R, C); voffA[i] = (unsigned)(R * lda + C) * 2u; voffB[i] = (unsigned)(R * ldb + C) * 2u; }
    const size_t kstep = (size_t)(BK * 2);
    const size_t hstepA = (size_t)HALF * lda * 2, hstepB = (size_t)HALF * ldb * 2;
    const unsigned ldsw = (unsigned)wid * 1024u;
    const int aoff = lds_byte(wr * 64 + fr, fq * 8), boff = lds_byte(wc * 32 + fr, fq * 8);
#define PG8_SA(b, h) (((b) * 2 + (h)) * HTB)
#define PG8_SB(b, h) ((4 + (b) * 2 + (h)) * HTB)
#define PG8_STAGE(bufoff, gbase, voff) do { _Pragma("unroll") for (int _i = 0; _i < 2; ++_i) \
        __builtin_amdgcn_global_load_lds((const unsigned*)((const char*)(gbase) + (voff)[_i]), (LAS unsigned*)(lds + (bufoff) + ldsw + _i * 8192), 16, 0, 0); } while (0)
#define PG8_LDA(dst, b, h) do { _Pragma("unroll") for (int m = 0; m < 4; ++m) _Pragma("unroll") for (int k = 0; k < 2; ++k) dst[m][k] = *(const LAS bf16x8*)(lds + PG8_SA(b, h) + aoff + m * 2048 + k * 1024); } while (0)
#define PG8_LDB(dst, b, h) do { _Pragma("unroll") for (int n = 0; n < 2; ++n) _Pragma("unroll") for (int k = 0; k < 2; ++k) dst[n][k] = *(const LAS bf16x8*)(lds + PG8_SB(b, h) + boff + n * 2048 + k * 1024); } while (0)
#define PG8_MMA(ai, bj, At, Bt) do { __builtin_amdgcn_s_setprio(1); _Pragma("unroll") for (int m = 0; m < 4; ++m) _Pragma("unroll") for (int n = 0; n < 2; ++n) _Pragma("unroll") for (int k = 0; k < 2; ++k) \
        acc[ai][bj][m][n] = __builtin_amdgcn_mfma_f32_16x16x32_bf16(Bt[n][k], At[m][k], acc[ai][bj][m][n], 0, 0, 0); __builtin_amdgcn_s_setprio(0); } while (0)
#define PG8_WAIT_V(n) asm volatile("s_waitcnt vmcnt(" #n ")" ::: "memory")
#define PG8_WAIT_L(n) asm volatile("s_waitcnt lgkmcnt(" #n ")" ::: "memory")
#define PG8_BAR __builtin_amdgcn_s_barrier()
#define PG8_SCHED __builtin_amdgcn_sched_barrier(0)
    Unit cur, nxt; int ui = 0;
    if (!S.next(0, cur)) return;
    f32x4 acc[2][2][4][2];
#pragma unroll
    for (int a = 0; a < 2; ++a)
#pragma unroll
        for (int b = 0; b < 2; ++b)
#pragma unroll
            for (int m = 0; m < 4; ++m)
#pragma unroll
                for (int n = 0; n < 2; ++n) acc[a][b][m][n] = (f32x4){0.f, 0.f, 0.f, 0.f};
    bf16x8 At[4][2], B0[2][2], B1[2][2];
    const char* cA = S.aptr(cur); const char* cB = S.bptr(cur); int nt = S.nt(cur);
    RsFill rsf; if constexpr (Epi::NEEDS_RS) rs_fill_issue(rsf, E.ssq, cur.pm * 256, 256, tid);
    PG8_STAGE(PG8_SB(0, 0), cB, voffB); PG8_STAGE(PG8_SB(0, 1), cB + hstepB, voffB); PG8_STAGE(PG8_SA(0, 0), cA, voffA); PG8_STAGE(PG8_SA(0, 1), cA + hstepA, voffA);
    if constexpr (Epi::NEEDS_RS) rs_fill_finish(rsf, (LAS float*)(lds + RSTAB_OFF), 256, tid);
    pre();
    if (wr == 1) PG8_BAR;
    PG8_WAIT_V(2); PG8_BAR;
    PG8_STAGE(PG8_SB(1, 0), cB + kstep, voffB); PG8_STAGE(PG8_SA(1, 0), cA + kstep, voffA); PG8_STAGE(PG8_SB(1, 1), cB + hstepB + kstep, voffB);
    PG8_WAIT_V(6); PG8_BAR;
    for (;;) {
        const bool has_next = S.next(ui + 1, nxt);
        const char* nA = has_next ? S.aptr(nxt) : (tailA ? tailA : cA); const char* nB = has_next ? S.bptr(nxt) : (tailB ? tailB : cB);
        for (int t = 0; t < nt; t += 2) {
            const bool last = (t == nt - 2);
            unsigned tk = (unsigned)t * (unsigned)kstep; asm volatile("" : "+s"(tk));
            asm volatile("" : "+v"(voffA[0]), "+v"(voffA[1]), "+v"(voffB[0]), "+v"(voffB[1]));
            const char* a1 = cA + tk + kstep;
            const char* a2 = last ? nA : cA + tk + 2 * kstep; const char* b2 = last ? nB : cB + tk + 2 * kstep;
            const char* a3 = a2 + kstep; const char* b3 = b2 + kstep;
            PG8_LDB(B0, 0, 0); PG8_LDB(B1, 0, 1); PG8_SCHED; PG8_LDA(At, 0, 0); PG8_STAGE(PG8_SA(1, 1), a1 + hstepA, voffA);
            PG8_WAIT_V(8); PG8_WAIT_L(0); PG8_BAR; PG8_MMA(0, 0, At, B0); PG8_MMA(0, 1, At, B1); PG8_BAR; PG8_SCHED;
            PG8_LDA(At, 0, 1); PG8_STAGE(PG8_SB(0, 0), b2, voffB); PG8_STAGE(PG8_SB(0, 1), b2 + hstepB, voffB); PG8_STAGE(PG8_SA(0, 0), a2, voffA);
            PG8_WAIT_V(8); PG8_WAIT_L(0); PG8_BAR; PG8_MMA(1, 0, At, B0); PG8_MMA(1, 1, At, B1); PG8_BAR; PG8_SCHED;
            PG8_LDB(B0, 1, 0); PG8_LDB(B1, 1, 1); PG8_SCHED; PG8_LDA(At, 1, 0); PG8_STAGE(PG8_SA(0, 1), a2 + hstepA, voffA);
            PG8_WAIT_V(8); PG8_WAIT_L(0); PG8_BAR; PG8_MMA(0, 0, At, B0); PG8_MMA(0, 1, At, B1); PG8_BAR; PG8_SCHED;
            PG8_LDA(At, 1, 1); PG8_STAGE(PG8_SB(1, 0), b3, voffB); PG8_STAGE(PG8_SB(1, 1), b3 + hstepB, voffB); PG8_STAGE(PG8_SA(1, 0), a3, voffA);
            PG8_WAIT_V(8); PG8_WAIT_L(0); PG8_BAR; PG8_MMA(1, 0, At, B0); PG8_MMA(1, 1, At, B1); PG8_BAR; PG8_SCHED;
        }
        if (wr == 0) PG8_BAR;
        int fr_ = fr, fq_ = fq; asm volatile("" : "+v"(fr_), "+v"(fq_));
#if defined(EPI_REP)
        if (Epi::IDEMP == EPI_REP) { (void)E(acc, cur, wr, wc, fr_, fq_, lds + STG_OFF + wid * STG_WAVE); }
#endif
        const bool zero = E(acc, cur, wr, wc, fr_, fq_, lds + STG_OFF + wid * STG_WAVE);
        if (!has_next) break;
        if (zero) {
#pragma unroll
        for (int a = 0; a < 2; ++a)
#pragma unroll
            for (int b = 0; b < 2; ++b)
#pragma unroll
                for (int m = 0; m < 4; ++m)
#pragma unroll
                    for (int n = 0; n < 2; ++n) acc[a][b][m][n] = (f32x4){0.f, 0.f, 0.f, 0.f};
        }
        if constexpr (Epi::NEEDS_RS) { if (nxt.pm != cur.pm) {
            asm volatile("s_waitcnt lgkmcnt(0)" ::: "memory"); PG8_BAR; fill_rs_table((LAS float*)(lds + RSTAB_OFF), E.ssq, nxt.pm * 256, 256, tid); asm volatile("s_waitcnt lgkmcnt(0)" ::: "memory"); PG8_BAR; } }
        cur = nxt; cA = nA; cB = nB; nt = S.nt(cur); ++ui;
        if (wr == 1) PG8_BAR;
    }
    PG8_WAIT_V(0);
    PG8_BAR;
#undef PG8_SA
#undef PG8_SB
#undef PG8_STAGE
#undef PG8_LDA
#undef PG8_LDB
#undef PG8_MMA
#undef PG8_WAIT_V
#undef PG8_WAIT_L
#undef PG8_BAR
#undef PG8_SCHED
}

template <class Epi, class Ord>
__device__ __forceinline__ void gemm_half_phase(LAS unsigned char* lds, const Ord S, const int L, const int half, const int lda, const int ldb, const Epi E, const bool prestaged = false) {
    int tid = threadIdx.x; asm volatile("" : "+v"(tid));
    const int wid = __builtin_amdgcn_readfirstlane(tid >> 6), lane = tid & 63, wr = wid >> 2, wc = wid & 3, fr = lane & 15, fq = lane >> 4;
    unsigned voffA[2], voffB[2];
#pragma unroll
    for (int i = 0; i < 2; ++i) { int R, C; stage_rc(tid * 16 + i * 8192, R, C); voffA[i] = (unsigned)(R * lda + C) * 2u; voffB[i] = (unsigned)(R * ldb + C) * 2u; }
    const size_t kstep = (size_t)(BK * 2);
    const size_t hstepA = (size_t)HALF * lda * 2, hstepB = (size_t)HALF * ldb * 2;
    const unsigned ldsw = (unsigned)wid * 1024u;
    const int aoff = lds_byte(wr * 64 + fr, fq * 8), boff = lds_byte(wc * 32 + fr, fq * 8);
#define PG8_SA(b, h) (((b) * 2 + (h)) * HTB)
#define PG8_SB(b, h) ((4 + (b) * 2 + (h)) * HTB)
#define PG8_STAGE(bufoff, gbase, voff) do { _Pragma("unroll") for (int _i = 0; _i < 2; ++_i) \
        __builtin_amdgcn_global_load_lds((const unsigned*)((const char*)(gbase) + (voff)[_i]), (LAS unsigned*)(lds + (bufoff) + ldsw + _i * 8192), 16, 0, 0); } while (0)
#define PG8_LDA(dst, b, h) do { _Pragma("unroll") for (int m = 0; m < 4; ++m) _Pragma("unroll") for (int k = 0; k < 2; ++k) dst[m][k] = *(const LAS bf16x8*)(lds + PG8_SA(b, h) + aoff + m * 2048 + k * 1024); } while (0)
#define PG8_LDB(dst, b, h) do { _Pragma("unroll") for (int n = 0; n < 2; ++n) _Pragma("unroll") for (int k = 0; k < 2; ++k) dst[n][k] = *(const LAS bf16x8*)(lds + PG8_SB(b, h) + boff + n * 2048 + k * 1024); } while (0)
#define PG8_MMA(ai, bj, At, Bt) do { __builtin_amdgcn_s_setprio(1); _Pragma("unroll") for (int m = 0; m < 4; ++m) _Pragma("unroll") for (int n = 0; n < 2; ++n) _Pragma("unroll") for (int k = 0; k < 2; ++k) \
        acc[ai][bj][m][n] = __builtin_amdgcn_mfma_f32_16x16x32_bf16(Bt[n][k], At[m][k], acc[ai][bj][m][n], 0, 0, 0); __builtin_amdgcn_s_setprio(0); } while (0)
#define PG8_WAIT_V(n) asm volatile("s_waitcnt vmcnt(" #n ")" ::: "memory")
#define PG8_WAIT_L(n) asm volatile("s_waitcnt lgkmcnt(" #n ")" ::: "memory")
#define PG8_BAR __builtin_amdgcn_s_barrier()
#define PG8_SCHED __builtin_amdgcn_sched_barrier(0)
    Unit u; S.tile_of(L, u); u.seg = 0; u.rowoff = 128 * half; u.nai = 1;
    f32x4 acc[2][2][4][2];
#pragma unroll
    for (int a = 0; a < 2; ++a)
#pragma unroll
        for (int b = 0; b < 2; ++b)
#pragma unroll
            for (int m = 0; m < 4; ++m)
#pragma unroll
                for (int n = 0; n < 2; ++n) acc[a][b][m][n] = (f32x4){0.f, 0.f, 0.f, 0.f};
    bf16x8 At[4][2], B0[2][2], B1[2][2], Au[4][2], C0[2][2], C1[2][2];
    const char* cA = S.A + (size_t)u.pm * S.tstepA + (size_t)half * hstepA; const char* cB = S.Bt + (size_t)u.pn * S.tstepB; const int nt = S.ntk;
    RsFill rsf; if constexpr (Epi::NEEDS_RS) rs_fill_issue(rsf, E.ssq, u.pm * 256 + 128 * half, 128, tid);
    if (!prestaged) {
        PG8_STAGE(PG8_SB(0, 0), cB, voffB); PG8_STAGE(PG8_SB(0, 1), cB + hstepB, voffB); PG8_STAGE(PG8_SA(0, 0), cA, voffA);
        PG8_STAGE(PG8_SB(1, 0), cB + kstep, voffB); PG8_STAGE(PG8_SB(1, 1), cB + hstepB + kstep, voffB); PG8_STAGE(PG8_SA(1, 0), cA + kstep, voffA);
        PG8_WAIT_V(6); PG8_BAR; }
    PG8_LDB(B0, 0, 0); PG8_LDB(B1, 0, 1); PG8_LDA(At, 0, 0); PG8_WAIT_L(0);
    for (int t = 0; t < nt; t += 2) {
        unsigned tk = (unsigned)t * (unsigned)kstep; asm volatile("" : "+s"(tk));
        asm volatile("" : "+v"(voffA[0]), "+v"(voffA[1]), "+v"(voffB[0]), "+v"(voffB[1]));
        const bool more = (t + 2 < nt);
        PG8_WAIT_V(0); PG8_BAR; PG8_SCHED;
        if (more) { PG8_STAGE(PG8_SB(0, 0), cB + tk + 2 * kstep, voffB); PG8_STAGE(PG8_SB(0, 1), cB + hstepB + tk + 2 * kstep, voffB); PG8_STAGE(PG8_SA(0, 0), cA + tk + 2 * kstep, voffA); }
        PG8_LDB(C0, 1, 0); PG8_LDB(C1, 1, 1); PG8_LDA(Au, 1, 0); PG8_SCHED;
        PG8_MMA(0, 0, At, B0); PG8_MMA(0, 1, At, B1);
        PG8_WAIT_L(0);
        if (more) { PG8_WAIT_V(0); PG8_BAR; PG8_SCHED;
            PG8_STAGE(PG8_SB(1, 0), cB + tk + 3 * kstep, voffB); PG8_STAGE(PG8_SB(1, 1), cB + hstepB + tk + 3 * kstep, voffB); PG8_STAGE(PG8_SA(1, 0), cA + tk + 3 * kstep, voffA);
            PG8_LDB(B0, 0, 0); PG8_LDB(B1, 0, 1); PG8_LDA(At, 0, 0); PG8_SCHED; }
        PG8_MMA(0, 0, Au, C0); PG8_MMA(0, 1, Au, C1);
        PG8_WAIT_L(0);
    }
    if constexpr (Epi::NEEDS_RS) { rs_fill_finish(rsf, (LAS float*)(lds + RSTAB_OFF), 128, tid); PG8_WAIT_L(0); PG8_BAR; }
    int fr_ = fr, fq_ = fq; asm volatile("" : "+v"(fr_), "+v"(fq_));
    (void)E(acc, u, wr, wc, fr_, fq_, lds + STG_OFF + wid * STG_WAVE);
    PG8_WAIT_V(0); PG8_BAR;
#undef PG8_SA
#undef PG8_SB
#undef PG8_STAGE
#undef PG8_LDA
#undef PG8_LDB
#undef PG8_MMA
#undef PG8_WAIT_V
#undef PG8_WAIT_L
#undef PG8_BAR
#undef PG8_SCHED
}
}

__device__ __forceinline__ float shx(float v, int o) {
    int l; asm volatile("v_mbcnt_lo_u32_b32 %0, -1, 0\n\tv_mbcnt_hi_u32_b32 %0, -1, %0" : "=v"(l));
    return __int_as_float(__builtin_amdgcn_ds_bpermute((l ^ o) << 2, __float_as_int(v)));
}

__device__ __forceinline__ float row_rs(const float* ssq, int row, int fq) {
    const f32x4 a = *(const f32x4*)(ssq + (size_t)row * 16 + 4 * fq);
    float s = (a.x + a.y) + (a.z + a.w);
    s += shx(s, 16); s += shx(s, 32);
    return __builtin_amdgcn_rsqf(s * (1.0f / 1024.0f) + RMS_EPS);
}
__device__ __forceinline__ float sum_fq4(float x) {
    { auto r = __builtin_amdgcn_permlane32_swap(__float_as_uint(x), __float_as_uint(x), false, false); x = __uint_as_float(r[0]) + __uint_as_float(r[1]); }
    { auto r = __builtin_amdgcn_permlane16_swap(__float_as_uint(x), __float_as_uint(x), false, false); x = __uint_as_float(r[0]) + __uint_as_float(r[1]); }
    return x;
}
#ifndef WT_STORES
#define WT_STORES 1
#endif
__device__ __forceinline__ void store16_wt(void* p, u32x4 v) {
#if WT_STORES
    asm volatile("global_store_dwordx4 %0, %1, off sc1\n\ts_nop 1" :: "v"(p), "v"(v) : "memory");
#else
    *(u32x4*)p = v;
#endif
}
typedef f32x4 acc_t[2][2][4][2];
__device__ __forceinline__ void rows_rs(float (&rs)[8], const float* ssq, int row0, int fq, int nai) {
    f32x4 t[8];
#pragma unroll
    for (int k = 0; k < 8; ++k) t[k] = ((k >> 2) < nai) ? *(const f32x4*)(ssq + (size_t)(row0 + (k >> 2) * 128 + (k & 3) * 16) * 16 + 4 * fq) : (f32x4){1.f, 1.f, 1.f, 1.f};
#pragma unroll
    for (int k = 0; k < 8; ++k) { float s = (t[k].x + t[k].y) + (t[k].z + t[k].w); s += shx(s, 16); s += shx(s, 32); rs[k] = __builtin_amdgcn_rsqf(s * (1.0f / 1024.0f) + RMS_EPS); }
}

struct EpiQKV {
    static constexpr int IDEMP = 1; static constexpr bool NEEDS_RS = true;
    bf16_t* Z; const float* ssq; const float* qkg;
    __device__ __forceinline__ bool operator()(acc_t& acc, const pg8::Unit& u, int wr, int wc, int fr, int fq, LAS unsigned char* stg) const {
        const int pn = u.pn;
        int kind = 0, gi = 0; bool scale = false;
        if (pn < 3) { kind = 1; gi = 0; scale = true; } else if (pn < 6) { kind = 1; gi = 1; } else if (pn < 9) { kind = 0; }
        else if (pn < 11) { kind = 1; gi = 2; scale = true; } else if (pn < 13) { kind = 1; gi = 3; } else if (pn < 15) { kind = 0; }
        else if (pn < 17) { kind = 2; gi = 4; scale = true; } else { if (wc < 2) { kind = 2; gi = 5; } else kind = 0; }
        f32x4 g[2][2];
#pragma unroll
        for (int bj = 0; bj < 2; ++bj)
#pragma unroll
            for (int n = 0; n < 2; ++n) g[bj][n] = kind ? *(const f32x4*)(qkg + gi * 64 + 32 * bj + 16 * n + 4 * fq) : (f32x4){1.f, 1.f, 1.f, 1.f};
        float inv[4];
#pragma unroll
        for (int e = 0; e < 4; ++e) inv[e] = fast_exp2(-(float)(4 * fq + e) * (13.287712379549449f / 16.0f)) * 0.15915494309189535f;
        const float sc = scale ? C2 : 1.0f;
        const LAS float* rstab = (const LAS float*)(stg - (wr * 4 + wc) * STG_WAVE + 8 * STG_WAVE) + wr * 64 + fr;
#pragma unroll
        for (int ai = 0; ai < 2; ++ai)
#pragma unroll
            for (int m = 0; m < 4; ++m) {
                if (ai >= u.nai) continue;
                const int row = u.pm * 256 + u.rowoff + ai * 128 + wr * 64 + m * 16 + fr;
                const float rs = rstab[ai * 128 + m * 16];
                f32x4 v[2][2];
#pragma unroll
                for (int bj = 0; bj < 2; ++bj)
#pragma unroll
                    for (int n = 0; n < 2; ++n) v[bj][n] = acc[ai][bj][m][n] * rs;
                if (kind) {
                    float ss = 0.f;
#pragma unroll
                    for (int bj = 0; bj < 2; ++bj)
#pragma unroll
                        for (int n = 0; n < 2; ++n) { const f32x4 x = v[bj][n]; ss += (x.x * x.x + x.y * x.y) + (x.z * x.z + x.w * x.w); }
                    ss = sum_fq4(ss);
                    const float r = __builtin_amdgcn_rsqf(ss * (1.0f / 64.0f) + RMS_EPS);
#pragma unroll
                    for (int bj = 0; bj < 2; ++bj)
#pragma unroll
                        for (int n = 0; n < 2; ++n) v[bj][n] = v[bj][n] * r * g[bj][n];
                }
                if (kind == 2) {
                    const int t = row & (SEQ - 1); const float pr = (float)(t >> 6), pc = (float)(t & 63);
#pragma unroll
                    for (int bj = 0; bj < 2; ++bj) { const float pos = bj ? pc : pr;
#pragma unroll
                        for (int e = 0; e < 4; ++e) { const float rev = pos * inv[e]; const float c = __builtin_amdgcn_cosf(rev), s = __builtin_amdgcn_sinf(rev);
                            const float x1 = v[bj][0][e], x2 = v[bj][1][e]; v[bj][0][e] = x1 * c - x2 * s; v[bj][1][e] = x1 * s + x2 * c; } }
                }
#pragma unroll
                for (int bj = 0; bj < 2; ++bj)
#pragma unroll
                    for (int n = 0; n < 2; ++n) { const f32x4 x = v[bj][n] * sc; u32x2 w; w.x = cvt_pk_bf16(x.x, x.y); w.y = cvt_pk_bf16(x.z, x.w); *(LAS u32x2*)(stg + fr * STG_ROW + 64 * bj + 32 * n + 8 * fq) = w; }
                { const int lane_ = fq * 16 + fr, r8 = lane_ >> 3, ch = lane_ & 7; const int rowg = row - fr;
                  const u32x4 w0 = *(const LAS u32x4*)(stg + r8 * STG_ROW + 16 * ch), w1 = *(const LAS u32x4*)(stg + (r8 + 8) * STG_ROW + 16 * ch);
                  bf16_t* gp = Z + (size_t)(rowg + r8) * ZP + 256 * pn + 64 * wc + 8 * ch;
                  store16_wt(gp, w0); store16_wt(gp + (size_t)8 * ZP, w1); }
                asm volatile("" ::: "memory");
            }
        return true;
    }
};
struct EpiGate {
    static constexpr int IDEMP = 2; static constexpr bool NEEDS_RS = true;
    bf16_t* G; const float* ssq;
    __device__ __forceinline__ bool operator()(acc_t& acc, const pg8::Unit& u, int wr, int wc, int fr, int fq, LAS unsigned char* stg) const {
        const LAS float* rstab = (const LAS float*)(stg - (wr * 4 + wc) * STG_WAVE + 8 * STG_WAVE) + wr * 64 + fr;
        const int lane_ = fq * 16 + fr, r8 = lane_ >> 3, ch = lane_ & 7;
#pragma unroll
        for (int ai = 0; ai < 2; ++ai)
#pragma unroll
            for (int m = 0; m < 4; ++m) {
                if (ai >= u.nai) continue;
                const int row = u.pm * 256 + u.rowoff + ai * 128 + wr * 64 + m * 16 + fr;
                const float rsn = rstab[ai * 128 + m * 16] * (-LOG2E);
#define GATE_E(v) (1.0f + fast_exp2(fminf((v) * rsn, 60.0f)))
#pragma unroll
                for (int bj = 0; bj < 2; ++bj) { const f32x4 a = acc[ai][bj][m][0], b = acc[ai][bj][m][1]; u32x4 w;
                    w.x = cvt_pk_bf16(GATE_E(a.x), GATE_E(a.y)); w.y = cvt_pk_bf16(GATE_E(a.z), GATE_E(a.w));
                    w.z = cvt_pk_bf16(GATE_E(b.x), GATE_E(b.y)); w.w = cvt_pk_bf16(GATE_E(b.z), GATE_E(b.w));
                    *(LAS u32x4*)(stg + fr * STG_ROW + 64 * bj + 16 * fq) = w; }
#undef GATE_E
                { const u32x4 w0 = *(const LAS u32x4*)(stg + r8 * STG_ROW + 16 * ch), w1 = *(const LAS u32x4*)(stg + (r8 + 8) * STG_ROW + 16 * ch);
                  bf16_t* gp = G + (size_t)(row - fr + r8) * ZP + 256 * u.pn + 64 * wc + 8 * ch;
                  store16_wt(gp, w0); store16_wt(gp + (size_t)8 * ZP, w1); }
                asm volatile("" ::: "memory");
            }
        return true;
    }
};
struct EpiBranch {
    static constexpr int IDEMP = 0; static constexpr bool NEEDS_RS = false;
    const bf16_t* G; bf16_t* Mg;
    __device__ __forceinline__ bool operator()(acc_t& acc, const pg8::Unit& u, int wr, int wc, int fr, int fq, LAS unsigned char* stg) const {
        const int seg = u.seg; const int rowb = u.pm * 256 + wr * 64; const int colw = 256 * u.pn + 64 * wc;
        const int lane_ = fq * 16 + fr, r8 = lane_ >> 3, ch = lane_ & 7;
        u32x4 gbuf[2][4];
#define EBR_ISSUE(k, pp) do { const bf16_t* gp_ = G + (size_t)(rowb + ((k) >> 2) * 128 + ((k) & 3) * 16 + r8) * ZP + seg * 1024 + colw + 8 * ch; \
            gbuf[pp][0] = __builtin_nontemporal_load((const u32x4*)gp_); gbuf[pp][1] = __builtin_nontemporal_load((const u32x4*)(gp_ + (size_t)8 * ZP)); \
            if (seg < 2) { gbuf[pp][2] = __builtin_nontemporal_load((const u32x4*)(gp_ + 1024)); gbuf[pp][3] = __builtin_nontemporal_load((const u32x4*)(gp_ + (size_t)8 * ZP + 1024)); } } while (0)
        EBR_ISSUE(0, 0);
#pragma unroll
        for (int k = 0; k < 8; ++k) {
            if (k + 1 < 8) EBR_ISSUE(k + 1, (k + 1) & 1);
            const int ai = k >> 2, m = k & 3; const int rowg = rowb + ai * 128 + m * 16;
            u32x4 gc[2], gn[2];
            *(LAS u32x4*)(stg + r8 * STG_ROW + 16 * ch) = gbuf[k & 1][0]; *(LAS u32x4*)(stg + (r8 + 8) * STG_ROW + 16 * ch) = gbuf[k & 1][1];
            gc[0] = *(const LAS u32x4*)(stg + fr * STG_ROW + 16 * fq); gc[1] = *(const LAS u32x4*)(stg + fr * STG_ROW + 64 + 16 * fq);
            if (seg < 2) {
                *(LAS u32x4*)(stg + r8 * STG_ROW + 16 * ch) = gbuf[k & 1][2]; *(LAS u32x4*)(stg + (r8 + 8) * STG_ROW + 16 * ch) = gbuf[k & 1][3];
                gn[0] = *(const LAS u32x4*)(stg + fr * STG_ROW + 16 * fq); gn[1] = *(const LAS u32x4*)(stg + fr * STG_ROW + 64 + 16 * fq); }
#pragma unroll
            for (int bj = 0; bj < 2; ++bj) {
                const u32x4 gw = gc[bj];
                float f0 = fast_rcp(bf_lo(gw.x)), f1 = fast_rcp(bf_hi(gw.x)), f2 = fast_rcp(bf_lo(gw.y)), f3 = fast_rcp(bf_hi(gw.y)), f4 = fast_rcp(bf_lo(gw.z)), f5 = fast_rcp(bf_hi(gw.z)), f6 = fast_rcp(bf_lo(gw.w)), f7 = fast_rcp(bf_hi(gw.w));
                if (seg < 2) { const u32x4 nw = gn[bj];
                    f0 *= bf_lo(nw.x); f1 *= bf_hi(nw.x); f2 *= bf_lo(nw.y); f3 *= bf_hi(nw.y);
                    f4 *= bf_lo(nw.z); f5 *= bf_hi(nw.z); f6 *= bf_lo(nw.w); f7 *= bf_hi(nw.w); }
                f32x4 a = acc[ai][bj][m][0], b = acc[ai][bj][m][1];
                a.x *= f0; a.y *= f1; a.z *= f2; a.w *= f3; b.x *= f4; b.y *= f5; b.z *= f6; b.w *= f7;
                if (seg < 2) { acc[ai][bj][m][0] = a; acc[ai][bj][m][1] = b; }
                else { u32x4 w; w.x = cvt_pk_bf16(a.x, a.y); w.y = cvt_pk_bf16(a.z, a.w); w.z = cvt_pk_bf16(b.x, b.y); w.w = cvt_pk_bf16(b.z, b.w);
                    *(LAS u32x4*)(stg + fr * STG_ROW + 64 * bj + 16 * fq) = w; } }
            if (seg == 2) { const u32x4 w0 = *(const LAS u32x4*)(stg + r8 * STG_ROW + 16 * ch), w1 = *(const LAS u32x4*)(stg + (r8 + 8) * STG_ROW + 16 * ch);
                bf16_t* mp = Mg + (size_t)(rowg + r8) * DM + colw + 8 * ch;
                store16_wt(mp, w0); store16_wt(mp + (size_t)8 * DM, w1); }
            asm volatile("" ::: "memory");
        }
#undef EBR_ISSUE
        return seg == 2;
    }
};
template <bool RES_F32, bool OUT_F32> struct EpiRes {
    static constexpr int IDEMP = 0; static constexpr bool NEEDS_RS = false;
    const void* xin; float* xout; bf16_t* xb; float* ssq;
    __device__ __forceinline__ bool operator()(acc_t& acc, const pg8::Unit& u, int wr, int wc, int fr, int fq, LAS unsigned char* stg) const {
        const int rowb = u.pm * 256 + wr * 64; const int colw = 256 * u.pn + 64 * wc;
        const int lane_ = fq * 16 + fr, r8 = lane_ >> 3, ch = lane_ & 7;
        f32x4 buf[2][4]; u32x4 bbuf[2][2];
        const float* xf = (const float*)xin; const bf16_t* xh = (const bf16_t*)xin;
#define ERES_ISSUE(k, pp) do { const size_t row_ = (size_t)(rowb + ((k) >> 2) * 128 + ((k) & 3) * 16 + r8); \
            if (RES_F32) { const size_t off_ = row_ * DM + colw + 4 * ch; buf[pp][0] = __builtin_nontemporal_load((const f32x4*)(xf + off_)); buf[pp][1] = __builtin_nontemporal_load((const f32x4*)(xf + off_ + (size_t)8 * DM)); \
                buf[pp][2] = __builtin_nontemporal_load((const f32x4*)(xf + off_ + 32)); buf[pp][3] = __builtin_nontemporal_load((const f32x4*)(xf + off_ + (size_t)8 * DM + 32)); } \
            else { const size_t off_ = row_ * DM + colw + 8 * ch; bbuf[pp][0] = __builtin_nontemporal_load((const u32x4*)(xh + off_)); bbuf[pp][1] = __builtin_nontemporal_load((const u32x4*)(xh + off_ + (size_t)8 * DM)); } } while (0)
        ERES_ISSUE(0, 0);
#pragma unroll
        for (int k = 0; k < 8; ++k) {
            if (k + 1 < 8) ERES_ISSUE(k + 1, (k + 1) & 1);
            const int ai = k >> 2, m = k & 3; const int rowg = rowb + ai * 128 + m * 16;
            float sq = 0.f; f32x4 x[4];
            if (!RES_F32) {
                *(LAS u32x4*)(stg + r8 * STG_ROW + 16 * ch) = bbuf[k & 1][0]; *(LAS u32x4*)(stg + (r8 + 8) * STG_ROW + 16 * ch) = bbuf[k & 1][1];
#pragma unroll
                for (int q = 0; q < 4; ++q) { const u32x2 rw = *(const LAS u32x2*)(stg + fr * STG_ROW + 64 * (q >> 1) + 32 * (q & 1) + 8 * fq);
                    x[q] = (f32x4){bf_lo(rw.x), bf_hi(rw.x), bf_lo(rw.y), bf_hi(rw.y)} + acc[ai][q >> 1][m][q & 1]; } }
#pragma unroll
            for (int bj = 0; bj < 2; ++bj) {
                if (RES_F32) {
                    *(LAS f32x4*)(stg + r8 * STG_ROW + 16 * ch) = buf[k & 1][2 * bj]; *(LAS f32x4*)(stg + (r8 + 8) * STG_ROW + 16 * ch) = buf[k & 1][2 * bj + 1];
                    const f32x4 r0 = *(const LAS f32x4*)(stg + fr * STG_ROW + 16 * fq), r1 = *(const LAS f32x4*)(stg + fr * STG_ROW + 64 + 16 * fq);
                    x[2 * bj] = r0 + acc[ai][bj][m][0]; x[2 * bj + 1] = r1 + acc[ai][bj][m][1]; }
                if (OUT_F32) {
                    *(LAS f32x4*)(stg + fr * STG_ROW + 16 * fq) = x[2 * bj]; *(LAS f32x4*)(stg + fr * STG_ROW + 64 + 16 * fq) = x[2 * bj + 1];
                    const f32x4 w0 = *(const LAS f32x4*)(stg + r8 * STG_ROW + 16 * ch), w1 = *(const LAS f32x4*)(stg + (r8 + 8) * STG_ROW + 16 * ch);
                    float* gp = xout + (size_t)(rowg + r8) * DM + colw + 32 * bj + 4 * ch;
                    __builtin_nontemporal_store(w0, (f32x4*)gp); __builtin_nontemporal_store(w1, (f32x4*)(gp + (size_t)8 * DM)); } }
            if (xb) {
#pragma unroll
                for (int q = 0; q < 4; ++q) sq += (x[q].x * x[q].x + x[q].y * x[q].y) + (x[q].z * x[q].z + x[q].w * x[q].w);
#pragma unroll
                for (int q = 0; q < 4; ++q) { u32x2 w; w.x = cvt_pk_bf16(x[q].x, x[q].y); w.y = cvt_pk_bf16(x[q].z, x[q].w); *(LAS u32x2*)(stg + fr * STG_ROW + 64 * (q >> 1) + 32 * (q & 1) + 8 * fq) = w; }
                const u32x4 w0 = *(const LAS u32x4*)(stg + r8 * STG_ROW + 16 * ch), w1 = *(const LAS u32x4*)(stg + (r8 + 8) * STG_ROW + 16 * ch);
                bf16_t* gp = xb + (size_t)(rowg + r8) * DM + colw + 8 * ch;
                store16_wt(gp, w0); store16_wt(gp + (size_t)8 * DM, w1);
                sq = sum_fq4(sq); if (fq == 0) ssq[(size_t)(rowg + fr) * 16 + u.pn * 4 + wc] = sq; }
            asm volatile("" ::: "memory");
        }
#undef ERES_ISSUE
        return true;
    }
};
struct EpiSwiglu {
    static constexpr int IDEMP = 3; static constexpr bool NEEDS_RS = true;
    bf16_t* H; const float* ssq;
    __device__ __forceinline__ bool operator()(acc_t& acc, const pg8::Unit& u, int wr, int wc, int fr, int fq, LAS unsigned char* stg) const {
        const LAS float* rstab = (const LAS float*)(stg - (wr * 4 + wc) * STG_WAVE + 8 * STG_WAVE) + wr * 64 + fr;
#pragma unroll
        for (int ai = 0; ai < 2; ++ai)
#pragma unroll
            for (int m = 0; m < 4; ++m) {
                if (ai >= u.nai) continue;
                const int row = u.pm * 256 + u.rowoff + ai * 128 + wr * 64 + m * 16 + fr;
                const float rs = rstab[ai * 128 + m * 16];
                float h[8];
#pragma unroll
                for (int n = 0; n < 2; ++n) { const f32x4 a = acc[ai][0][m][n] * rs, b = acc[ai][1][m][n] * rs;
#pragma unroll
                    for (int e = 0; e < 4; ++e) h[4 * n + e] = a[e] * sigmoidf_(a[e]) * b[e]; }
                u32x4 w; w.x = cvt_pk_bf16(h[0], h[1]); w.y = cvt_pk_bf16(h[2], h[3]); w.z = cvt_pk_bf16(h[4], h[5]); w.w = cvt_pk_bf16(h[6], h[7]);
                store16_wt(H + (size_t)row * DFF + 128 * u.pn + 32 * wc + 8 * fq, w);
                asm volatile("" ::: "memory");
            }
        return true;
    }
};

namespace att {
typedef LAS const char* lds_cptr;
__device__ __forceinline__ int crow(int r, int hi) { return (r & 3) + 8 * (r >> 2) + 4 * hi; }
constexpr int NSLOT = 5, SLOTB = 8192, LDS_K = 0, LDS_V = NSLOT * SLOTB, LDS_WS = 2 * NSLOT * SLOTB, LDS_OST = LDS_WS + 8 * 256, LDS_TAB = LDS_OST + 8 * 4096, LDS_END = LDS_TAB + 8192;
static_assert(LDS_END <= RING_BYTES, "attention LDS");
__device__ __forceinline__ void glds16(const void* gsrc, unsigned lds_dst) { unsigned keep;
    asm volatile("s_mov_b32 %0, m0\n\ts_mov_b32 m0, %2\n\ts_nop 0\n\tglobal_load_lds_dwordx4 %1, off\n\ts_mov_b32 m0, %0" : "=&s"(keep) : "v"(gsrc), "s"(lds_dst) : "memory"); }
#define ATT_WAIT_BAR(N) asm volatile("s_waitcnt vmcnt(" #N ") lgkmcnt(0)\n\ts_barrier" ::: "memory")
#define ATT_LBAR() asm volatile("s_waitcnt lgkmcnt(0)\n\ts_barrier" ::: "memory")
#define MFMA32(a, b, c) __builtin_amdgcn_mfma_f32_32x32x16_bf16(a, b, c, 0, 0, 0)
__device__ __forceinline__ void qkt(f32x16& p0, f32x16& p1, lds_cptr kb, const bf16x8* qr, const f32x16& c0, const f32x16& c1) {
#pragma unroll
    for (int d0 = 0; d0 < 4; ++d0) {
        const bf16x8 b0 = *(const LAS bf16x8*)(kb + d0 * 2048);
        const bf16x8 b1 = *(const LAS bf16x8*)(kb + d0 * 2048 + 512);
        if (d0 == 0) { p0 = MFMA32(b0, qr[0], c0); p1 = MFMA32(b1, qr[0], c1); }
        else { p0 = MFMA32(b0, qr[d0], p0); p1 = MFMA32(b1, qr[d0], p1); } }
}
__device__ __forceinline__ float rowmax(const f32x16& p0, const f32x16& p1) {
    float a = fmaxf(p0[0], p1[0]);
#pragma unroll
    for (int r = 1; r < 16; ++r) a = fmaxf(a, fmaxf(p0[r], p1[r]));
    auto rr = __builtin_amdgcn_permlane32_swap(__float_as_uint(a), __float_as_uint(a), false, false);
    return fmaxf(__uint_as_float(rr[0]), __uint_as_float(rr[1]));
}
template <unsigned KS> __device__ __forceinline__ void pv(f32x16* o, int vb, int vbB, bf16x8 pa0, bf16x8 pa1, bf16x8 pa2, bf16x8 pa3) {
#pragma unroll
    for (int d0 = 0; d0 < 2; ++d0) { s16x4 lo[4], hi[4];
#pragma unroll
        for (int ks = 0; ks < 4; ++ks) if ((KS >> ks) & 1u) {
            asm volatile("ds_read_b64_tr_b16 %0,%1 offset:%c2" : "=&v"(lo[ks]) : "v"(ks < 2 ? vb : vbB), "i"(d0 * 4096 + (ks & 1) * 1024) : "memory");
            asm volatile("ds_read_b64_tr_b16 %0,%1 offset:%c2" : "=&v"(hi[ks]) : "v"(ks < 2 ? vb : vbB), "i"(d0 * 4096 + (ks & 1) * 1024 + 512) : "memory"); }
        asm volatile("s_waitcnt lgkmcnt(0)" ::: "memory"); __builtin_amdgcn_sched_barrier(0);
#define PK(k) (bf16x8){lo[k][0], lo[k][1], lo[k][2], lo[k][3], hi[k][0], hi[k][1], hi[k][2], hi[k][3]}
        if (KS & 1u) o[d0] = MFMA32(pa0, PK(0), o[d0]);
        if (KS & 2u) o[d0] = MFMA32(pa1, PK(1), o[d0]);
        if (KS & 4u) o[d0] = MFMA32(pa2, PK(2), o[d0]);
        if (KS & 8u) o[d0] = MFMA32(pa3, PK(3), o[d0]);
#undef PK
    }
}
template <unsigned L0, unsigned L1, bool HASCM, class P> __device__ __forceinline__ void att_step(const P& p, int j, int wid, f32x16& cm0, f32x16& cm1, lds_cptr kb, lds_cptr kbB, int vb, int vbB, const bf16x8* qr,
                                                                             float& mhat, float& lrun, f32x16* o, LAS float* wsf, bool& first, int r32, int hi) {
    f32x16 p0, p1, c0, c1;
    p.template cinit<L0, L1>(c0, c1, cm0, cm1, mhat, j, wid, r32, hi);
#pragma unroll
    for (int d0 = 0; d0 < 4; ++d0) {
        if (L0) { const bf16x8 b0 = *(const LAS bf16x8*)(kb + d0 * 2048); p0 = MFMA32(b0, qr[d0], d0 == 0 ? c0 : p0); }
        if (L1) { const bf16x8 b1 = *(const LAS bf16x8*)(kbB + d0 * 2048); p1 = MFMA32(b1, qr[d0], d0 == 0 ? c1 : p1); }
        if (HASCM && d0 == 1) __builtin_amdgcn_sched_barrier(0); }
    float s4[4] = {0.f, 0.f, 0.f, 0.f};
#pragma unroll
    for (int r = 0; r < 16; ++r) { if ((L0 >> r) & 1u) { p0[r] = fast_exp2(p0[r]); s4[r & 3] += p0[r]; } else p0[r] = 0.f; if ((L1 >> r) & 1u) { p1[r] = fast_exp2(p1[r]); s4[r & 3] += p1[r]; } else p1[r] = 0.f; }
    lrun += (s4[0] + s4[1]) + (s4[2] + s4[3]);
    u32x4 pw0, pw1, pw2, pw3;
    pw0 = (u32x4){cvt_pk_bf16(p0[0], p0[1]), cvt_pk_bf16(p0[2], p0[3]), cvt_pk_bf16(p0[4], p0[5]), cvt_pk_bf16(p0[6], p0[7])};
    pw1 = (u32x4){cvt_pk_bf16(p0[8], p0[9]), cvt_pk_bf16(p0[10], p0[11]), cvt_pk_bf16(p0[12], p0[13]), cvt_pk_bf16(p0[14], p0[15])};
    pw2 = (u32x4){cvt_pk_bf16(p1[0], p1[1]), cvt_pk_bf16(p1[2], p1[3]), cvt_pk_bf16(p1[4], p1[5]), cvt_pk_bf16(p1[6], p1[7])};
    pw3 = (u32x4){cvt_pk_bf16(p1[8], p1[9]), cvt_pk_bf16(p1[10], p1[11]), cvt_pk_bf16(p1[12], p1[13]), cvt_pk_bf16(p1[14], p1[15])};
    constexpr unsigned KS = ((L0 & 0x00FFu) ? 1u : 0u) | ((L0 & 0xFF00u) ? 2u : 0u) | ((L1 & 0x00FFu) ? 4u : 0u) | ((L1 & 0xFF00u) ? 8u : 0u);
    pv<KS>(o, vb, vbB, __builtin_bit_cast(bf16x8, pw0), __builtin_bit_cast(bf16x8, pw1), __builtin_bit_cast(bf16x8, pw2), __builtin_bit_cast(bf16x8, pw3));
}
template <class P> __device__ __forceinline__ void unit_simple(const P& p, bool prestaged, const P& pn, bool has_next, const float Bref, LAS char* shm) {
    int tid = threadIdx.x; asm volatile("" : "+v"(tid));
    const int lane = tid & 63, r32 = lane & 31, hi = lane >> 5; const int wid = __builtin_amdgcn_readfirstlane(tid >> 6);
    const unsigned lds0 = (unsigned)(uintptr_t)shm;
    LAS float* wsf = (LAS float*)(shm + LDS_WS) + wid * 64;
    const unsigned kdst = lds0 + LDS_K + wid * 1024, vdst = lds0 + LDS_V + wid * 1024;
    const int vb0 = (int)(lds0 + LDS_V) + ((lane >> 4) & 1) * 32 + (lane & 3) * 8 + (4 * hi + ((lane & 15) >> 2)) * 64;
    const lds_cptr kp0 = (lds_cptr)shm + LDS_K + hi * 1024 + r32 * 16;
    const int NT = p.ntiles();
#define ATT_STAGE_P(pp, j, slot) do { const bf16_t* kp_ = (pp).kptr((j), lane) + wid * 8; const bf16_t* vp_ = (pp).vptr((j), 16 * (wid & 3) + (lane >> 2)) + (wid >> 2) * 32 + (lane & 3) * 8; \
        glds16(kp_, (unsigned)__builtin_amdgcn_readfirstlane(kdst + (slot) * SLOTB)); glds16(vp_, (unsigned)__builtin_amdgcn_readfirstlane(vdst + (slot) * SLOTB)); } while (0)
#define ATT_STAGE(j, slot) ATT_STAGE_P(p, j, slot)
    constexpr int NPRE = (P::KIND == 2) ? 5 : 4;
    bf16x8 qr[4];
    { const bf16_t* qrow = p.qrow(wid, r32);
#pragma unroll
      for (int d0 = 0; d0 < 4; ++d0) qr[d0] = *(const bf16x8*)(qrow + d0 * 16 + hi * 8); }
    asm volatile("" ::: "memory");
    if (!prestaged) {
#pragma unroll
        for (int j0 = 0; j0 < NPRE; ++j0) if (j0 < NT) ATT_STAGE(j0, j0); }
    float mrun = Bref, lrun = 0.f; f32x16 o[2]; o[0] = f32x16{}; o[1] = f32x16{}; bool first = false;
    f32x16 cm0 = f32x16{}, cm1 = f32x16{}; p.prep(cm0, cm1, wid, r32, hi);
    if constexpr (P::KIND == 2) {
#pragma unroll
        for (int st = 0; st < 3; ++st) {
            if (st == 0) { ATT_WAIT_BAR(2); } else { ATT_WAIT_BAR(0); }
            if (st == 1) ATT_STAGE(5, 0);
            const int t = (wid >> 1) + st, sl = (t == 5) ? 0 : t;
            if (p.active(t, wid)) {
                const lds_cptr kb = kp0 + sl * SLOTB; const int vb = vb0 + sl * SLOTB;
                if (st == 0 && (wid & 1))       att_step<0x0000u, 0xFFFFu, false>(p, t, wid, cm0, cm1, kb, kb + 512, vb, vb + 2048, qr, mrun, lrun, o, wsf, first, r32, hi);
                else if (st == 2 && !(wid & 1)) att_step<0xFFFFu, 0x0000u, false>(p, t, wid, cm0, cm1, kb, kb + 512, vb, vb + 2048, qr, mrun, lrun, o, wsf, first, r32, hi);
                else                            att_step<0xFFFFu, 0xFFFFu, false>(p, t, wid, cm0, cm1, kb, kb + 512, vb, vb + 2048, qr, mrun, lrun, o, wsf, first, r32, hi);
            }
        }
    } else {
    int slot = 0, slot4 = 4;
    for (int j = 0; j < NT; ++j) {
        const int rem = NT - 1 - j;
        if (rem >= 3) { ATT_WAIT_BAR(6); } else if (rem == 2) { ATT_WAIT_BAR(4); } else if (rem == 1) { ATT_WAIT_BAR(2); } else { ATT_WAIT_BAR(0); }
        if (j + 4 < NT) ATT_STAGE(j + 4, slot4);
        if (p.active(j, wid)) {
            const lds_cptr kb = kp0 + slot * SLOTB; const int vb = vb0 + slot * SLOTB;
            const int pat = p.pattern(j, wid);
            if constexpr (P::KIND == 1) {
                if (pat == 1) att_step<0xFFFFu, 0x000Fu, true>(p, j, wid, cm0, cm1, kb, kb + 512, vb, vb + 2048, qr, mrun, lrun, o, wsf, first, r32, hi);
                else          att_step<0xF000u, 0xFFFFu, true>(p, j, wid, cm0, cm1, kb, kb + 512, vb, vb + 2048, qr, mrun, lrun, o, wsf, first, r32, hi);
            } else if constexpr (P::KIND == 2) {
                if (pat == 3)      att_step<0x0000u, 0xFFFFu, false>(p, j, wid, cm0, cm1, kb, kb + 512, vb, vb + 2048, qr, mrun, lrun, o, wsf, first, r32, hi);
                else if (pat == 4) att_step<0xFFFFu, 0x0000u, false>(p, j, wid, cm0, cm1, kb, kb + 512, vb, vb + 2048, qr, mrun, lrun, o, wsf, first, r32, hi);
                else               att_step<0xFFFFu, 0xFFFFu, false>(p, j, wid, cm0, cm1, kb, kb + 512, vb, vb + 2048, qr, mrun, lrun, o, wsf, first, r32, hi);
            } else att_step<0xFFFFu, 0xFFFFu, false>(p, j, wid, cm0, cm1, kb, kb + 512, vb, vb + 2048, qr, mrun, lrun, o, wsf, first, r32, hi);
        }
        slot = (slot == NSLOT - 1) ? 0 : slot + 1; slot4 = (slot4 == NSLOT - 1) ? 0 : slot4 + 1;
    }
    }
    ATT_LBAR();
    if (has_next) { const int NTn = pn.ntiles();
#pragma unroll
        for (int j0 = 0; j0 < NPRE; ++j0) if (j0 < NTn) ATT_STAGE_P(pn, j0, j0); }
    { auto rr = __builtin_amdgcn_permlane32_swap(__float_as_uint(lrun), __float_as_uint(lrun), false, false); lrun = __uint_as_float(rr[0]) + __uint_as_float(rr[1]); }
    if (p.skip_out()) return;
    p.store_lse(wid, r32, hi, mrun, lrun);
    if (hi == 0) wsf[32 + r32] = lrun;
    asm volatile("s_waitcnt lgkmcnt(0)" ::: "memory");
    float rli[16];
#pragma unroll
    for (int r = 0; r < 16; ++r) rli[r] = fast_rcp(wsf[32 + crow(r, hi)]);
    { LAS bf16_t* stg = (LAS bf16_t*)(shm + LDS_OST) + wid * 2048;
#pragma unroll
      for (int r = 0; r < 16; ++r) { const int orow = crow(r, hi);
#pragma unroll
        for (int d0 = 0; d0 < 2; ++d0) { const float v = o[d0][r] * rli[r]; stg[orow * 64 + d0 * 32 + r32] = (bf16_t)(cvt_pk_bf16(v, v) & 0xffffu); } }
      asm volatile("s_waitcnt lgkmcnt(0)" ::: "memory");
#pragma unroll
      for (int i = 0; i < 4; ++i) { const int row = i * 8 + (lane >> 3), ch = lane & 7; const u32x4 v = *(const LAS u32x4*)(stg + row * 64 + ch * 8); *(u32x4*)(p.optr(wid, row) + ch * 8) = v; } }
#undef ATT_STAGE
#undef ATT_STAGE_P
}

struct PolC {
    static constexpr int KIND = 0;
    const bf16_t* Z; bf16_t* O; int b, h, qb;
    __device__ __forceinline__ int ntiles() const { return SEQ / 64; }
    __device__ __forceinline__ const bf16_t* qrow(int wid, int r32) const { return Z + (size_t)(b * SEQ + qb * 256 + wid * 32 + r32) * ZP + ZQC + 64 * h; }
    __device__ __forceinline__ const bf16_t* kptr(int j, int row) const { return Z + (size_t)(b * SEQ + 64 * j + row) * ZP + ZKC + 64 * (h >> 2); }
    __device__ __forceinline__ const bf16_t* vptr(int j, int row) const { return Z + (size_t)(b * SEQ + 64 * j + row) * ZP + ZVC + 64 * (h >> 2); }
    __device__ __forceinline__ bool active(int, int) const { return true; }
    __device__ __forceinline__ void prep(f32x16&, f32x16&, int, int, int) const {}
    template <unsigned L0, unsigned L1> __device__ __forceinline__ void cinit(f32x16& c0, f32x16& c1, const f32x16&, const f32x16&, float mhat, int, int, int, int) const {
#pragma unroll
        for (int r = 0; r < 16; ++r) { c0[r] = -mhat; c1[r] = -mhat; } }
    __device__ __forceinline__ bool skip_out() const { return false; }
    __device__ __forceinline__ int pattern(int, int) const { return 0; }
    __device__ __forceinline__ void store_lse(int, int, int, float, float) const {}
    __device__ __forceinline__ bf16_t* optr(int wid, int row) const { return O + (size_t)(b * SEQ + qb * 256 + wid * 32 + row) * OP + 768 + 64 * h; }
};
struct PolB {
    static constexpr int KIND = 1;
    const bf16_t* Z; bf16_t* O; const LAS float* tab; int b, h, i0, kr0, nt;
    __device__ __forceinline__ int ntiles() const { return nt; }
    __device__ __forceinline__ const bf16_t* qrow(int wid, int r32) const { return Z + (size_t)(b * SEQ + (i0 + (wid >> 1)) * 64 + 32 * (wid & 1) + r32) * ZP + ZQB + 64 * h; }
    __device__ __forceinline__ const bf16_t* kptr(int j, int row) const { return Z + (size_t)(b * SEQ + (kr0 + j) * 64 + row) * ZP + ZKB + 64 * h; }
    __device__ __forceinline__ const bf16_t* vptr(int j, int row) const { return Z + (size_t)(b * SEQ + (kr0 + j) * 64 + row) * ZP + ZVB + 64 * h; }
    __device__ __forceinline__ bool active(int j, int wid) const { const int gi = i0 + (wid >> 1); int rs = gi - 4; rs = rs < 0 ? 0 : (rs > 120 ? 120 : rs); const int kr = kr0 + j; return kr >= rs && kr <= rs + 7; }
    __device__ __forceinline__ void prep(f32x16& cm0, f32x16& cm1, int wid, int r32, int hi) const {
        const int c = 32 * (wid & 1) + r32; int c0 = c - 8; c0 = c0 < 0 ? 0 : (c0 > 48 ? 48 : c0);
#pragma unroll
        for (int r = 0; r < 16; ++r) { const int k0 = crow(r, hi), k1 = k0 + 32; cm0[r] = (k0 >= c0 && k0 < c0 + 16) ? 0.f : NEGBIG; cm1[r] = (k1 >= c0 && k1 < c0 + 16) ? 0.f : NEGBIG; }
    }
    template <unsigned L0, unsigned L1> __device__ __forceinline__ void cinit(f32x16& c0, f32x16& c1, const f32x16& cm0, const f32x16& cm1, float, int j, int wid, int r32, int hi) const {
        const int gi = i0 + (wid >> 1), c = 32 * (wid & 1) + r32; const int dr = kr0 + j - gi + 7;
        const LAS float* base = tab + dr * 128 + (48 + 15 + 4 * hi - c);
#pragma unroll
        for (int r = 0; r < 16; ++r) { const int kc = (r & 3) + 8 * (r >> 2); c0[r] = ((L0 >> r) & 1u) ? base[kc] + cm0[r] : 0.f; c1[r] = ((L1 >> r) & 1u) ? base[kc + 32] + cm1[r] : 0.f; }
    }
    __device__ __forceinline__ bool skip_out() const { return false; }
    __device__ __forceinline__ int pattern(int, int wid) const { return (wid & 1) ? 2 : 1; }
    __device__ __forceinline__ void store_lse(int, int, int, float, float) const {}
    __device__ __forceinline__ bf16_t* optr(int wid, int row) const { return O + (size_t)(b * SEQ + (i0 + (wid >> 1)) * 64 + 32 * (wid & 1) + row) * OP + 256 + 64 * h; }
};
constexpr int B2_NSLOT = 4, B2_K = 0, B2_V = B2_NSLOT * SLOTB, B2_WS = 2 * B2_NSLOT * SLOTB, B2_OST = B2_WS + 8 * 256, B2_TAB = B2_OST + 8 * 4096, B2_END = B2_TAB + 16 * 128 * 4;
static_assert(B2_END <= RING_BYTES, "mixer B LDS");
struct PolB2 {
    const LAS float* tab; int i0, R0;
    template <unsigned L0, unsigned L1> __device__ __forceinline__ void cinit(f32x16& c0, f32x16& c1, const f32x16& cm0, const f32x16&, float, int s, int wid, int r32, int hi) const {
        const int p = wid >> 2, mb = wid & 3; int cs = 16 * mb - 8; cs = cs < 0 ? 0 : (cs > 32 ? 32 : cs);
        const int qrow = i0 + 2 * p + (r32 >> 4), qcol = 16 * mb + (r32 & 15); int rsq = qrow - 4; rsq = rsq < 0 ? 0 : (rsq > 120 ? 120 : rsq);
        const int krA = R0 + 2 * s, krB = krA + 1;
        const int drA = (krA >= rsq && krA <= rsq + 7) ? krA - qrow + 7 : 15, drB = (krB >= rsq && krB <= rsq + 7) ? krB - qrow + 7 : 15;
        const int off = 48 + 15 + cs + 4 * hi - qcol;
        const LAS float* bA = tab + drA * 128 + off; const LAS float* bB = tab + drB * 128 + off;
#pragma unroll
        for (int r = 0; r < 16; ++r) { const int kc = (r & 3) + 8 * (r >> 2); c0[r] = ((L0 >> r) & 1u) ? bA[kc] + cm0[r] : 0.f; c1[r] = ((L1 >> r) & 1u) ? bB[kc] + cm0[r] : 0.f; }
    }
};
__device__ __forceinline__ void unit_b2(const bf16_t* Z, bf16_t* O, const LAS float* tab, int b, int h, int i0, const float Bref, LAS char* shm) {
    int tid = threadIdx.x; asm volatile("" : "+v"(tid));
    const int lane = tid & 63, r32 = lane & 31, hi = lane >> 5; const int wid = __builtin_amdgcn_readfirstlane(tid >> 6);
    const int p = wid >> 2, mb = wid & 3; int cs = 16 * mb - 8; cs = cs < 0 ? 0 : (cs > 32 ? 32 : cs);
    int R0 = i0 - 4; R0 = R0 < 0 ? 0 : (R0 > 120 ? 120 : R0); int rs3 = i0 - 1; rs3 = rs3 < 0 ? 0 : (rs3 > 120 ? 120 : rs3);
    const int NS = (rs3 + 8 - R0 + 1) >> 1, NR = 2 * NS;
    const unsigned lds0 = (unsigned)(uintptr_t)shm;
    LAS float* wsf = (LAS float*)(shm + B2_WS) + wid * 64;
    const unsigned kdst = lds0 + B2_K + wid * 1024, vdst = lds0 + B2_V + wid * 1024;
    const int vbl = (int)(lds0 + B2_V) + cs * 64 + ((lane >> 4) & 1) * 32 + (lane & 3) * 8 + (4 * hi + ((lane & 15) >> 2)) * 64;
    const lds_cptr kpl = (lds_cptr)shm + B2_K + hi * 1024 + (cs + r32) * 16;
    const bf16_t* Zb = Z + (size_t)(b * SEQ) * ZP + 64 * h;
#define B2_STAGE(ri) do { int kr_ = R0 + (ri); kr_ = kr_ > 127 ? 127 : kr_; const int sl_ = (ri) & (B2_NSLOT - 1); \
        const bf16_t* kp_ = Zb + (size_t)(kr_ * 64 + lane) * ZP + ZKB + wid * 8; const bf16_t* vp_ = Zb + (size_t)(kr_ * 64 + 16 * (wid & 3) + (lane >> 2)) * ZP + ZVB + (wid >> 2) * 32 + (lane & 3) * 8; \
        glds16(kp_, (unsigned)__builtin_amdgcn_readfirstlane(kdst + sl_ * SLOTB)); glds16(vp_, (unsigned)__builtin_amdgcn_readfirstlane(vdst + sl_ * SLOTB)); } while (0)
#pragma unroll
    for (int ri = 0; ri < 4; ++ri) B2_STAGE(ri);
    const int qrow = i0 + 2 * p + (r32 >> 4), qcol = 16 * mb + (r32 & 15);
    bf16x8 qr[4];
    { const bf16_t* qp = Zb + (size_t)(qrow * 64 + qcol) * ZP + ZQB;
#pragma unroll
      for (int d0 = 0; d0 < 4; ++d0) qr[d0] = *(const bf16x8*)(qp + d0 * 16 + hi * 8); }
    float mrun = Bref, lrun = 0.f; f32x16 o[2]; o[0] = f32x16{}; o[1] = f32x16{}; bool first = false;
    f32x16 cm0, cm1 = f32x16{};
    { int c0w = qcol - 8; c0w = c0w < 0 ? 0 : (c0w > 48 ? 48 : c0w);
#pragma unroll
      for (int r = 0; r < 16; ++r) { const int kc = cs + crow(r, hi); cm0[r] = (kc >= c0w && kc < c0w + 16) ? -Bref : NEGBIG; } }
    const PolB2 P{tab, i0, R0};
    int rs0p = i0 + 2 * p - 4; rs0p = rs0p < 0 ? 0 : (rs0p > 120 ? 120 : rs0p); int rs1p = i0 + 2 * p - 3; rs1p = rs1p < 0 ? 0 : (rs1p > 120 ? 120 : rs1p);
    for (int s = 0; s < NS; ++s) {
        if (s == 0) { ATT_WAIT_BAR(4); } else { ATT_WAIT_BAR(0); }
        if (s >= 1 && 2 * s + 2 < NR) { B2_STAGE(2 * s + 2); B2_STAGE(2 * s + 3); }
        const int krA = R0 + 2 * s;
        if (krA + 1 >= rs0p && krA <= rs1p + 7) {
            const int slA = (2 * s) & (B2_NSLOT - 1), slB = (2 * s + 1) & (B2_NSLOT - 1);
            const lds_cptr kbA = kpl + slA * SLOTB, kbB = kpl + slB * SLOTB; const int vbA = vbl + slA * SLOTB, vbB = vbl + slB * SLOTB;
            if (mb == 0)      att_step<0x0FFFu, 0x0FFFu, true>(P, s, wid, cm0, cm1, kbA, kbB, vbA, vbB, qr, mrun, lrun, o, wsf, first, r32, hi);
            else if (mb == 3) att_step<0xFFF0u, 0xFFF0u, true>(P, s, wid, cm0, cm1, kbA, kbB, vbA, vbB, qr, mrun, lrun, o, wsf, first, r32, hi);
            else              att_step<0xFFFFu, 0xFFFFu, true>(P, s, wid, cm0, cm1, kbA, kbB, vbA, vbB, qr, mrun, lrun, o, wsf, first, r32, hi);
        }
    }
    ATT_LBAR();
    { auto rr = __builtin_amdgcn_permlane32_swap(__float_as_uint(lrun), __float_as_uint(lrun), false, false); lrun = __uint_as_float(rr[0]) + __uint_as_float(rr[1]); }
    if (hi == 0) wsf[32 + r32] = lrun;
    asm volatile("s_waitcnt lgkmcnt(0)" ::: "memory");
    float rli[16];
#pragma unroll
    for (int r = 0; r < 16; ++r) rli[r] = fast_rcp(wsf[32 + crow(r, hi)]);
    { LAS bf16_t* stg = (LAS bf16_t*)(shm + B2_OST) + wid * 2048;
#pragma unroll
      for (int r = 0; r < 16; ++r) { const int orow = crow(r, hi);
#pragma unroll
        for (int d0 = 0; d0 < 2; ++d0) { const float v = o[d0][r] * rli[r]; stg[orow * 64 + d0 * 32 + r32] = (bf16_t)(cvt_pk_bf16(v, v) & 0xffffu); } }
      asm volatile("s_waitcnt lgkmcnt(0)" ::: "memory");
      bf16_t* Ob = O + (size_t)(b * SEQ) * OP + 256 + 64 * h;
#pragma unroll
      for (int i = 0; i < 4; ++i) { const int row = i * 8 + (lane >> 3), ch = lane & 7; const u32x4 v = *(const LAS u32x4*)(stg + row * 64 + ch * 8);
          *(u32x4*)(Ob + (size_t)((i0 + 2 * p + (row >> 4)) * 64 + 16 * mb + (row & 15)) * OP + ch * 8) = v; } }
    ATT_LBAR();
#undef B2_STAGE
}
__device__ __forceinline__ void unit_b8(const bf16_t* Z, bf16_t* O, const LAS float* tab, int b, int h, int i0, const float Bref, LAS char* shm) {
    int tid = threadIdx.x; asm volatile("" : "+v"(tid));
    const int lane = tid & 63, r32 = lane & 31, hi = lane >> 5; const int wid = __builtin_amdgcn_readfirstlane(tid >> 6);
    const int p = wid >> 2, mb = wid & 3; int cs = 16 * mb - 8; cs = cs < 0 ? 0 : (cs > 32 ? 32 : cs);
    int R0 = i0 - 4; R0 = R0 < 0 ? 0 : (R0 > 120 ? 120 : R0); int rsl = i0 + 3; rsl = rsl < 0 ? 0 : (rsl > 120 ? 120 : rsl);
    const int NS = (rsl + 8 - R0 + 1) >> 1, NR = 2 * NS;
    const unsigned lds0 = (unsigned)(uintptr_t)shm;
    LAS float* wsf = (LAS float*)(shm + B2_WS) + wid * 64;
    const unsigned kdst = lds0 + B2_K + wid * 1024, vdst = lds0 + B2_V + wid * 1024;
    const int vbl = (int)(lds0 + B2_V) + cs * 64 + ((lane >> 4) & 1) * 32 + (lane & 3) * 8 + (4 * hi + ((lane & 15) >> 2)) * 64;
    const lds_cptr kpl = (lds_cptr)shm + B2_K + hi * 1024 + (cs + r32) * 16;
    const bf16_t* Zb = Z + (size_t)(b * SEQ) * ZP + 64 * h;
#define B8_STAGE(ri) do { int kr_ = R0 + (ri); kr_ = kr_ > 127 ? 127 : kr_; const int sl_ = (ri) & (B2_NSLOT - 1); \
        const bf16_t* kp_ = Zb + (size_t)(kr_ * 64 + lane) * ZP + ZKB + wid * 8; const bf16_t* vp_ = Zb + (size_t)(kr_ * 64 + 16 * (wid & 3) + (lane >> 2)) * ZP + ZVB + (wid >> 2) * 32 + (lane & 3) * 8; \
        glds16(kp_, (unsigned)__builtin_amdgcn_readfirstlane(kdst + sl_ * SLOTB)); glds16(vp_, (unsigned)__builtin_amdgcn_readfirstlane(vdst + sl_ * SLOTB)); } while (0)
    const int qcol = 16 * mb + (r32 & 15), qrowA = i0 + 2 * p + (r32 >> 4), qrowB = qrowA + 4;
    bf16x8 qa[4], qb[4];
    { const bf16_t* qp = Zb + (size_t)(qrowA * 64 + qcol) * ZP + ZQB; const bf16_t* qq = Zb + (size_t)(qrowB * 64 + qcol) * ZP + ZQB;
#pragma unroll
      for (int d0 = 0; d0 < 4; ++d0) { qa[d0] = *(const bf16x8*)(qp + d0 * 16 + hi * 8); qb[d0] = *(const bf16x8*)(qq + d0 * 16 + hi * 8); } }
    asm volatile("" ::: "memory");
#pragma unroll
    for (int ri = 0; ri < 4; ++ri) B8_STAGE(ri);
    float mrun = Bref, lrA = 0.f, lrB = 0.f; f32x16 oa[2], ob[2]; oa[0] = f32x16{}; oa[1] = f32x16{}; ob[0] = f32x16{}; ob[1] = f32x16{}; bool first = false;
    f32x16 cm0, cm1 = f32x16{};
    { int c0w = qcol - 8; c0w = c0w < 0 ? 0 : (c0w > 48 ? 48 : c0w);
#pragma unroll
      for (int r = 0; r < 16; ++r) { const int kc = cs + crow(r, hi); cm0[r] = (kc >= c0w && kc < c0w + 16) ? -Bref : NEGBIG; } }
    const PolB2 PA{tab, i0, R0}, PB{tab, i0 + 4, R0};
    int a0 = i0 + 2 * p - 4; a0 = a0 < 0 ? 0 : (a0 > 120 ? 120 : a0); int a1 = i0 + 2 * p - 3; a1 = a1 < 0 ? 0 : (a1 > 120 ? 120 : a1);
    int b0 = i0 + 2 * p;     b0 = b0 < 0 ? 0 : (b0 > 120 ? 120 : b0); int b1 = i0 + 2 * p + 1; b1 = b1 < 0 ? 0 : (b1 > 120 ? 120 : b1);
#define B8_STEP(PP, QQ, LR, OO) do { __builtin_amdgcn_sched_barrier(0); \
        if (mb == 0)      att_step<0x0FFFu, 0x0FFFu, true>(PP, s, wid, cm0, cm1, kbA, kbB, vbA, vbB, QQ, mrun, LR, OO, wsf, first, r32, hi); \
        else if (mb == 3) att_step<0xFFF0u, 0xFFF0u, true>(PP, s, wid, cm0, cm1, kbA, kbB, vbA, vbB, QQ, mrun, LR, OO, wsf, first, r32, hi); \
        else              att_step<0xFFFFu, 0xFFFFu, true>(PP, s, wid, cm0, cm1, kbA, kbB, vbA, vbB, QQ, mrun, LR, OO, wsf, first, r32, hi); \
        __builtin_amdgcn_sched_barrier(0); } while (0)
#pragma unroll 1
    for (int s = 0; s < NS; ++s) {
        if (s == 0) { ATT_WAIT_BAR(4); } else { ATT_WAIT_BAR(0); }
        if (s >= 1 && 2 * s + 2 < NR) { B8_STAGE(2 * s + 2); B8_STAGE(2 * s + 3); }
        const int krA = R0 + 2 * s;
        const int slA = (2 * s) & (B2_NSLOT - 1), slB = (2 * s + 1) & (B2_NSLOT - 1);
        const lds_cptr kbA = kpl + slA * SLOTB, kbB = kpl + slB * SLOTB; const int vbA = vbl + slA * SLOTB, vbB = vbl + slB * SLOTB;
        if (krA + 1 >= a0 && krA <= a1 + 7) B8_STEP(PA, qa, lrA, oa);
        if (krA + 1 >= b0 && krA <= b1 + 7) B8_STEP(PB, qb, lrB, ob);
    }
    ATT_LBAR();
    bf16_t* Ob = O + (size_t)(b * SEQ) * OP + 256 + 64 * h;
    LAS bf16_t* stg = (LAS bf16_t*)(shm + B2_OST) + wid * 2048;
#define B8_OUT(LR, OO, ROW0) do { float l_ = LR; \
        { auto rr = __builtin_amdgcn_permlane32_swap(__float_as_uint(l_), __float_as_uint(l_), false, false); l_ = __uint_as_float(rr[0]) + __uint_as_float(rr[1]); } \
        if (hi == 0) wsf[32 + r32] = l_; \
        asm volatile("s_waitcnt lgkmcnt(0)" ::: "memory"); \
        _Pragma("unroll") for (int r = 0; r < 16; ++r) { const int orow = crow(r, hi); const float rl_ = fast_rcp(wsf[32 + orow]); \
            _Pragma("unroll") for (int d0 = 0; d0 < 2; ++d0) { const float v = OO[d0][r] * rl_; stg[orow * 64 + d0 * 32 + r32] = (bf16_t)(cvt_pk_bf16(v, v) & 0xffffu); } } \
        asm volatile("s_waitcnt lgkmcnt(0)" ::: "memory"); \
        _Pragma("unroll") for (int i = 0; i < 4; ++i) { const int row = i * 8 + (lane >> 3), ch = lane & 7; const u32x4 v = *(const LAS u32x4*)(stg + row * 64 + ch * 8); \
            *(u32x4*)(Ob + (size_t)(((ROW0) + (row >> 4)) * 64 + 16 * mb + (row & 15)) * OP + ch * 8) = v; } \
        asm volatile("s_waitcnt lgkmcnt(0)" ::: "memory"); } while (0)
    B8_OUT(lrA, oa, i0 + 2 * p);
    B8_OUT(lrB, ob, i0 + 4 + 2 * p);
    ATT_LBAR();
#undef B8_STAGE
#undef B8_STEP
#undef B8_OUT
}
struct PolA {
    static constexpr int KIND = 2;
    bf16_t* Z; float* LSE; const LAS float* tab; int b, g, h, rate, rho, u, nblk; bool dry;
    __device__ __forceinline__ int ntiles() const { return 6; }
    __device__ __forceinline__ size_t tokrow(int didx) const { return (size_t)(b * SEQ + didx * rate + rho); }
    __device__ __forceinline__ const bf16_t* qrow(int wid, int r32) const { return Z + tokrow(256 * u + 32 * wid + r32) * ZP + ZQA + 256 * g + 64 * h; }
    __device__ __forceinline__ int blk(int j) const { int bj = 4 * u - 1 + j; return bj < 0 ? 0 : (bj >= nblk ? nblk - 1 : bj); }
    __device__ __forceinline__ const bf16_t* kptr(int j, int row) const { return Z + tokrow(64 * blk(j) + row) * ZP + ZKA + 256 * g + 64 * h; }
    __device__ __forceinline__ const bf16_t* vptr(int j, int row) const { return Z + tokrow(64 * blk(j) + row) * ZP + ZVA + 256 * g + 64 * h; }
    __device__ __forceinline__ bool active(int j, int wid) const { const int bj = 4 * u - 1 + j, d = bj - (4 * u + (wid >> 1)); return bj >= 0 && bj < nblk && d >= -1 && d <= 1; }
    __device__ __forceinline__ void prep(f32x16&, f32x16&, int, int, int) const {}
    template <unsigned L0, unsigned L1> __device__ __forceinline__ void cinit(f32x16& c0, f32x16& c1, const f32x16&, const f32x16&, float mhat, int j, int wid, int r32, int hi) const {
        const int qi = 256 * u + 32 * wid + r32; const LAS float* base = tab + (64 * (4 * u - 1 + j) - qi + 4 * hi + 127);
#pragma unroll
        for (int r = 0; r < 16; ++r) { const int kc = (r & 3) + 8 * (r >> 2); c0[r] = L0 ? base[kc] - mhat : 0.f; c1[r] = L1 ? base[kc + 32] - mhat : 0.f; }
    }
    __device__ __forceinline__ bool skip_out() const { return dry; }
    __device__ __forceinline__ int pattern(int j, int wid) const { const int d = (4 * u - 1 + j) - (4 * u + (wid >> 1)); return (d < 0 && (wid & 1)) ? 3 : ((d > 0 && !(wid & 1)) ? 4 : 0); }
    __device__ __forceinline__ void store_lse(int wid, int r32, int hi, float m, float l) const {
        if (hi == 0) LSE[tokrow(256 * u + 32 * wid + r32) * 12 + g * 4 + h] = (m + __builtin_amdgcn_logf(l)) * 0.6931471805599453f;
    }
    __device__ __forceinline__ bf16_t* optr(int wid, int row) const { return Z + tokrow(256 * u + 32 * wid + row) * ZP + ZQA + 256 * g + 64 * h; }
};
__device__ __forceinline__ int t5_bucket(int rel) {
    const int ret = rel > 0 ? 16 : 0; const int n = rel < 0 ? -rel : rel;
    const float nf = (float)(n < 1 ? 1 : n);
    int large = 8 + (int)(__logf(nf / 8.0f) / 4.852030263919617f * 8.0f);
    large = large > 15 ? 15 : large;
    return ret + (n < 8 ? n : large);
}
}

namespace attp {
using bf16=__hip_bfloat16;
__device__ __forceinline__ int crow(int r,int hi){return (r&3)+8*(r>>2)+4*hi;}
#define SBAR() __builtin_amdgcn_sched_barrier(0)
constexpr int NSLOT=3, SLOTB=8192;
constexpr int NW=8, QBLK=32, KVBLK=64; constexpr int LDS_K=0, LDS_V=NSLOT*SLOTB, LDS_WS=2*NSLOT*SLOTB, LDS_OST=LDS_WS+NW*64*4, LDS_BYTES=LDS_OST+NW*4096;
__device__ __forceinline__ void glds16(const void*gsrc,unsigned lds_dst){unsigned keep;
  asm volatile("s_mov_b32 %0, m0\n\ts_mov_b32 m0, %2\n\ts_nop 0\n\tglobal_load_lds_dwordx4 %1, off\n\ts_mov_b32 m0, %0":"=&s"(keep):"v"(gsrc),"s"(lds_dst):"memory");}
__device__ __forceinline__ float max3f(float a,float b,float c){float r;asm("v_max3_f32 %0, %1, %2, %3":"=v"(r):"v"(a),"v"(b),"v"(c));return r;}
__device__ __forceinline__ float max2f(float a,float b){float r;asm("v_max_f32_e32 %0, %1, %2":"=v"(r):"v"(a),"v"(b));return r;}
__device__ __forceinline__ float fadd_s(float a,float b){float r;asm("v_add_f32_e32 %0, %1, %2":"=v"(r):"v"(a),"v"(b));return r;}
__device__ __forceinline__ float fsub_s(float a,float b){float r;asm("v_sub_f32_e32 %0, %1, %2":"=v"(r):"v"(a),"v"(b));return r;}
typedef float f32x2_t __attribute__((ext_vector_type(2)));
__device__ __forceinline__ unsigned cvtpk_s(float lo,float hi){f32x2_t v={lo,hi};bf16x2_t b=__builtin_convertvector(v,bf16x2_t);return __builtin_bit_cast(unsigned,b);}
#define WAIT_BAR(N) asm volatile("s_waitcnt vmcnt(" #N ") lgkmcnt(0)\n\ts_barrier":::"memory")

typedef __attribute__((address_space(3))) const char* lds_cptr;
__device__ __forceinline__ void qkt(f32x16&p0,f32x16&p1,lds_cptr Kslot,const bf16x8*qr,const f32x16&negm,int r32,int hi){
  lds_cptr kb=Kslot+hi*1024+r32*16;
  #pragma unroll
  for(int d0=0;d0<4;++d0){
    const bf16x8 b0=*(const __attribute__((address_space(3))) bf16x8*)(kb+d0*2048);
    const bf16x8 b1=*(const __attribute__((address_space(3))) bf16x8*)(kb+d0*2048+512);
    if(d0==0){p0=__builtin_amdgcn_mfma_f32_32x32x16_bf16(b0,qr[0],negm,0,0,0);p1=__builtin_amdgcn_mfma_f32_32x32x16_bf16(b1,qr[0],negm,0,0,0);}
    else{p0=__builtin_amdgcn_mfma_f32_32x32x16_bf16(b0,qr[d0],p0,0,0,0);p1=__builtin_amdgcn_mfma_f32_32x32x16_bf16(b1,qr[d0],p1,0,0,0);}}
}
typedef short v4i16_t __attribute__((ext_vector_type(4)));
__device__ __forceinline__ void kload8(bf16x8*kf,lds_cptr kp){
  kf[0]=*(const __attribute__((address_space(3))) bf16x8*)(kp);      kf[1]=*(const __attribute__((address_space(3))) bf16x8*)(kp+512);
  kf[2]=*(const __attribute__((address_space(3))) bf16x8*)(kp+2048); kf[3]=*(const __attribute__((address_space(3))) bf16x8*)(kp+2560);
  kf[4]=*(const __attribute__((address_space(3))) bf16x8*)(kp+4096); kf[5]=*(const __attribute__((address_space(3))) bf16x8*)(kp+4608);
  kf[6]=*(const __attribute__((address_space(3))) bf16x8*)(kp+6144); kf[7]=*(const __attribute__((address_space(3))) bf16x8*)(kp+6656);
}
__device__ __forceinline__ void kload2(bf16x8*kf,lds_cptr kp,int j){ kf[2*j]=*(const __attribute__((address_space(3))) bf16x8*)(kp+j*2048); kf[2*j+1]=*(const __attribute__((address_space(3))) bf16x8*)(kp+j*2048+512); }
__device__ __forceinline__ s16x4 vtr(lds_cptr p){ return __builtin_bit_cast(s16x4,__builtin_amdgcn_ds_read_tr16_b64_v4i16((__attribute__((address_space(3))) v4i16_t*)p)); }
__device__ __forceinline__ float rowmax(const f32x16&p0,const f32x16&p1){
  float a=max3f(p0[0],p0[1],p1[0]),b=max3f(p0[2],p0[3],p1[1]);a=max3f(a,p1[2],p1[3]);
  #pragma unroll
  for(int r=4;r<16;r+=4){a=max3f(a,p0[r],p0[r+1]);b=max3f(b,p0[r+2],p0[r+3]);a=max3f(a,p1[r],p1[r+1]);b=max3f(b,p1[r+2],p1[r+3]);}
  const float m=max2f(a,b);
  auto rr=__builtin_amdgcn_permlane32_swap(__float_as_uint(m),__float_as_uint(m),false,false);
  return max2f(__uint_as_float(rr[0]),__uint_as_float(rr[1]));
}
__device__ __forceinline__ void pv(f32x16*o,int vb,bf16x8 pa0,bf16x8 pa1,bf16x8 pa2,bf16x8 pa3){
  #pragma unroll
  for(int d0=0;d0<2;++d0){s16x4 lo[4],hi[4];
    #pragma unroll
    for(int ks=0;ks<4;++ks){
      asm volatile("ds_read_b64_tr_b16 %0,%1 offset:%c2":"=&v"(lo[ks]):"v"(vb),"i"(d0*4096+ks*1024):"memory");
      asm volatile("ds_read_b64_tr_b16 %0,%1 offset:%c2":"=&v"(hi[ks]):"v"(vb),"i"(d0*4096+ks*1024+512):"memory");}
    asm volatile("s_waitcnt lgkmcnt(0)":::"memory");SBAR();
    #define PK(k) (bf16x8){lo[k][0],lo[k][1],lo[k][2],lo[k][3],hi[k][0],hi[k][1],hi[k][2],hi[k][3]}
    o[d0]=__builtin_amdgcn_mfma_f32_32x32x16_bf16(pa0,PK(0),o[d0],0,0,0);
    o[d0]=__builtin_amdgcn_mfma_f32_32x32x16_bf16(pa1,PK(1),o[d0],0,0,0);
    o[d0]=__builtin_amdgcn_mfma_f32_32x32x16_bf16(pa2,PK(2),o[d0],0,0,0);
    o[d0]=__builtin_amdgcn_mfma_f32_32x32x16_bf16(pa3,PK(3),o[d0],0,0,0);
    #undef PK
  }
}
#ifndef ATTN_STORE16
#define ATTN_STORE16(p,v) (*(u32x4*)(p)=(v))
#endif
template<int THRL,int KP,int OPITCH,bool FIXREF> __device__ __forceinline__ void attn_unit(const bf16*Qw,const bf16*__restrict__ Kh,const bf16*__restrict__ Vh,bf16*Ow,const int NT,const float Bref,__attribute__((address_space(3))) char*shm){
  int tid=threadIdx.x; asm volatile("":"+v"(tid)); const int lane=tid&63,r32=lane&31,hi=lane>>5; const int wid=__builtin_amdgcn_readfirstlane(tid>>6);
  const unsigned lds0=(unsigned)(uintptr_t)shm;
  __attribute__((address_space(3))) float*wsf=(__attribute__((address_space(3))) float*)(shm+LDS_WS)+wid*64;
  const bf16*ksrc=Kh+(long)lane*KP+wid*8;
  const bf16*vsrc=Vh+(long)(16*(wid&3)+(lane>>2))*KP+(wid>>2)*32+(lane&3)*8;
  const unsigned kdst=lds0+LDS_K+wid*1024, vdst=lds0+LDS_V+wid*1024;
  #define DMA_K(t,slot) glds16(ksrc+(long)(t)*KVBLK*KP,(unsigned)__builtin_amdgcn_readfirstlane(kdst+(slot)))
  #define DMA_V(t,slot) glds16(vsrc+(long)(t)*KVBLK*KP,(unsigned)__builtin_amdgcn_readfirstlane(vdst+(slot)))
  const int vb0=(int)(lds0+LDS_V)+((lane>>4)&1)*32+(lane&3)*8+(4*hi+((lane&15)>>2))*64;
  bf16x8 kf[8];
  const lds_cptr shm3=(lds_cptr)shm; const lds_cptr kp0=shm3+LDS_K+hi*1024+r32*16; const lds_cptr vp0=shm3+LDS_V+((lane>>4)&1)*32+(lane&3)*8+(4*hi+((lane&15)>>2))*64;
  DMA_K(0,0);DMA_V(0,0);DMA_K(1,SLOTB);
  bf16x8 qr[4];
  #pragma unroll
  for(int d0=0;d0<4;++d0)qr[d0]=*reinterpret_cast<const bf16x8*>(&Qw[(long)r32*KP+d0*16+hi*8]);
  float mhat=FIXREF?Bref:0.f,l_reg=0.f;f32x16 o[2];o[0]=f32x16{};o[1]=f32x16{};f32x16 negm=f32x16{};
  if constexpr(FIXREF){ _Pragma("unroll") for(int r=0;r<16;++r)negm[r]=-Bref; }
  asm volatile("":"+v"(negm));
  #define CMASK(P0,P1,t) do{}while(0)
  bool resc=false;
  #define START(P0,P1) do{ resc=false; if constexpr(!FIXREF) { const float rm=rowmax(P0,P1); \
    { const float dl=rm; mhat=fadd_s(mhat,dl); \
      _Pragma("unroll") for(int r=0;r<16;++r){P0[r]=fsub_s(P0[r],dl);P1[r]=fsub_s(P1[r],dl);} \
      _Pragma("unroll") for(int r=0;r<16;++r)negm[r]=-mhat; asm volatile("":"+v"(negm)); } } \
    _Pragma("unroll") for(int r=0;r<16;++r)P0[r]=__builtin_amdgcn_exp2f(P0[r]); }while(0)
  #define RESC() do{ if(resc){ asm volatile("s_waitcnt lgkmcnt(0)":::"memory"); \
      _Pragma("unroll") for(int d_=0;d_<2;++d_) _Pragma("unroll") for(int r=0;r<16;++r)o[d_][r]*=wsf[crow(r,hi)]; } }while(0)
  f32x16 pA0,pA1,pB0,pB1;
  int sl_prev=0,sl_cur=0,sl_next=SLOTB;
  #define ROT() do{sl_prev=sl_cur;sl_cur=sl_next;sl_next=(sl_next==(NSLOT-1)*SLOTB)?0:sl_next+SLOTB;}while(0)
  DMA_K(2,2*SLOTB);
  WAIT_BAR(3);
  qkt(pA0,pA1,shm3+LDS_K,qr,negm,r32,hi);asm volatile("s_nop 15\n\ts_nop 7":"+v"(pA0),"+v"(pA1));CMASK(pA0,pA1,0);
  START(pA0,pA1);
  _Pragma("unroll") for(int r=0;r<16;++r)pA1[r]=__builtin_amdgcn_exp2f(pA1[r]);
  WAIT_BAR(0);
  DMA_K(3,0);DMA_V(1,SLOTB);
  ROT();
  kload8(kf,kp0+sl_cur);
  WAIT_BAR(2);
  s16x4 vlo[8],vhi[8]; u32x4 pw0,pw1,pw2,pw3;
  #define PKW(P,B) cvtpk_s(P[B],P[B+1])
  #define PAF(k) __builtin_bit_cast(bf16x8,pw##k)
  #define VFR(i) (bf16x8){vlo[i][0],vlo[i][1],vlo[i][2],vlo[i][3],vhi[i][0],vhi[i][1],vhi[i][2],vhi[i][3]}
  #define PIN(x) asm volatile("":"+v"(x))
  #define MX3(a,b,c) __builtin_fmaxf(__builtin_fmaxf((a),(b)),(c))
  #define GAPA(MF,A0,A1,A2,A3,W0,W1,PW) do{ MF; sacc+=A0; sacc+=A1; sacc+=A2; sacc+=A3; PIN(sacc); W0; W1; PIN(PW); SBAR(); }while(0)
  #define EX(v) __builtin_amdgcn_exp2f(v)
  #define GAPB(MF,X,B) do{ MF; X[B]=EX(X[B]); X[B+1]=EX(X[B+1]); X[B+2]=EX(X[B+2]); X[B+3]=EX(X[B+3]); PIN(X); SBAR(); }while(0)
  #define VRD(i) do{ vlo[i]=vtr(vp_+(((i)>>2)*4096+((i)&3)*1024)); vhi[i]=vtr(vp_+(((i)>>2)*4096+((i)&3)*1024+512)); }while(0)
  #define KRD(G,j) do{ if(G){ kload2(kf,kp0+sl_next,j); SBAR(); } }while(0)
  #define STEP(C0,C1,P0,P1,t,GK,GV,GL) do{ SBAR(); \
    const lds_cptr vp_=vp0+sl_prev; \
    VRD(0); SBAR(); float sacc=(P0[0]+P0[1]); \
    GAPA(C0=__builtin_amdgcn_mfma_f32_32x32x16_bf16(kf[0],qr[0],negm,0,0,0), P0[2],P0[3],P0[4],P0[5],     pw0[0]=PKW(P0,0), pw0[1]=PKW(P0,2), pw0); \
    VRD(4); SBAR(); GAPA(C1=__builtin_amdgcn_mfma_f32_32x32x16_bf16(kf[1],qr[0],negm,0,0,0), P0[6],P0[7],P0[8],P0[9],     pw0[2]=PKW(P0,4), pw0[3]=PKW(P0,6), pw0); \
    VRD(1); SBAR(); GAPA(C0=__builtin_amdgcn_mfma_f32_32x32x16_bf16(kf[2],qr[1],C0,0,0,0),   P0[10],P0[11],P0[12],P0[13], pw1[0]=PKW(P0,8), pw1[1]=PKW(P0,10), pw1); \
    VRD(5); SBAR(); GAPA(C1=__builtin_amdgcn_mfma_f32_32x32x16_bf16(kf[3],qr[1],C1,0,0,0),   P0[14],P0[15],P1[0],P1[1],   pw1[2]=PKW(P0,12),pw1[3]=PKW(P0,14), pw1); \
    VRD(2); SBAR(); GAPA(C0=__builtin_amdgcn_mfma_f32_32x32x16_bf16(kf[4],qr[2],C0,0,0,0),   P1[2],P1[3],P1[4],P1[5],     pw2[0]=PKW(P1,0), pw2[1]=PKW(P1,2), pw2); \
    VRD(6); SBAR(); GAPA(C1=__builtin_amdgcn_mfma_f32_32x32x16_bf16(kf[5],qr[2],C1,0,0,0),   P1[6],P1[7],P1[8],P1[9],     pw2[2]=PKW(P1,4), pw2[3]=PKW(P1,6), pw2); \
    VRD(3); SBAR(); GAPA(C0=__builtin_amdgcn_mfma_f32_32x32x16_bf16(kf[6],qr[3],C0,0,0,0),   P1[10],P1[11],P1[12],P1[13], pw3[0]=PKW(P1,8), pw3[1]=PKW(P1,10), pw3); \
    VRD(7); SBAR(); GAPA(C1=__builtin_amdgcn_mfma_f32_32x32x16_bf16(kf[7],qr[3],C1,0,0,0),   P1[14],P1[15],0.f,0.f,       pw3[2]=PKW(P1,12),pw3[3]=PKW(P1,14), pw3); \
    l_reg+=sacc; \
    if(GK){DMA_K((t)+3,sl_cur);} if(GV){DMA_V((t)+1,sl_next);} \
    CMASK(C0,C1,t); \
    resc=false; \
    if constexpr(!FIXREF) { float a=MX3(C0[0],C0[1],C1[0]),b=MX3(C0[2],C0[3],C1[1]); a=MX3(a,C1[2],C1[3]); \
      _Pragma("unroll") for(int r=4;r<16;r+=4){a=MX3(a,C0[r],C0[r+1]);b=MX3(b,C0[r+2],C0[r+3]);a=MX3(a,C1[r],C1[r+1]);b=MX3(b,C1[r+2],C1[r+3]);} \
      float rm=__builtin_fmaxf(a,b); { auto rr=__builtin_amdgcn_permlane32_swap(__float_as_uint(rm),__float_as_uint(rm),false,false); rm=__builtin_fmaxf(__uint_as_float(rr[0]),__uint_as_float(rr[1])); } \
      resc=false; \
      if(__builtin_expect(__any(rm>(float)THRL),0)){ const float dl=__builtin_fmaxf(rm,0.f); mhat+=dl; \
        _Pragma("unroll") for(int r=0;r<16;++r){C0[r]-=dl;C1[r]-=dl;} \
        _Pragma("unroll") for(int r=0;r<16;++r)negm[r]=-mhat; asm volatile("":"+v"(negm)); \
        const float f=__builtin_amdgcn_exp2f(-dl); l_reg*=f; if(hi==0)wsf[r32]=f; resc=true; } } \
    SBAR(); \
    GAPB(o[0]=__builtin_amdgcn_mfma_f32_32x32x16_bf16(PAF(0),VFR(0),o[0],0,0,0), C0,0); \
    GAPB(o[1]=__builtin_amdgcn_mfma_f32_32x32x16_bf16(PAF(0),VFR(4),o[1],0,0,0), C0,4); \
    KRD(GL,0); GAPB(o[0]=__builtin_amdgcn_mfma_f32_32x32x16_bf16(PAF(1),VFR(1),o[0],0,0,0), C0,8); \
    KRD(GL,1); GAPB(o[1]=__builtin_amdgcn_mfma_f32_32x32x16_bf16(PAF(1),VFR(5),o[1],0,0,0), C0,12); \
    KRD(GL,2); GAPB(o[0]=__builtin_amdgcn_mfma_f32_32x32x16_bf16(PAF(2),VFR(2),o[0],0,0,0), C1,0); \
    KRD(GL,3); GAPB(o[1]=__builtin_amdgcn_mfma_f32_32x32x16_bf16(PAF(2),VFR(6),o[1],0,0,0), C1,4); \
    GAPB(o[0]=__builtin_amdgcn_mfma_f32_32x32x16_bf16(PAF(3),VFR(3),o[0],0,0,0), C1,8); \
    GAPB(o[1]=__builtin_amdgcn_mfma_f32_32x32x16_bf16(PAF(3),VFR(7),o[1],0,0,0), C1,12); \
    }while(0)
  int t=1;
  for(;t+5<NT;t+=2){
    STEP(pB0,pB1,pA0,pA1,t,true,true,true);     WAIT_BAR(2); RESC(); ROT();
    STEP(pA0,pA1,pB0,pB1,t+1,true,true,true);   WAIT_BAR(2); RESC(); ROT();
  }
  #define ENDW(tt) do{ if((tt)+3<NT){WAIT_BAR(2);} else if((tt)+2<NT){WAIT_BAR(1);} else {WAIT_BAR(0);} }while(0)
  for(;t+1<NT;t+=2){
    STEP(pB0,pB1,pA0,pA1,t,(t+3<NT),(t+1<NT),(t+1<NT));       ENDW(t);   RESC(); ROT();
    STEP(pA0,pA1,pB0,pB1,t+1,(t+4<NT),(t+2<NT),(t+2<NT));     ENDW(t+1); RESC(); ROT();
  }
  STEP(pB0,pB1,pA0,pA1,NT-1,false,false,false); RESC();
  { float sacc=pB0[0]+pB0[1]; _Pragma("unroll") for(int r=2;r<16;++r)sacc+=pB0[r]; _Pragma("unroll") for(int r=0;r<16;++r)sacc+=pB1[r]; l_reg+=sacc;
    pw0=(u32x4){PKW(pB0,0),PKW(pB0,2),PKW(pB0,4),PKW(pB0,6)};pw1=(u32x4){PKW(pB0,8),PKW(pB0,10),PKW(pB0,12),PKW(pB0,14)};pw2=(u32x4){PKW(pB1,0),PKW(pB1,2),PKW(pB1,4),PKW(pB1,6)};pw3=(u32x4){PKW(pB1,8),PKW(pB1,10),PKW(pB1,12),PKW(pB1,14)};
    SBAR(); pv(o,vb0+sl_cur,PAF(0),PAF(1),PAF(2),PAF(3)); }
  #undef PKW
  #undef PAF
  #undef VFR
  #undef PIN
  #undef MX3
  #undef GAPA
  #undef GAPB
  #undef EX
  #undef VRD
  #undef KRD
  #undef STEP
  #undef ENDW
  {auto rr=__builtin_amdgcn_permlane32_swap(__float_as_uint(l_reg),__float_as_uint(l_reg),false,false);l_reg=__uint_as_float(rr[0])+__uint_as_float(rr[1]);}
  if(hi==0)wsf[32+r32]=l_reg;asm volatile("s_waitcnt lgkmcnt(0)":::"memory");
  float rli[16];
  #pragma unroll
  for(int r=0;r<16;++r)rli[r]=__builtin_amdgcn_rcpf(wsf[32+crow(r,hi)]);
  { __attribute__((address_space(3))) unsigned short*stg=(__attribute__((address_space(3))) unsigned short*)(shm+LDS_OST)+wid*2048;
    #pragma unroll
    for(int r=0;r<16;++r){const int orow=crow(r,hi);
      #pragma unroll
      for(int d0=0;d0<2;++d0){const float v_=o[d0][r]*rli[r]; stg[orow*64+d0*32+r32]=(unsigned short)(cvtpk_s(v_,v_)&0xffffu);}}
    asm volatile("s_waitcnt lgkmcnt(0)":::"memory");
    #pragma unroll
    for(int i=0;i<4;++i){const int row=i*8+(lane>>3),ch=lane&7; const u32x4 v=*(const __attribute__((address_space(3))) u32x4*)(stg+row*64+ch*8); ATTN_STORE16(Ow+(long)row*OPITCH+ch*8,v);} }
  asm volatile("s_waitcnt lgkmcnt(0)\n\ts_barrier":::"memory");
  #undef DMA_K
  #undef DMA_V
  #undef CMASK
  #undef START
  #undef RESC
  #undef ROT
}
constexpr int ATTN_LDS_BYTES=LDS_BYTES;
#undef SBAR
#undef WAIT_BAR
}

#define XB_TMO      128
#define XB_XCNT(j)  (256  + 64 * (j))
#define XB_XSUB(j)  (1280 + 64 * (j))
#define XB_XGEN(j)  (2304 + 64 * (j))
#define XB_TOP      3328
#define XB_TOPGEN   3392
#define XCD_BAR_WORDS 3456
#define XB_SPIN_CAP (1u << 22)
__device__ __forceinline__ unsigned xb_ld(unsigned* p)              { return __hip_atomic_load(p, __ATOMIC_RELAXED, __HIP_MEMORY_SCOPE_AGENT); }
__device__ __forceinline__ unsigned xb_add(unsigned* p, unsigned v) { return __hip_atomic_fetch_add(p, v, __ATOMIC_RELAXED, __HIP_MEMORY_SCOPE_AGENT); }
__device__ __forceinline__ unsigned xb_xcc_id() { return (unsigned)__builtin_amdgcn_s_getreg((3 << 11) | 20) & 0xFu; }
#define XB_SPIN(cond, bar) do { unsigned _sp = 0; while (cond) { __builtin_amdgcn_s_sleep(1); \
    if ((++_sp & 255u) == 0u) { if (xb_ld(&(bar)[XB_TMO])) break; if (_sp > XB_SPIN_CAP) { atomicAdd(&(bar)[XB_TMO], 1u); break; } } } } while (0)
struct XcdBarrier { unsigned* bar; unsigned x; volatile LAS unsigned* st; };
__device__ __forceinline__ XcdBarrier xcd_barrier_post(unsigned* bar, volatile LAS unsigned* st) {
    XcdBarrier b; b.bar = bar; b.x = xb_xcc_id(); b.st = st;
    if (threadIdx.x == 0) (void)xb_add(&bar[XB_XCNT(b.x)], 1u);
    return b;
}
__device__ __forceinline__ void xcd_barrier_complete(unsigned* bar, unsigned x, unsigned& nloc, unsigned& nx) {
    const unsigned G = gridDim.x * gridDim.y * gridDim.z;
    unsigned sum, cnt, mine, sp = 0u;
    for (;;) {
        sum = 0u; cnt = 0u; mine = 0u;
#pragma unroll
        for (unsigned j = 0; j < 16; ++j) { const unsigned c = xb_ld(&bar[XB_XCNT(j)]); sum += c; cnt += (c > 0u) ? 1u : 0u; mine = (j == x) ? c : mine; }
        if (sum == G) break;
        __builtin_amdgcn_s_sleep(1);
        if ((++sp & 255u) == 0u) { if (xb_ld(&bar[XB_TMO])) break; if (sp > XB_SPIN_CAP) { atomicAdd(&bar[XB_TMO], 1u); break; } }
    }
    nloc = mine > 0u ? mine : 1u; nx = cnt > 0u ? cnt : 1u;
}
__device__ __forceinline__ void xcd_barrier(const XcdBarrier& b) {
    asm volatile("s_waitcnt vmcnt(0)" ::: "memory");
    __syncthreads();
    if (threadIdx.x == 0) {
        unsigned* bar = b.bar;
        __builtin_amdgcn_s_waitcnt(0);
        unsigned nloc = b.st[0], nx = b.st[1];
        if (nloc == 0u) { xcd_barrier_complete(bar, b.x, nloc, nx); b.st[0] = nloc; b.st[1] = nx; }
        asm volatile("buffer_inv sc1" ::: "memory");
        const unsigned old = xb_add(&bar[XB_XSUB(b.x)], 1u);
        const unsigned gen = old / nloc;
        if (old + 1u == (gen + 1u) * nloc) {
            __builtin_amdgcn_fence(__ATOMIC_RELEASE, "agent");
            asm volatile("s_waitcnt vmcnt(0)" ::: "memory");
            const unsigned og = xb_add(&bar[XB_TOP], 1u);
            const unsigned tg = og / nx;
            if (og + 1u == (tg + 1u) * nx) xb_add(&bar[XB_TOPGEN], 1u);
            else XB_SPIN(xb_ld(&bar[XB_TOPGEN]) == tg, bar);
            asm volatile("" ::: "memory");
            xb_add(&bar[XB_XGEN(b.x)], 1u);
            asm volatile("s_waitcnt vmcnt(0)" ::: "memory");
        } else {
            XB_SPIN(xb_ld(&bar[XB_XGEN(b.x)]) == gen, bar);
            asm volatile("s_waitcnt vmcnt(0)" ::: "memory");
        }
    }
    __syncthreads();
}

__device__ __forceinline__ unsigned f2bf(float f) { unsigned u = __builtin_bit_cast(unsigned, f); return (u + 0x7fffu + ((u >> 16) & 1u)) >> 16; }
__device__ __forceinline__ unsigned pk2(float lo, float hi) { return f2bf(lo) | (f2bf(hi) << 16); }
__device__ __forceinline__ int perm32_inv(int s) { return 16 * ((s >> 2) & 1) + 4 * (s >> 3) + (s & 3); }
__device__ __forceinline__ int rowmap(int kind, int c) {
    if (kind == 0) {
        const int pn = c >> 8, wc = (c >> 6) & 3, bj = (c >> 5) & 1, low = c & 31;
        if (c < NQKV) return 256 * pn + 128 * bj + 32 * wc + low;
        return 256 * pn + 128 * bj + 32 * wc + perm32_inv(low);
    }
    if (kind == 1) { const int pn = c >> 8, wc = (c >> 6) & 3, bj = (c >> 5) & 1, low = c & 31; return 256 * pn + 128 * bj + 32 * wc + perm32_inv(low); }
    if (kind == 3) { const int half = c >= DFF ? 1 : 0, cc = c - DFF * half, pn = cc >> 7, q = cc & 127; return 256 * pn + 128 * half + (q & ~31) + perm32_inv(q & 31); }
    if (kind == 4) { const int pn = c >> 8, wc = (c >> 6) & 3, bj = (c >> 5) & 1, low = c & 31; return 256 * pn + 128 * bj + 32 * wc + low; }
    return c;
}
__device__ __forceinline__ void p0_transpose_item(const float* W, int N, const float* scale, bf16_t* WT, int ldk, int koff, int kind, LAS float* scr, int item, int lane) {
    const int nblk = N / 32, kb = item / nblk, nb = item % nblk, k0 = 64 * kb, n0 = 32 * nb;
    float wv[32];
#pragma unroll
    for (int i = 0; i < 32; ++i) wv[i] = __builtin_nontemporal_load(&W[(size_t)(k0 + 2 * i + (lane >> 5)) * N + n0 + (lane & 31)]);
    if (scale) {
#pragma unroll
        for (int i = 0; i < 32; ++i) wv[i] *= scale[k0 + 2 * i + (lane >> 5)];
    }
#pragma unroll
    for (int i = 0; i < 32; ++i) scr[(2 * i + (lane >> 5)) * 33 + (lane & 31)] = wv[i];
    asm volatile("s_waitcnt lgkmcnt(0)" ::: "memory");
    const int c = lane & 7;
#pragma unroll
    for (int j = 0; j < 4; ++j) { const int n = (lane >> 3) + 8 * j; const LAS float* s = scr + (8 * c) * 33 + n;
        u32x4 o; o.x = pk2(s[0 * 33], s[1 * 33]); o.y = pk2(s[2 * 33], s[3 * 33]); o.z = pk2(s[4 * 33], s[5 * 33]); o.w = pk2(s[6 * 33], s[7 * 33]);
        *(u32x4*)(WT + (size_t)rowmap(kind, n0 + n) * ldk + koff + k0 + 8 * c) = o; }
    asm volatile("s_waitcnt lgkmcnt(0)" ::: "memory");
}

struct Args { const float* in[13]; float* out; unsigned char* ws; int ph_lo, ph_hi, li, pad; };
constexpr int NPHASE = 1 + 8 * DEPTH;

__device__ __forceinline__ void convert_weights(const Args& args, int l, LAS unsigned char* lds, int gw, int NGW, int wave, int lane) {
    unsigned char* ws = args.ws;
    LAS float* scr = (LAS float*)(lds + wave * 16384);
    const float* w_in = args.in[3] + (size_t)l * DM * INW; const float* n1 = args.in[2] + l * DM;
    const float* pa = args.in[6] + (size_t)l * 256 * DM; const float* pb = args.in[7] + (size_t)l * 512 * DM; const float* pc = args.in[8] + (size_t)l * 512 * DM;
    const float* w_o = args.in[9] + (size_t)l * DM * DM; const float* n2 = args.in[10] + l * DM;
    const float* w_up = args.in[11] + (size_t)l * DM * 2 * DFF; const float* w_dn = args.in[12] + (size_t)l * DFF * DM;
    constexpr int I_IN = (DM / 64) * (INW / 32), I_PA = (256 / 64) * (DM / 32), I_PB = (512 / 64) * (DM / 32), I_O = (DM / 64) * (DM / 32), I_UP = (DM / 64) * (2 * DFF / 32), I_DN = (DFF / 64) * (DM / 32);
    constexpr int NITEMS = I_IN + I_PA + 2 * I_PB + I_O + I_UP + I_DN;
    for (int it = gw; it < NITEMS; it += NGW) {
        int r = it;
        if (r < I_IN) { p0_transpose_item(w_in, INW, n1, (bf16_t*)(ws + WS_WIN), DM, 0, 0, scr, r, lane); continue; } r -= I_IN;
        if (r < I_PA) { p0_transpose_item(pa, DM, nullptr, (bf16_t*)(ws + WS_PCAT), OP, 0, 1, scr, r, lane); continue; } r -= I_PA;
        if (r < I_PB) { p0_transpose_item(pb, DM, nullptr, (bf16_t*)(ws + WS_PCAT), OP, 256, 1, scr, r, lane); continue; } r -= I_PB;
        if (r < I_PB) { p0_transpose_item(pc, DM, nullptr, (bf16_t*)(ws + WS_PCAT), OP, 768, 1, scr, r, lane); continue; } r -= I_PB;
        if (r < I_O) { p0_transpose_item(w_o, DM, nullptr, (bf16_t*)(ws + WS_WO), DM, 0, 4, scr, r, lane); continue; } r -= I_O;
        if (r < I_UP) { p0_transpose_item(w_up, 2 * DFF, n2, (bf16_t*)(ws + WS_WUP), DM, 0, 3, scr, r, lane); continue; } r -= I_UP;
        p0_transpose_item(w_dn, DM, nullptr, (bf16_t*)(ws + WS_WDN), DFF, 0, 4, scr, r, lane);
    }
}

struct MergeA {
    const bf16_t* Z; bf16_t* OB; const float* LSE; int gw, NGW, lane;
    __device__ __forceinline__ void operator()() const {
#pragma unroll 1
        for (int t2 = 4 * gw; t2 < MTOK / 2; t2 += 4 * NGW) {
            u32x4 a[4], b[4], c[4]; float l0[4], l1[4], l2[4];
            const int q = lane & 31, h = q >> 3;
#pragma unroll
            for (int k = 0; k < 4; ++k) { const int tok = 2 * (t2 + k) + (lane >> 5);
                const float* ls = LSE + (size_t)tok * 12 + h; l0[k] = ls[0]; l1[k] = ls[4]; l2[k] = ls[8];
                const bf16_t* zr = Z + (size_t)tok * ZP + ZQA + 8 * q; a[k] = __builtin_nontemporal_load((const u32x4*)zr); b[k] = __builtin_nontemporal_load((const u32x4*)(zr + 256)); c[k] = __builtin_nontemporal_load((const u32x4*)(zr + 512)); }
#pragma unroll
            for (int k = 0; k < 4; ++k) { const int tok = 2 * (t2 + k) + (lane >> 5);
                const float mx = fmaxf(l0[k], fmaxf(l1[k], l2[k])); float w0 = fast_exp2((l0[k] - mx) * LOG2E), w1 = fast_exp2((l1[k] - mx) * LOG2E), w2 = fast_exp2((l2[k] - mx) * LOG2E);
                const float inv = fast_rcp(w0 + w1 + w2); w0 *= inv; w1 *= inv; w2 *= inv;
                u32x4 o;
                o.x = cvt_pk_bf16(w0 * bf_lo(a[k].x) + w1 * bf_lo(b[k].x) + w2 * bf_lo(c[k].x), w0 * bf_hi(a[k].x) + w1 * bf_hi(b[k].x) + w2 * bf_hi(c[k].x));
                o.y = cvt_pk_bf16(w0 * bf_lo(a[k].y) + w1 * bf_lo(b[k].y) + w2 * bf_lo(c[k].y), w0 * bf_hi(a[k].y) + w1 * bf_hi(b[k].y) + w2 * bf_hi(c[k].y));
                o.z = cvt_pk_bf16(w0 * bf_lo(a[k].z) + w1 * bf_lo(b[k].z) + w2 * bf_lo(c[k].z), w0 * bf_hi(a[k].z) + w1 * bf_hi(b[k].z) + w2 * bf_hi(c[k].z));
                o.w = cvt_pk_bf16(w0 * bf_lo(a[k].w) + w1 * bf_lo(b[k].w) + w2 * bf_lo(c[k].w), w0 * bf_hi(a[k].w) + w1 * bf_hi(b[k].w) + w2 * bf_hi(c[k].w));
                *(u32x4*)(OB + (size_t)tok * OP + 8 * q) = o; }
        }
    }
};
__device__ __forceinline__ float block_max8(float v, LAS float* scr, int tid) {
#pragma unroll
    for (int o = 1; o < 64; o <<= 1) v = fmaxf(v, shx(v, o));
    if ((tid & 63) == 0) scr[tid >> 6] = v;
    __syncthreads();
    float r = scr[0];
#pragma unroll
    for (int i = 1; i < 8; ++i) r = fmaxf(r, scr[i]);
    __syncthreads();
    return r;
}
#ifndef ATT_DO_A
#define ATT_DO_A 1
#endif
#ifndef ATT_DO_B
#define ATT_DO_B 1
#endif
#ifndef ATT_DO_C
#define ATT_DO_C 1
#endif
#ifndef TIME_G3
#define TIME_G3 1
#endif
#ifndef TIME_A
#define TIME_A 1
#endif
#ifndef TIME_G1A
#define TIME_G1A 1
#endif
#ifndef TIME_G1B
#define TIME_G1B 1
#endif
#ifndef TIME_G2
#define TIME_G2 1
#endif
#ifndef TIME_G4
#define TIME_G4 1
#endif
#ifndef TIME_C
#define TIME_C 1
#endif
#ifndef TIME_B
#define TIME_B 1
#endif
#ifndef PHMASK
#define PHMASK 0x1FF
#endif
#define PHON(j) (((PHMASK) >> (j)) & 1)
#define OPAQUE_S(x) asm volatile("" : "+s"(x))
#define OPAQUE_V(x) asm volatile("" : "+v"(x))
__global__ void __launch_bounds__(512, 2) fwd_megakernel(Args args) {
    extern __shared__ __attribute__((aligned(16))) unsigned char lds_raw[];
    LAS unsigned char* lds = (LAS unsigned char*)lds_raw;
    volatile LAS unsigned* MISC = (volatile LAS unsigned*)(lds + MISC_OFF);
    const int G = gridDim.x; const int bx = blockIdx.x;
    { const int tid0 = threadIdx.x; for (int u = tid0; u < (STG_OFF - LDSCTL_OFF) / 4; u += 512) ((LAS unsigned*)(lds + LDSCTL_OFF))[u] = 0u; }
    __syncthreads();
    const int lo = args.ph_lo, hi = args.ph_hi;
    const bool multi = (hi - lo) > 1;
    XcdBarrier bar; bar.bar = (unsigned*)(args.ws + WS_CTL) + CW_BAR + args.li * XCD_BAR_WORDS; bar.x = 0; bar.st = nullptr;
    if (multi) bar = xcd_barrier_post((unsigned*)(args.ws + WS_CTL) + CW_BAR + args.li * XCD_BAR_WORDS, MISC + 8);
#define IN(k) (lo <= (k) && (k) < hi)
#define SEAM(k) do { if (IN(k) && IN((k) + 1)) xcd_barrier(bar); } while (0)
#define PHASE_LOCALS() unsigned zoff_ = 0u; OPAQUE_S(zoff_); unsigned char* ws = args.ws + zoff_; int tid = threadIdx.x; OPAQUE_V(tid); const int lane = tid & 63, wave = __builtin_amdgcn_readfirstlane(tid >> 6); \
    const int vcu = (G % 8 == 0) ? (bx % 8) * (G / 8) + bx / 8 : bx; const int gw = vcu * 8 + wave, NGW = G * 8; (void)lane; (void)gw; (void)NGW; (void)vcu

    if (PHON(0) && IN(0)) {
        PHASE_LOCALS();
        convert_weights(args, 0, lds, gw, NGW, wave, lane);
        float* ssq = (float*)(ws + WS_SSQ); bf16_t* XB0 = (bf16_t*)(ws + WS_XB0); const float* xin0 = args.in[0];
#pragma unroll 1
        for (int m0 = 4 * gw; m0 < MTOK; m0 += 4 * NGW) {
            f32x4 v[4][4];
#pragma unroll
            for (int rr = 0; rr < 4; ++rr) { const f32x4* xr = (const f32x4*)(xin0 + (size_t)(m0 + rr) * DM) + lane;
#pragma unroll
                for (int j = 0; j < 4; ++j) v[rr][j] = __builtin_nontemporal_load(&xr[64 * j]); }
#pragma unroll
            for (int rr = 0; rr < 4; ++rr) { float s = 0.f;
#pragma unroll
                for (int j = 0; j < 4; ++j) s += (v[rr][j].x * v[rr][j].x + v[rr][j].y * v[rr][j].y) + (v[rr][j].z * v[rr][j].z + v[rr][j].w * v[rr][j].w);
#pragma unroll
                for (int o = 1; o < 64; o <<= 1) s += shx(s, o);
                u32x2* o8 = (u32x2*)(XB0 + (size_t)(m0 + rr) * DM) + lane;
#pragma unroll
                for (int j = 0; j < 4; ++j) { u32x2 w; w.x = cvt_pk_bf16(v[rr][j].x, v[rr][j].y); w.y = cvt_pk_bf16(v[rr][j].z, v[rr][j].w); o8[64 * j] = w; }
                if (lane < 16) ssq[(size_t)(m0 + rr) * 16 + lane] = (lane == 0) ? s : 0.f; }
        }
    }
    SEAM(0);

#pragma unroll 1
    for (int l = 0; l < DEPTH; ++l) {
        const int pb = 1 + 8 * l;
        if (PHON(0) && IN(pb)) { if (l > 0) { PHASE_LOCALS(); (void)ws; convert_weights(args, l, lds, gw, NGW, wave, lane); } }
        if (l > 0) SEAM(pb);
        if (PHON(1) && IN(pb + 1)) {
            PHASE_LOCALS();
            const pg8::Order<1> S = pg8::make_order<1>((l == 0) ? (const bf16_t*)(ws + WS_XB0) : (const bf16_t*)args.out, DM, (const bf16_t*)(ws + WS_WIN), DM, MTOK, NQKV, DM, G, bx);
            EpiQKV E{(bf16_t*)(ws + WS_BIG), (const float*)(ws + WS_SSQ), args.in[4] + l * 6 * 64};
            for (int rep = 0; rep < TIME_G1A; ++rep) {
                const int fullr = S.nwg / G, tailn = S.nwg - fullr * G;
                if (2 * tailn == G) { pg8::Order<1> S2 = S; S2.maxr = fullr;
                    pg8::Unit tu; S.tile_of(fullr * G + (bx % tailn), tu);
                    pg8::gemm_phase(lds, S2, DM, DM, E, S.A + (size_t)tu.pm * S.tstepA + (size_t)(bx / tailn) * 128 * DM * 2, S.Bt + (size_t)tu.pn * S.tstepB);
                    pg8::gemm_half_phase(lds, S, fullr * G + (bx % tailn), bx / tailn, DM, DM, E, true); }
                else pg8::gemm_phase(lds, S, DM, DM, E); }
        }
        SEAM(pb + 1);
        if (PHON(2) && IN(pb + 2)) {
            PHASE_LOCALS();
            bf16_t* Z = (bf16_t*)(ws + WS_BIG); bf16_t* OB = (bf16_t*)(ws + WS_OBUF); float* LSE = (float*)(ws + WS_LSE);
            LAS char* shm = (LAS char*)lds;
            float BrefA, BrefB, BrefC;
            LAS float* mxscr = (LAS float*)(shm + att::LDS_TAB + 4096);
            { const float* gq = args.in[4] + l * 6 * 64;
              if (tid < 64) { float v[6];
#pragma unroll
                  for (int t = 0; t < 6; ++t) v[t] = fabsf(gq[t * 64 + tid]);
#pragma unroll
                  for (int o = 1; o < 64; o <<= 1)
#pragma unroll
                      for (int t = 0; t < 6; ++t) v[t] = fmaxf(v[t], shx(v[t], o));
                  if (tid == 0) {
#pragma unroll
                      for (int t = 0; t < 6; ++t) mxscr[8 + t] = v[t]; } }
              __syncthreads();
              BrefA = 64.0f * mxscr[8] * mxscr[9] * C2 * 1.02f; BrefB = 64.0f * mxscr[10] * mxscr[11] * C2 * 1.02f; BrefC = 64.0f * mxscr[12] * mxscr[13] * C2 * 1.02f; }
#pragma unroll 1
            for (int i = 0; i < 2 * TIME_C * ATT_DO_C; ++i) { const int id = vcu * 2 + (i & 1); const int bh = id >> 5; const int b = bh >> 3, h = bh & 7, qb = id & 31;
                const bf16_t* Qw = Z + (size_t)(b * SEQ + qb * 256 + wave * 32) * ZP + ZQC + 64 * h;
                const bf16_t* Kh = Z + (size_t)(b * SEQ) * ZP + ZKC + 64 * (h >> 2); const bf16_t* Vh = Z + (size_t)(b * SEQ) * ZP + ZVC + 64 * (h >> 2);
                bf16_t* Ow = OB + (size_t)(b * SEQ + qb * 256 + wave * 32) * OP + 768 + 64 * h;
                attp::attn_unit<8, ZP, OP, true>((const attp::bf16*)Qw, (const attp::bf16*)Kh, (const attp::bf16*)Vh, (attp::bf16*)Ow, SEQ / 64, BrefC, shm); }
            LAS float* tab = (LAS float*)(shm + att::LDS_TAB);
            const float* rpb = args.in[5] + (size_t)l * 8 * 15 * 31;
            for (int rep = 0; rep < TIME_B * ATT_DO_B; ++rep) { const int idb = vcu;
                const int hB = (idb >> 4) & 7;
                LAS float* tabB = (LAS float*)(shm + att::B2_TAB);
                float bmx = 0.f;
                for (int e = tid; e < 16 * 128; e += 512) { const int dr = e >> 7, dc = (e & 127) - 48; const float tv = dr == 15 ? NEGBIG : ((dc >= 0 && dc <= 30) ? rpb[hB * 465 + dr * 31 + dc] * LOG2E : 0.f); tabB[e] = tv; if (dr != 15) bmx = fmaxf(bmx, tv); }
                const float BrefBu = BrefB + block_max8(bmx, mxscr, tid);
                att::unit_b8(Z, OB, tabB, (idb >> 7) & 1, hB, 8 * (idb & 15), BrefBu, shm); }
            const float* rbt = args.in[1];
            { const float bv = (tid < 32 * 12) ? fabsf(rbt[tid]) * LOG2E : 0.f; BrefA += block_max8(bv, mxscr, tid); }
#define MK_POLA(ii, PA) const int ida_##PA = vcu * 3 + ((ii) % 3); const int bgh_##PA = ida_##PA >> 5, sub_##PA = ida_##PA & 31; const int g_##PA = (bgh_##PA % 12) >> 2; \
            const int rate_##PA = g_##PA == 0 ? 1 : (g_##PA == 1 ? 4 : 16); const int rho_##PA = g_##PA == 0 ? 0 : (g_##PA == 1 ? (sub_##PA >> 3) : (sub_##PA >> 1)); const int u_##PA = g_##PA == 0 ? sub_##PA : (g_##PA == 1 ? (sub_##PA & 7) : (sub_##PA & 1)); \
            const att::PolA PA{Z, LSE, tab, bgh_##PA / 12, g_##PA, bgh_##PA & 3, rate_##PA, rho_##PA, u_##PA, (SEQ / rate_##PA) / 64, (ii) >= 3}
            int tab_gh = -1;
#pragma unroll 1
            for (int i = 3 * (TIME_A - 1); i >= 0 && i < 3 * TIME_A * ATT_DO_A; i = (i == 5 ? 0 : (i == 2 ? 99 : i + 1))) { MK_POLA(i, Pc); MK_POLA((i % 3) + 1 < 3 ? i + 1 : i, Pn);
                if (Pc.g * 4 + Pc.h != tab_gh) { tab_gh = Pc.g * 4 + Pc.h;
                    if (tid < 255) { const int d = tid - 127; tab[tid] = (d >= -64 && d <= 64) ? rbt[att::t5_bucket(d * Pc.rate) * 12 + Pc.g * 4 + Pc.h] * LOG2E : NEGBIG; } }
                att::unit_simple<att::PolA>(Pc, (i % 3) > 0, Pn, (i % 3) + 1 < 3, BrefA, shm); }
#undef MK_POLA
        }
        SEAM(pb + 2);
        if (PHON(3) && IN(pb + 3)) {
            PHASE_LOCALS();
            const MergeA mrg{(const bf16_t*)(ws + WS_BIG), (bf16_t*)(ws + WS_OBUF), (const float*)(ws + WS_LSE), gw, NGW, lane};
            const pg8::Order<1> S = pg8::make_order<1>((l == 0) ? (const bf16_t*)(ws + WS_XB0) : (const bf16_t*)args.out, DM, (const bf16_t*)(ws + WS_WIN) + (size_t)NQKV * DM, DM, MTOK, NGATE, DM, G, bx);
            EpiGate E{(bf16_t*)(ws + WS_BIG) + ZGATE, (const float*)(ws + WS_SSQ)};
            for (int rep = 0; rep < TIME_G1B; ++rep) pg8::gemm_phase(lds, S, DM, DM, E, nullptr, nullptr, mrg);
        }
        SEAM(pb + 3);
        if (PHON(4) && IN(pb + 4)) {
            PHASE_LOCALS();
            const pg8::Order<3> S = pg8::make_order<3>((const bf16_t*)(ws + WS_OBUF), OP, (const bf16_t*)(ws + WS_PCAT), OP, MTOK, DM, 256, G, bx);
            EpiBranch E{(const bf16_t*)(ws + WS_BIG) + ZGATE, (bf16_t*)(ws + WS_XB0)};
            for (int rep = 0; rep < TIME_G2; ++rep) pg8::gemm_phase(lds, S, OP, OP, E);
        }
        SEAM(pb + 4);
        if (PHON(5) && IN(pb + 5)) {
            PHASE_LOCALS();
            const pg8::Order<1> S = pg8::make_order<1>((const bf16_t*)(ws + WS_XB0), DM, (const bf16_t*)(ws + WS_WO), DM, MTOK, DM, DM, G, bx);
            if (l == 0) { EpiRes<true, false> E{(const void*)args.in[0], nullptr, (bf16_t*)(ws + WS_OBUF), (float*)(ws + WS_SSQ)}; pg8::gemm_phase(lds, S, DM, DM, E); }
            else { EpiRes<false, false> E{(const void*)args.out, nullptr, (bf16_t*)(ws + WS_OBUF), (float*)(ws + WS_SSQ)}; pg8::gemm_phase(lds, S, DM, DM, E); }
        }
        SEAM(pb + 5);
        if (PHON(6) && IN(pb + 6)) {
            PHASE_LOCALS();
            const pg8::Order<1> S = pg8::make_order<1>((const bf16_t*)(ws + WS_OBUF), DM, (const bf16_t*)(ws + WS_WUP), DM, MTOK, 2 * DFF, DM, G, bx);
            EpiSwiglu E{(bf16_t*)(ws + WS_BIG), (const float*)(ws + WS_SSQ)};
            for (int rep = 0; rep < TIME_G4; ++rep) {
                const int fullr = S.nwg / G, tailn = S.nwg - fullr * G;
                if (2 * tailn == G) { pg8::Order<1> S2 = S; S2.maxr = fullr;
                    pg8::Unit tu; S.tile_of(fullr * G + (bx % tailn), tu);
                    pg8::gemm_phase(lds, S2, DM, DM, E, S.A + (size_t)tu.pm * S.tstepA + (size_t)(bx / tailn) * 128 * DM * 2, S.Bt + (size_t)tu.pn * S.tstepB);
                    pg8::gemm_half_phase(lds, S, fullr * G + (bx % tailn), bx / tailn, DM, DM, E, true); }
                else pg8::gemm_phase(lds, S, DM, DM, E); }
        }
        SEAM(pb + 6);
        if (PHON(7) && IN(pb + 7)) {
            PHASE_LOCALS();
            const pg8::Order<1> S = pg8::make_order<1>((const bf16_t*)(ws + WS_BIG), DFF, (const bf16_t*)(ws + WS_WDN), DFF, MTOK, DM, DFF, G, bx);
            if (l + 1 < DEPTH) { EpiRes<false, false> E{(const void*)(ws + WS_OBUF), nullptr, (bf16_t*)args.out, (float*)(ws + WS_SSQ)}; pg8::gemm_phase(lds, S, DFF, DFF, E); }
            else { EpiRes<false, true> E{(const void*)(ws + WS_OBUF), args.out, nullptr, (float*)(ws + WS_SSQ)}; pg8::gemm_phase(lds, S, DFF, DFF, E); }
        }
        SEAM(pb + 7);
    }
#undef IN
#undef SEAM
}

#ifndef MK_PER_PHASE
#define MK_PER_PHASE 0
#endif
extern "C" void kernel_launch(void* const* d_in, const int* in_sizes, int n_in, void* d_out, int out_size, void* d_ws, size_t ws_size, hipStream_t stream) {
    static int grid = 0;
    if (grid == 0) {
        if (n_in != 13 || out_size != MTOK * DM || ws_size < WS_END) { fprintf(stderr, "kernel_launch: unexpected shapes (n_in %d, out %d, ws %zu)\n", n_in, out_size, ws_size); grid = -1; return; }
        int dev = 0, cus = 0, per_cu = 0;
        if (hipGetDevice(&dev) != hipSuccess || hipDeviceGetAttribute(&cus, hipDeviceAttributeMultiprocessorCount, dev) != hipSuccess) { grid = -1; return; }
        if (hipFuncSetAttribute((const void*)fwd_megakernel, hipFuncAttributeMaxDynamicSharedMemorySize, LDS_BYTES) != hipSuccess) { fprintf(stderr, "kernel_launch: hipFuncSetAttribute failed\n"); grid = -1; return; }
        if (hipOccupancyMaxActiveBlocksPerMultiprocessor(&per_cu, (const void*)fwd_megakernel, 512, LDS_BYTES) != hipSuccess || per_cu < 1) { fprintf(stderr, "kernel_launch: occupancy query says %d blocks per CU\n", per_cu); grid = -1; (void)hipGetLastError(); return; }
        (void)hipGetLastError();
        grid = cus;
        if (grid != 256) fprintf(stderr, "kernel_launch: %d CUs (built for 256)\n", grid);
    }
    if (grid < 0) return;
    if (hipMemsetAsync((char*)d_ws + WS_CTL, 0, CTL_ZERO_BYTES, stream) != hipSuccess) return;
    Args a{};
    for (int i = 0; i < 13; ++i) a.in[i] = (const float*)d_in[i];
    a.out = (float*)d_out; a.ws = (unsigned char*)d_ws;
#if MK_PER_PHASE
    for (int p = 0; p < NPHASE; ++p) { a.ph_lo = p; a.ph_hi = p + 1; a.li = 0; hipLaunchKernelGGL(fwd_megakernel, dim3(grid), dim3(512), LDS_BYTES, stream, a); }
#else
    a.ph_lo = 0; a.ph_hi = NPHASE; a.li = 0;
    hipLaunchKernelGGL(fwd_megakernel, dim3(grid), dim3(512), LDS_BYTES, stream, a);
#endif
}
```

```cpp
#include <hip/hip_runtime.h>
#include <hip/hip_bf16.h>
#include <cstdio>
#include <cstdint>

#define LAS __attribute__((address_space(3)))
#define GAS __attribute__((address_space(1)))
typedef unsigned short bf16_t;
typedef short bf16x8 __attribute__((ext_vector_type(8)));
typedef short s16x4 __attribute__((ext_vector_type(4)));
typedef float f32x4 __attribute__((ext_vector_type(4)));
typedef float f32x2 __attribute__((ext_vector_type(2)));
typedef float f32x16 __attribute__((ext_vector_type(16)));
typedef unsigned u32x4 __attribute__((ext_vector_type(4)));
typedef unsigned u32x2 __attribute__((ext_vector_type(2)));

constexpr int BATCH = 2, SEQ = 8192, MTOK = BATCH * SEQ, DM = 1024, DEPTH = 2;
constexpr int ZP = 4608;
constexpr int ZQA = 0, ZKA = 768, ZVA = 1536, ZQB = 2304, ZKB = 2816, ZVB = 3328, ZQC = 3840, ZKC = 4352, ZVC = 4480;
constexpr int ZSL = 64;
constexpr size_t ZGOFF = (size_t)12 * 16384 * 64;
constexpr int ZGP = 3072;
constexpr int ZGATE = 768;
constexpr int INW = 7680, NQKV = 4608, NGATE = 3072;
constexpr int OP = 1280;
constexpr int DFF = 2816;
constexpr float RMS_EPS = 1e-6f;
constexpr float LOG2E = 1.4426950408889634f;
constexpr float C2 = 0.125f * LOG2E;
constexpr float NEGBIG = -1e30f;

constexpr size_t MiB = 1u << 20;
constexpr size_t WS_CTL = 0, CTL_ZERO_BYTES = 64 * 1024;
constexpr size_t WS_SSQ = 1 * MiB;
constexpr size_t WS_WIN = 2 * MiB;
constexpr size_t WS_PCAT = 17 * MiB;
constexpr size_t WS_WO = WS_PCAT + 1024 * 1280 * 2;
constexpr size_t WS_WUP = WS_WO + 2 * MiB;
constexpr size_t WS_WDN = WS_WUP + 11 * MiB;
constexpr size_t WS_XB0 = 38 * MiB;
constexpr size_t WS_BIG = 70 * MiB;
constexpr size_t WS_OBUF = 214 * MiB;
constexpr size_t WS_LSE = 254 * MiB;
constexpr size_t WS_END = 256 * MiB;
static_assert(WS_WDN + (size_t)1024 * 2816 * 2 <= WS_XB0, "weights fit");
constexpr int CW_BAR = 4096;

constexpr int RING_BYTES = 131072;
constexpr int LDSCTL_OFF = RING_BYTES, MISC_OFF = LDSCTL_OFF + 320;
constexpr int STG_OFF = 132096, STG_ROW = 144, STG_WAVE = 16 * STG_ROW;
constexpr int RSTAB_OFF = STG_OFF + 8 * STG_WAVE;
constexpr int LDS_BYTES = 151552;
static_assert(MISC_OFF + 128 <= STG_OFF && RSTAB_OFF + 1024 <= LDS_BYTES, "LDS map");

typedef __bf16 bf16x2_t __attribute__((ext_vector_type(2)));
__device__ __forceinline__ unsigned cvt_pk_bf16(float lo, float hi) { f32x2 v = {lo, hi}; bf16x2_t b = __builtin_convertvector(v, bf16x2_t); return __builtin_bit_cast(unsigned, b); }
__device__ __forceinline__ float bf_lo(unsigned u) { return __uint_as_float(u << 16); }
__device__ __forceinline__ float bf_hi(unsigned u) { return __uint_as_float(u & 0xffff0000u); }
__device__ __forceinline__ float fast_exp2(float x) { return __builtin_amdgcn_exp2f(x); }
__device__ __forceinline__ float fast_rcp(float x) { return __builtin_amdgcn_rcpf(x); }
__device__ __forceinline__ float sigmoidf_(float x) { return fast_rcp(1.0f + fast_exp2(-x * LOG2E)); }

struct RsFill { f32x4 a, b, c, d; };
__device__ __forceinline__ void rs_fill_issue(RsFill& f, const float* ssq, int row0, int nrows, int tid) {
    if (tid < nrows) { const f32x4* p = (const f32x4*)(ssq + (size_t)(row0 + tid) * 16); f.a = p[0]; f.b = p[1]; f.c = p[2]; f.d = p[3]; }
}
__device__ __forceinline__ void rs_fill_finish(const RsFill& f, LAS float* tab, int nrows, int tid) {
    if (tid < nrows) { const float sm = ((f.a.x + f.a.y) + (f.a.z + f.a.w)) + ((f.b.x + f.b.y) + (f.b.z + f.b.w)) + ((f.c.x + f.c.y) + (f.c.z + f.c.w)) + ((f.d.x + f.d.y) + (f.d.z + f.d.w));
        tab[tid] = __builtin_amdgcn_rsqf(sm * (1.0f / 1024.0f) + RMS_EPS); }
}
__device__ __forceinline__ void fill_rs_table(LAS float* tab, const float* ssq, int row0, int nrows, int tid) { RsFill f; rs_fill_issue(f, ssq, row0, nrows, tid); rs_fill_finish(f, tab, nrows, tid); }
namespace pg8 {
constexpr int BM = 256, BK = 64, HALF = 128, HTB = HALF * BK * 2, STAGE_BYTES = 8 * HTB, NXCD = 8, WGM = 8;
__host__ __device__ __forceinline__ int lds_byte(int r, int c) { const int st = (r >> 4) * 2 + (c >> 5), rr = r & 15, cc = c & 31, ob = rr * 64 + cc * 2; return st * 1024 + (ob ^ (((ob >> 9) & 1) << 5)); }
__host__ __device__ __forceinline__ void stage_rc(int b, int& R, int& C) { const int st = b / 1024, sb = b % 1024, swz = sb ^ (((sb >> 9) & 1) << 5); R = (st >> 1) * 16 + swz / 64; C = (st & 1) * 32 + (swz % 64) / 2; }

struct Unit { int pm, pn, seg, rowoff, nai; };
template <int NSEG> struct Order {
    int nM, nN, nwg, G, c, ntk, maxr;
    const char* A; const char* Bt; size_t tstepA, tstepB;
    __device__ __forceinline__ void tile_of(int L, Unit& u) const {
        int wgid = L; { const int q = nwg / NXCD, r = nwg % NXCD, xcd = wgid % NXCD, off = wgid / NXCD; wgid = (xcd < r ? xcd * (q + 1) : r * (q + 1) + (xcd - r) * q) + off; }
        const int nig = WGM * nN, gid = wgid / nig, fm = gid * WGM, gsz = (nM - fm) < WGM ? (nM - fm) : WGM;
        u.pm = fm + ((wgid % nig) % gsz); u.pn = (wgid % nig) / gsz; u.rowoff = 0; u.nai = 2;
    }
    __device__ __forceinline__ bool next(int i, Unit& u) const {
        const int ti = i / NSEG; u.seg = i - ti * NSEG;
        if (ti >= maxr) return false;
        const long L = (long)ti * G + c; if (L >= nwg) return false;
        tile_of((int)L, u); return true;
    }
    static __device__ __forceinline__ int koff(int seg) { return NSEG == 1 ? 0 : (seg == 0 ? 0 : (seg == 1 ? 512 : 1536)); }
    __device__ __forceinline__ const char* aptr(const Unit& u) const { return A + (size_t)u.pm * tstepA + koff(u.seg); }
    __device__ __forceinline__ const char* bptr(const Unit& u) const { return Bt + (size_t)u.pn * tstepB + koff(u.seg); }
    __device__ __forceinline__ int nt(const Unit& u) const { return NSEG == 1 ? ntk : (u.seg == 0 ? 4 : 8); }
};
template <int NSEG> __device__ __forceinline__ Order<NSEG> make_order(const bf16_t* A, int lda, const bf16_t* Bt, int ldb, int M, int N, int K, int G, int c) {
    Order<NSEG> o; o.nM = M / BM; o.nN = N / BM; o.nwg = o.nM * o.nN; o.G = G; o.c = c; o.ntk = K / BK; o.maxr = 1 << 20;
    o.A = (const char*)A; o.Bt = (const char*)Bt; o.tstepA = (size_t)BM * lda * 2; o.tstepB = (size_t)BM * ldb * 2; return o;
}

struct NoPre { __device__ __forceinline__ void operator()() const {} };
template <class Epi, class Ord, class Pre = NoPre>
__device__ __forceinline__ void gemm_phase(LAS unsigned char* lds, const Ord S, const int lda, const int ldb, const Epi E, const char* tailA = nullptr, const char* tailB = nullptr, const Pre pre = Pre()) {
    int tid = threadIdx.x; asm volatile("" : "+v"(tid));
    const int wid = __builtin_amdgcn_readfirstlane(tid >> 6), lane = tid & 63, wr = wid >> 2, wc = wid & 3, fr = lane & 15, fq = lane >> 4;
    unsigned voffA[2], voffB[2];
#pragma unroll
    for (int i = 0; i < 2; ++i) { int R, C; stage_rc(tid * 16 + i * 8192, R, C); voffA[i] = (unsigned)(R * lda + C) * 2u; voffB[i] = (unsigned)(R * ldb + C) * 2u; }
    const size_t kstep = (size_t)(BK * 2);
    const size_t hstepA = (size_t)HALF * lda * 2, hstepB = (size_t)HALF * ldb * 2;
    const unsigned ldsw = (unsigned)wid * 1024u;
    const int aoff = lds_byte(wr * 64 + fr, fq * 8), boff = lds_byte(wc * 32 + fr, fq * 8);
#define PG8_SA(b, h) (((b) * 2 + (h)) * HTB)
#define PG8_SB(b, h) ((4 + (b) * 2 + (h)) * HTB)
#define PG8_STAGE(bufoff, gbase, voff) do { _Pragma("unroll") for (int _i = 0; _i < 2; ++_i) \
        __builtin_amdgcn_global_load_lds((const unsigned*)((const char*)(gbase) + (voff)[_i]), (LAS unsigned*)(lds + (bufoff) + ldsw + _i * 8192), 16, 0, 0); } while (0)
#define PG8_LDA(dst, b, h) do { _Pragma("unroll") for (int m = 0; m < 4; ++m) _Pragma("unroll") for (int k = 0; k < 2; ++k) dst[m][k] = *(const LAS bf16x8*)(lds + PG8_SA(b, h) + aoff + m * 2048 + k * 1024); } while (0)
#define PG8_LDB(dst, b, h) do { _Pragma("unroll") for (int n = 0; n < 2; ++n) _Pragma("unroll") for (int k = 0; k < 2; ++k) dst[n][k] = *(const LAS bf16x8*)(lds + PG8_SB(b, h) + boff + n * 2048 + k * 1024); } while (0)
#define PG8_MMA(ai, bj, At, Bt) do { __builtin_amdgcn_s_setprio(1); _Pragma("unroll") for (int m = 0; m < 4; ++m) _Pragma("unroll") for (int n = 0; n < 2; ++n) _Pragma("unroll") for (int k = 0; k < 2; ++k) \
        acc[ai][bj][m][n] = __builtin_amdgcn_mfma_f32_16x16x32_bf16(Bt[n][k], At[m][k], acc[ai][bj][m][n], 0, 0, 0); __builtin_amdgcn_s_setprio(0); } while (0)
#define PG8_WAIT_V(n) asm volatile("s_waitcnt vmcnt(" #n ")" ::: "memory")
#define PG8_WAIT_L(n) asm volatile("s_waitcnt lgkmcnt(" #n ")" ::: "memory")
#define PG8_BAR __builtin_amdgcn_s_barrier()
#define PG8_SCHED __builtin_amdgcn_sched_barrier(0)
    Unit cur, nxt; int ui = 0;
    if (!S.next(0, cur)) return;
    f32x4 acc[2][2][4][2];
#pragma unroll
    for (int a = 0; a < 2; ++a)
#pragma unroll
        for (int b = 0; b < 2; ++b)
#pragma unroll
            for (int m = 0; m < 4; ++m)
#pragma unroll
                for (int n = 0; n < 2; ++n) acc[a][b][m][n] = (f32x4){0.f, 0.f, 0.f, 0.f};
    bf16x8 At[4][2], B0[2][2], B1[2][2];
    const char* cA = S.aptr(cur); const char* cB = S.bptr(cur); int nt = S.nt(cur);
    RsFill rsf; if constexpr (Epi::NEEDS_RS) rs_fill_issue(rsf, E.ssq, cur.pm * 256, 256, tid);
    PG8_STAGE(PG8_SB(0, 0), cB, voffB); PG8_STAGE(PG8_SB(0, 1), cB + hstepB, voffB); PG8_STAGE(PG8_SA(0, 0), cA, voffA); PG8_STAGE(PG8_SA(0, 1), cA + hstepA, voffA);
    if constexpr (Epi::NEEDS_RS) rs_fill_finish(rsf, (LAS float*)(lds + RSTAB_OFF), 256, tid);
    pre();
    if (wr == 1) PG8_BAR;
    PG8_WAIT_V(2); PG8_BAR;
    PG8_STAGE(PG8_SB(1, 0), cB + kstep, voffB); PG8_STAGE(PG8_SA(1, 0), cA + kstep, voffA); PG8_STAGE(PG8_SB(1, 1), cB + hstepB + kstep, voffB);
    PG8_WAIT_V(6); PG8_BAR;
    for (;;) {
        const bool has_next = S.next(ui + 1, nxt);
        const char* nA = has_next ? S.aptr(nxt) : (tailA ? tailA : cA); const char* nB = has_next ? S.bptr(nxt) : (tailB ? tailB : cB);
        for (int t = 0; t < nt; t += 2) {
            const bool last = (t == nt - 2);
            unsigned tk = (unsigned)t * (unsigned)kstep; asm volatile("" : "+s"(tk));
            asm volatile("" : "+v"(voffA[0]), "+v"(voffA[1]), "+v"(voffB[0]), "+v"(voffB[1]));
            const char* a1 = cA + tk + kstep;
            const char* a2 = last ? nA : cA + tk + 2 * kstep; const char* b2 = last ? nB : cB + tk + 2 * kstep;
            const char* a3 = a2 + kstep; const char* b3 = b2 + kstep;
            PG8_LDB(B0, 0, 0); PG8_LDB(B1, 0, 1); PG8_SCHED; PG8_LDA(At, 0, 0); PG8_STAGE(PG8_SA(1, 1), a1 + hstepA, voffA);
            PG8_WAIT_V(8); PG8_WAIT_L(0); PG8_BAR; PG8_MMA(0, 0, At, B0); PG8_MMA(0, 1, At, B1); PG8_BAR; PG8_SCHED;
            PG8_LDA(At, 0, 1); PG8_STAGE(PG8_SB(0, 0), b2, voffB); PG8_STAGE(PG8_SB(0, 1), b2 + hstepB, voffB); PG8_STAGE(PG8_SA(0, 0), a2, voffA);
            PG8_WAIT_V(8); PG8_WAIT_L(0); PG8_BAR; PG8_MMA(1, 0, At, B0); PG8_MMA(1, 1, At, B1); PG8_BAR; PG8_SCHED;
            PG8_LDB(B0, 1, 0); PG8_LDB(B1, 1, 1); PG8_SCHED; PG8_LDA(At, 1, 0); PG8_STAGE(PG8_SA(0, 1), a2 + hstepA, voffA);
            PG8_WAIT_V(8); PG8_WAIT_L(0); PG8_BAR; PG8_MMA(0, 0, At, B0); PG8_MMA(0, 1, At, B1); PG8_BAR; PG8_SCHED;
            PG8_LDA(At, 1, 1); PG8_STAGE(PG8_SB(1, 0), b3, voffB); PG8_STAGE(PG8_SB(1, 1), b3 + hstepB, voffB); PG8_STAGE(PG8_SA(1, 0), a3, voffA);
            PG8_WAIT_V(8); PG8_WAIT_L(0); PG8_BAR; PG8_MMA(1, 0, At, B0); PG8_MMA(1, 1, At, B1); PG8_BAR; PG8_SCHED;
        }
        if (wr == 0) PG8_BAR;
        int fr_ = fr, fq_ = fq; asm volatile("" : "+v"(fr_), "+v"(fq_));
#if defined(EPI_REP)
        if (Epi::IDEMP == EPI_REP) { (void)E(acc, cur, wr, wc, fr_, fq_, lds + STG_OFF + wid * STG_WAVE); }
#endif
        const bool zero = E(acc, cur, wr, wc, fr_, fq_, lds + STG_OFF + wid * STG_WAVE);
        if (!has_next) break;
        if (zero) {
#pragma unroll
        for (int a = 0; a < 2; ++a)
#pragma unroll
            for (int b = 0; b < 2; ++b)
#pragma unroll
                for (int m = 0; m < 4; ++m)
#pragma unroll
                    for (int n = 0; n < 2; ++n) acc[a][b][m][n] = (f32x4){0.f, 0.f, 0.f, 0.f};
        }
        if constexpr (Epi::NEEDS_RS) { if (nxt.pm != cur.pm) {
            asm volatile("s_waitcnt lgkmcnt(0)" ::: "memory"); PG8_BAR; fill_rs_table((LAS float*)(lds + RSTAB_OFF), E.ssq, nxt.pm * 256, 256, tid); asm volatile("s_waitcnt lgkmcnt(0)" ::: "memory"); PG8_BAR; } }
        cur = nxt; cA = nA; cB = nB; nt = S.nt(cur); ++ui;
        if (wr == 1) PG8_BAR;
    }
    PG8_WAIT_V(0);
    PG8_BAR;
#undef PG8_SA
#undef PG8_SB
#undef PG8_STAGE
#undef PG8_LDA
#undef PG8_LDB
#undef PG8_MMA
#undef PG8_WAIT_V
#undef PG8_WAIT_L
#undef PG8_BAR
#undef PG8_SCHED
}

template <class Epi, class Ord>
__device__ __forceinline__ void gemm_half_phase(LAS unsigned char* lds, const Ord S, const int L, const int half, const int lda, const int ldb, const Epi E, const bool prestaged = false) {
    int tid = threadIdx.x; asm volatile("" : "+v"(tid));
    const int wid = __builtin_amdgcn_readfirstlane(tid >> 6), lane = tid & 63, wr = wid >> 2, wc = wid & 3, fr = lane & 15, fq = lane >> 4;
    unsigned voffA[2], voffB[2];
#pragma unroll
    for (int i = 0; i < 2; ++i) { int R, C; stage_rc(tid * 16 + i * 8192, R, C); voffA[i] = (unsigned)(R * lda + C) * 2u; voffB[i] = (unsigned)(R * ldb + C) * 2u; }
    const size_t kstep = (size_t)(BK * 2);
    const size_t hstepA = (size_t)HALF * lda * 2, hstepB = (size_t)HALF * ldb * 2;
    const unsigned ldsw = (unsigned)wid * 1024u;
    const int aoff = lds_byte(wr * 64 + fr, fq * 8), boff = lds_byte(wc * 32 + fr, fq * 8);
#define PG8_SA(b, h) (((b) * 2 + (h)) * HTB)
#define PG8_SB(b, h) ((4 + (b) * 2 + (h)) * HTB)
#define PG8_STAGE(bufoff, gbase, voff) do { _Pragma("unroll") for (int _i = 0; _i < 2; ++_i) \
        __builtin_amdgcn_global_load_lds((const unsigned*)((const char*)(gbase) + (voff)[_i]), (LAS unsigned*)(lds + (bufoff) + ldsw + _i * 8192), 16, 0, 0); } while (0)
#define PG8_LDA(dst, b, h) do { _Pragma("unroll") for (int m = 0; m < 4; ++m) _Pragma("unroll") for (int k = 0; k < 2; ++k) dst[m][k] = *(const LAS bf16x8*)(lds + PG8_SA(b, h) + aoff + m * 2048 + k * 1024); } while (0)
#define PG8_LDB(dst, b, h) do { _Pragma("unroll") for (int n = 0; n < 2; ++n) _Pragma("unroll") for (int k = 0; k < 2; ++k) dst[n][k] = *(const LAS bf16x8*)(lds + PG8_SB(b, h) + boff + n * 2048 + k * 1024); } while (0)
#define PG8_MMA(ai, bj, At, Bt) do { __builtin_amdgcn_s_setprio(1); _Pragma("unroll") for (int m = 0; m < 4; ++m) _Pragma("unroll") for (int n = 0; n < 2; ++n) _Pragma("unroll") for (int k = 0; k < 2; ++k) \
        acc[ai][bj][m][n] = __builtin_amdgcn_mfma_f32_16x16x32_bf16(Bt[n][k], At[m][k], acc[ai][bj][m][n], 0, 0, 0); __builtin_amdgcn_s_setprio(0); } while (0)
#define PG8_WAIT_V(n) asm volatile("s_waitcnt vmcnt(" #n ")" ::: "memory")
#define PG8_WAIT_L(n) asm volatile("s_waitcnt lgkmcnt(" #n ")" ::: "memory")
#define PG8_BAR __builtin_amdgcn_s_barrier()
#define PG8_SCHED __builtin_amdgcn_sched_barrier(0)
    Unit u; S.tile_of(L, u); u.seg = 0; u.rowoff = 128 * half; u.nai = 1;
    f32x4 acc[2][2][4][2];
#pragma unroll
    for (int a = 0; a < 2; ++a)
#pragma unroll
        for (int b = 0; b < 2; ++b)
#pragma unroll
            for (int m = 0; m < 4; ++m)
#pragma unroll
                for (int n = 0; n < 2; ++n) acc[a][b][m][n] = (f32x4){0.f, 0.f, 0.f, 0.f};
    bf16x8 At[4][2], B0[2][2], B1[2][2], Au[4][2], C0[2][2], C1[2][2];
    const char* cA = S.A + (size_t)u.pm * S.tstepA + (size_t)half * hstepA; const char* cB = S.Bt + (size_t)u.pn * S.tstepB; const int nt = S.ntk;
    RsFill rsf; if constexpr (Epi::NEEDS_RS) rs_fill_issue(rsf, E.ssq, u.pm * 256 + 128 * half, 128, tid);
    if (!prestaged) {
        PG8_STAGE(PG8_SB(0, 0), cB, voffB); PG8_STAGE(PG8_SB(0, 1), cB + hstepB, voffB); PG8_STAGE(PG8_SA(0, 0), cA, voffA);
        PG8_STAGE(PG8_SB(1, 0), cB + kstep, voffB); PG8_STAGE(PG8_SB(1, 1), cB + hstepB + kstep, voffB); PG8_STAGE(PG8_SA(1, 0), cA + kstep, voffA);
        PG8_WAIT_V(6); PG8_BAR; }
    PG8_LDB(B0, 0, 0); PG8_LDB(B1, 0, 1); PG8_LDA(At, 0, 0); PG8_WAIT_L(0);
    for (int t = 0; t < nt; t += 2) {
        unsigned tk = (unsigned)t * (unsigned)kstep; asm volatile("" : "+s"(tk));
        asm volatile("" : "+v"(voffA[0]), "+v"(voffA[1]), "+v"(voffB[0]), "+v"(voffB[1]));
        const bool more = (t + 2 < nt);
        PG8_WAIT_V(0); PG8_BAR; PG8_SCHED;
        if (more) { PG8_STAGE(PG8_SB(0, 0), cB + tk + 2 * kstep, voffB); PG8_STAGE(PG8_SB(0, 1), cB + hstepB + tk + 2 * kstep, voffB); PG8_STAGE(PG8_SA(0, 0), cA + tk + 2 * kstep, voffA); }
        PG8_LDB(C0, 1, 0); PG8_LDB(C1, 1, 1); PG8_LDA(Au, 1, 0); PG8_SCHED;
        PG8_MMA(0, 0, At, B0); PG8_MMA(0, 1, At, B1);
        PG8_WAIT_L(0);
        if (more) { PG8_WAIT_V(0); PG8_BAR; PG8_SCHED;
            PG8_STAGE(PG8_SB(1, 0), cB + tk + 3 * kstep, voffB); PG8_STAGE(PG8_SB(1, 1), cB + hstepB + tk + 3 * kstep, voffB); PG8_STAGE(PG8_SA(1, 0), cA + tk + 3 * kstep, voffA);
            PG8_LDB(B0, 0, 0); PG8_LDB(B1, 0, 1); PG8_LDA(At, 0, 0); PG8_SCHED; }
        PG8_MMA(0, 0, Au, C0); PG8_MMA(0, 1, Au, C1);
        PG8_WAIT_L(0);
    }
    if constexpr (Epi::NEEDS_RS) { rs_fill_finish(rsf, (LAS float*)(lds + RSTAB_OFF), 128, tid); PG8_WAIT_L(0); PG8_BAR; }
    int fr_ = fr, fq_ = fq; asm volatile("" : "+v"(fr_), "+v"(fq_));
    (void)E(acc, u, wr, wc, fr_, fq_, lds + STG_OFF + wid * STG_WAVE);
    PG8_WAIT_V(0); PG8_BAR;
#undef PG8_SA
#undef PG8_SB
#undef PG8_STAGE
#undef PG8_LDA
#undef PG8_LDB
#undef PG8_MMA
#undef PG8_WAIT_V
#undef PG8_WAIT_L
#undef PG8_BAR
#undef PG8_SCHED
}
}

__device__ __forceinline__ int zperm(int tok, int lr) { return (tok & ~(SEQ - 1)) + ((tok & ((1 << lr) - 1)) << (13 - lr)) + ((tok & (SEQ - 1)) >> lr); }
__device__ __forceinline__ size_t zplane(int slot) { return (size_t)slot * MTOK * ZSL; }
__device__ __forceinline__ float shx(float v, int o) {
    int l; asm volatile("v_mbcnt_lo_u32_b32 %0, -1, 0\n\tv_mbcnt_hi_u32_b32 %0, -1, %0" : "=v"(l));
    return __int_as_float(__builtin_amdgcn_ds_bpermute((l ^ o) << 2, __float_as_int(v)));
}

__device__ __forceinline__ float row_rs(const float* ssq, int row, int fq) {
    const f32x4 a = *(const f32x4*)(ssq + (size_t)row * 16 + 4 * fq);
    float s = (a.x + a.y) + (a.z + a.w);
    s += shx(s, 16); s += shx(s, 32);
    return __builtin_amdgcn_rsqf(s * (1.0f / 1024.0f) + RMS_EPS);
}
__device__ __forceinline__ float sum_fq4(float x) {
    { auto r = __builtin_amdgcn_permlane32_swap(__float_as_uint(x), __float_as_uint(x), false, false); x = __uint_as_float(r[0]) + __uint_as_float(r[1]); }
    { auto r = __builtin_amdgcn_permlane16_swap(__float_as_uint(x), __float_as_uint(x), false, false); x = __uint_as_float(r[0]) + __uint_as_float(r[1]); }
    return x;
}
#ifndef WT_STORES
#define WT_STORES 1
#endif
__device__ __forceinline__ void store16_wt(void* p, u32x4 v) {
#if WT_STORES
    asm volatile("global_store_dwordx4 %0, %1, off sc1\n\ts_nop 1" :: "v"(p), "v"(v) : "memory");
#else
    *(u32x4*)p = v;
#endif
}
typedef f32x4 acc_t[2][2][4][2];
__device__ __forceinline__ void rows_rs(float (&rs)[8], const float* ssq, int row0, int fq, int nai) {
    f32x4 t[8];
#pragma unroll
    for (int k = 0; k < 8; ++k) t[k] = ((k >> 2) < nai) ? *(const f32x4*)(ssq + (size_t)(row0 + (k >> 2) * 128 + (k & 3) * 16) * 16 + 4 * fq) : (f32x4){1.f, 1.f, 1.f, 1.f};
#pragma unroll
    for (int k = 0; k < 8; ++k) { float s = (t[k].x + t[k].y) + (t[k].z + t[k].w); s += shx(s, 16); s += shx(s, 32); rs[k] = __builtin_amdgcn_rsqf(s * (1.0f / 1024.0f) + RMS_EPS); }
}

struct EpiQKV {
    static constexpr int IDEMP = 1; static constexpr bool NEEDS_RS = true;
    bf16_t* Z; const float* ssq; const float* qkg;
    __device__ __forceinline__ bool operator()(acc_t& acc, const pg8::Unit& u, int wr, int wc, int fr, int fq, LAS unsigned char* stg) const {
        const int pn = u.pn;
        int kind = 0, gi = 0; bool scale = false;
        if (pn < 3) { kind = 1; gi = 0; scale = true; } else if (pn < 6) { kind = 1; gi = 1; } else if (pn < 9) { kind = 0; }
        else if (pn < 11) { kind = 1; gi = 2; scale = true; } else if (pn < 13) { kind = 1; gi = 3; } else if (pn < 15) { kind = 0; }
        else if (pn < 17) { kind = 2; gi = 4; scale = true; } else { if (wc < 2) { kind = 2; gi = 5; } else kind = 0; }
        f32x4 g[2][2];
#pragma unroll
        for (int bj = 0; bj < 2; ++bj)
#pragma unroll
            for (int n = 0; n < 2; ++n) g[bj][n] = kind ? *(const f32x4*)(qkg + gi * 64 + 32 * bj + 16 * n + 4 * fq) : (f32x4){1.f, 1.f, 1.f, 1.f};
        float inv[4];
#pragma unroll
        for (int e = 0; e < 4; ++e) inv[e] = fast_exp2(-(float)(4 * fq + e) * (13.287712379549449f / 16.0f)) * 0.15915494309189535f;
        const float sc = scale ? C2 : 1.0f;
        const LAS float* rstab = (const LAS float*)(stg - (wr * 4 + wc) * STG_WAVE + 8 * STG_WAVE) + wr * 64 + fr;
#pragma unroll
        for (int ai = 0; ai < 2; ++ai)
#pragma unroll
            for (int m = 0; m < 4; ++m) {
                if (ai >= u.nai) continue;
                const int row = u.pm * 256 + u.rowoff + ai * 128 + wr * 64 + m * 16 + fr;
                const float rs = rstab[ai * 128 + m * 16];
                f32x4 v[2][2];
#pragma unroll
                for (int bj = 0; bj < 2; ++bj)
#pragma unroll
                    for (int n = 0; n < 2; ++n) v[bj][n] = acc[ai][bj][m][n] * rs;
                if (kind) {
                    float ss = 0.f;
#pragma unroll
                    for (int bj = 0; bj < 2; ++bj)
#pragma unroll
                        for (int n = 0; n < 2; ++n) { const f32x4 x = v[bj][n]; ss += (x.x * x.x + x.y * x.y) + (x.z * x.z + x.w * x.w); }
                    ss = sum_fq4(ss);
                    const float r = __builtin_amdgcn_rsqf(ss * (1.0f / 64.0f) + RMS_EPS);
#pragma unroll
                    for (int bj = 0; bj < 2; ++bj)
#pragma unroll
                        for (int n = 0; n < 2; ++n) v[bj][n] = v[bj][n] * r * g[bj][n];
                }
                if (kind == 2) {
                    const int t = row & (SEQ - 1); const float pr = (float)(t >> 6), pc = (float)(t & 63);
#pragma unroll
                    for (int bj = 0; bj < 2; ++bj) { const float pos = bj ? pc : pr;
#pragma unroll
                        for (int e = 0; e < 4; ++e) { const float rev = pos * inv[e]; const float c = __builtin_amdgcn_cosf(rev), s = __builtin_amdgcn_sinf(rev);
                            const float x1 = v[bj][0][e], x2 = v[bj][1][e]; v[bj][0][e] = x1 * c - x2 * s; v[bj][1][e] = x1 * s + x2 * c; } }
                }
#pragma unroll
                for (int bj = 0; bj < 2; ++bj)
#pragma unroll
                    for (int n = 0; n < 2; ++n) { const f32x4 x = v[bj][n] * sc; u32x2 w; w.x = cvt_pk_bf16(x.x, x.y); w.y = cvt_pk_bf16(x.z, x.w); *(LAS u32x2*)(stg + fr * STG_ROW + 64 * bj + 32 * n + 8 * fq) = w; }
                { const int lane_ = fq * 16 + fr, r8 = lane_ >> 3, ch = lane_ & 7; const int rowg = row - fr;
                  const u32x4 w0 = *(const LAS u32x4*)(stg + r8 * STG_ROW + 16 * ch), w1 = *(const LAS u32x4*)(stg + (r8 + 8) * STG_ROW + 16 * ch);
                  const int lr_ = (pn < 9) ? 2 * (pn % 3) : 0;
                  bf16_t* zp_ = Z + zplane(4 * pn + wc) + 8 * ch;
                  store16_wt(zp_ + (size_t)zperm(rowg + r8, lr_) * ZSL, w0); store16_wt(zp_ + (size_t)zperm(rowg + r8 + 8, lr_) * ZSL, w1); }
                asm volatile("" ::: "memory");
            }
        return true;
    }
};
struct EpiGate {
    static constexpr int IDEMP = 2; static constexpr bool NEEDS_RS = true;
    bf16_t* G; const float* ssq;
    __device__ __forceinline__ bool operator()(acc_t& acc, const pg8::Unit& u, int wr, int wc, int fr, int fq, LAS unsigned char* stg) const {
        const LAS float* rstab = (const LAS float*)(stg - (wr * 4 + wc) * STG_WAVE + 8 * STG_WAVE) + wr * 64 + fr;
        const int lane_ = fq * 16 + fr, r8 = lane_ >> 3, ch = lane_ & 7;
#pragma unroll
        for (int ai = 0; ai < 2; ++ai)
#pragma unroll
            for (int m = 0; m < 4; ++m) {
                if (ai >= u.nai) continue;
                const int row = u.pm * 256 + u.rowoff + ai * 128 + wr * 64 + m * 16 + fr;
                const float rsn = rstab[ai * 128 + m * 16] * (-LOG2E);
#define GATE_E(v) (1.0f + fast_exp2(fminf((v) * rsn, 60.0f)))
#pragma unroll
                for (int bj = 0; bj < 2; ++bj) { const f32x4 a = acc[ai][bj][m][0], b = acc[ai][bj][m][1]; u32x4 w;
                    w.x = cvt_pk_bf16(GATE_E(a.x), GATE_E(a.y)); w.y = cvt_pk_bf16(GATE_E(a.z), GATE_E(a.w));
                    w.z = cvt_pk_bf16(GATE_E(b.x), GATE_E(b.y)); w.w = cvt_pk_bf16(GATE_E(b.z), GATE_E(b.w));
                    *(LAS u32x4*)(stg + fr * STG_ROW + 64 * bj + 16 * fq) = w; }
#undef GATE_E
                { const u32x4 w0 = *(const LAS u32x4*)(stg + r8 * STG_ROW + 16 * ch), w1 = *(const LAS u32x4*)(stg + (r8 + 8) * STG_ROW + 16 * ch);
                  bf16_t* gp = G + (size_t)(row - fr + r8) * ZGP + 256 * u.pn + 64 * wc + 8 * ch;
                  store16_wt(gp, w0); store16_wt(gp + (size_t)8 * ZGP, w1); }
                asm volatile("" ::: "memory");
            }
        return true;
    }
};
struct EpiBranch {
    static constexpr int IDEMP = 0; static constexpr bool NEEDS_RS = false;
    const bf16_t* G; bf16_t* Mg;
    __device__ __forceinline__ bool operator()(acc_t& acc, const pg8::Unit& u, int wr, int wc, int fr, int fq, LAS unsigned char* stg) const {
        const int seg = u.seg; const int rowb = u.pm * 256 + wr * 64; const int colw = 256 * u.pn + 64 * wc;
        const int lane_ = fq * 16 + fr, r8 = lane_ >> 3, ch = lane_ & 7;
        u32x4 gbuf[2][4];
#define EBR_ISSUE(k, pp) do { const bf16_t* gp_ = G + (size_t)(rowb + ((k) >> 2) * 128 + ((k) & 3) * 16 + r8) * ZGP + seg * 1024 + colw + 8 * ch; \
            gbuf[pp][0] = __builtin_nontemporal_load((const u32x4*)gp_); gbuf[pp][1] = __builtin_nontemporal_load((const u32x4*)(gp_ + (size_t)8 * ZGP)); \
            if (seg < 2) { gbuf[pp][2] = __builtin_nontemporal_load((const u32x4*)(gp_ + 1024)); gbuf[pp][3] = __builtin_nontemporal_load((const u32x4*)(gp_ + (size_t)8 * ZGP + 1024)); } } while (0)
        EBR_ISSUE(0, 0);
#pragma unroll
        for (int k = 0; k < 8; ++k) {
            if (k + 1 < 8) EBR_ISSUE(k + 1, (k + 1) & 1);
            const int ai = k >> 2, m = k & 3; const int rowg = rowb + ai * 128 + m * 16;
            u32x4 gc[2], gn[2];
            *(LAS u32x4*)(stg + r8 * STG_ROW + 16 * ch) = gbuf[k & 1][0]; *(LAS u32x4*)(stg + (r8 + 8) * STG_ROW + 16 * ch) = gbuf[k & 1][1];
            gc[0] = *(const LAS u32x4*)(stg + fr * STG_ROW + 16 * fq); gc[1] = *(const LAS u32x4*)(stg + fr * STG_ROW + 64 + 16 * fq);
            if (seg < 2) {
                *(LAS u32x4*)(stg + r8 * STG_ROW + 16 * ch) = gbuf[k & 1][2]; *(LAS u32x4*)(stg + (r8 + 8) * STG_ROW + 16 * ch) = gbuf[k & 1][3];
                gn[0] = *(const LAS u32x4*)(stg + fr * STG_ROW + 16 * fq); gn[1] = *(const LAS u32x4*)(stg + fr * STG_ROW + 64 + 16 * fq); }
#pragma unroll
            for (int bj = 0; bj < 2; ++bj) {
                const u32x4 gw = gc[bj];
                float f0 = fast_rcp(bf_lo(gw.x)), f1 = fast_rcp(bf_hi(gw.x)), f2 = fast_rcp(bf_lo(gw.y)), f3 = fast_rcp(bf_hi(gw.y)), f4 = fast_rcp(bf_lo(gw.z)), f5 = fast_rcp(bf_hi(gw.z)), f6 = fast_rcp(bf_lo(gw.w)), f7 = fast_rcp(bf_hi(gw.w));
                if (seg < 2) { const u32x4 nw = gn[bj];
                    f0 *= bf_lo(nw.x); f1 *= bf_hi(nw.x); f2 *= bf_lo(nw.y); f3 *= bf_hi(nw.y);
                    f4 *= bf_lo(nw.z); f5 *= bf_hi(nw.z); f6 *= bf_lo(nw.w); f7 *= bf_hi(nw.w); }
                f32x4 a = acc[ai][bj][m][0], b = acc[ai][bj][m][1];
                a.x *= f0; a.y *= f1; a.z *= f2; a.w *= f3; b.x *= f4; b.y *= f5; b.z *= f6; b.w *= f7;
                if (seg < 2) { acc[ai][bj][m][0] = a; acc[ai][bj][m][1] = b; }
                else { u32x4 w; w.x = cvt_pk_bf16(a.x, a.y); w.y = cvt_pk_bf16(a.z, a.w); w.z = cvt_pk_bf16(b.x, b.y); w.w = cvt_pk_bf16(b.z, b.w);
                    *(LAS u32x4*)(stg + fr * STG_ROW + 64 * bj + 16 * fq) = w; } }
            if (seg == 2) { const u32x4 w0 = *(const LAS u32x4*)(stg + r8 * STG_ROW + 16 * ch), w1 = *(const LAS u32x4*)(stg + (r8 + 8) * STG_ROW + 16 * ch);
                bf16_t* mp = Mg + (size_t)(rowg + r8) * DM + colw + 8 * ch;
                store16_wt(mp, w0); store16_wt(mp + (size_t)8 * DM, w1); }
            asm volatile("" ::: "memory");
        }
#undef EBR_ISSUE
        return seg == 2;
    }
};
template <bool RES_F32, bool OUT_F32> struct EpiRes {
    static constexpr int IDEMP = 0; static constexpr bool NEEDS_RS = false;
    const void* xin; float* xout; bf16_t* xb; float* ssq;
    __device__ __forceinline__ bool operator()(acc_t& acc, const pg8::Unit& u, int wr, int wc, int fr, int fq, LAS unsigned char* stg) const {
        const int rowb = u.pm * 256 + wr * 64; const int colw = 256 * u.pn + 64 * wc;
        const int lane_ = fq * 16 + fr, r8 = lane_ >> 3, ch = lane_ & 7;
        f32x4 buf[2][4]; u32x4 bbuf[2][2];
        const float* xf = (const float*)xin; const bf16_t* xh = (const bf16_t*)xin;
#define ERES_ISSUE(k, pp) do { const size_t row_ = (size_t)(rowb + ((k) >> 2) * 128 + ((k) & 3) * 16 + r8); \
            if (RES_F32) { const size_t off_ = row_ * DM + colw + 4 * ch; buf[pp][0] = __builtin_nontemporal_load((const f32x4*)(xf + off_)); buf[pp][1] = __builtin_nontemporal_load((const f32x4*)(xf + off_ + (size_t)8 * DM)); \
                buf[pp][2] = __builtin_nontemporal_load((const f32x4*)(xf + off_ + 32)); buf[pp][3] = __builtin_nontemporal_load((const f32x4*)(xf + off_ + (size_t)8 * DM + 32)); } \
            else { const size_t off_ = row_ * DM + colw + 8 * ch; bbuf[pp][0] = __builtin_nontemporal_load((const u32x4*)(xh + off_)); bbuf[pp][1] = __builtin_nontemporal_load((const u32x4*)(xh + off_ + (size_t)8 * DM)); } } while (0)
        ERES_ISSUE(0, 0);
#pragma unroll
        for (int k = 0; k < 8; ++k) {
            if (k + 1 < 8) ERES_ISSUE(k + 1, (k + 1) & 1);
            const int ai = k >> 2, m = k & 3; const int rowg = rowb + ai * 128 + m * 16;
            float sq = 0.f; f32x4 x[4];
            if (!RES_F32) {
                *(LAS u32x4*)(stg + r8 * STG_ROW + 16 * ch) = bbuf[k & 1][0]; *(LAS u32x4*)(stg + (r8 + 8) * STG_ROW + 16 * ch) = bbuf[k & 1][1];
#pragma unroll
                for (int q = 0; q < 4; ++q) { const u32x2 rw = *(const LAS u32x2*)(stg + fr * STG_ROW + 64 * (q >> 1) + 32 * (q & 1) + 8 * fq);
                    x[q] = (f32x4){bf_lo(rw.x), bf_hi(rw.x), bf_lo(rw.y), bf_hi(rw.y)} + acc[ai][q >> 1][m][q & 1]; } }
#pragma unroll
            for (int bj = 0; bj < 2; ++bj) {
                if (RES_F32) {
                    *(LAS f32x4*)(stg + r8 * STG_ROW + 16 * ch) = buf[k & 1][2 * bj]; *(LAS f32x4*)(stg + (r8 + 8) * STG_ROW + 16 * ch) = buf[k & 1][2 * bj + 1];
                    const f32x4 r0 = *(const LAS f32x4*)(stg + fr * STG_ROW + 16 * fq), r1 = *(const LAS f32x4*)(stg + fr * STG_ROW + 64 + 16 * fq);
                    x[2 * bj] = r0 + acc[ai][bj][m][0]; x[2 * bj + 1] = r1 + acc[ai][bj][m][1]; }
                if (OUT_F32) {
                    *(LAS f32x4*)(stg + fr * STG_ROW + 16 * fq) = x[2 * bj]; *(LAS f32x4*)(stg + fr * STG_ROW + 64 + 16 * fq) = x[2 * bj + 1];
                    const f32x4 w0 = *(const LAS f32x4*)(stg + r8 * STG_ROW + 16 * ch), w1 = *(const LAS f32x4*)(stg + (r8 + 8) * STG_ROW + 16 * ch);
                    float* gp = xout + (size_t)(rowg + r8) * DM + colw + 32 * bj + 4 * ch;
                    __builtin_nontemporal_store(w0, (f32x4*)gp); __builtin_nontemporal_store(w1, (f32x4*)(gp + (size_t)8 * DM)); } }
            if (xb) {
#pragma unroll
                for (int q = 0; q < 4; ++q) sq += (x[q].x * x[q].x + x[q].y * x[q].y) + (x[q].z * x[q].z + x[q].w * x[q].w);
#pragma unroll
                for (int q = 0; q < 4; ++q) { u32x2 w; w.x = cvt_pk_bf16(x[q].x, x[q].y); w.y = cvt_pk_bf16(x[q].z, x[q].w); *(LAS u32x2*)(stg + fr * STG_ROW + 64 * (q >> 1) + 32 * (q & 1) + 8 * fq) = w; }
                const u32x4 w0 = *(const LAS u32x4*)(stg + r8 * STG_ROW + 16 * ch), w1 = *(const LAS u32x4*)(stg + (r8 + 8) * STG_ROW + 16 * ch);
                bf16_t* gp = xb + (size_t)(rowg + r8) * DM + colw + 8 * ch;
                store16_wt(gp, w0); store16_wt(gp + (size_t)8 * DM, w1);
                sq = sum_fq4(sq); if (fq == 0) ssq[(size_t)(rowg + fr) * 16 + u.pn * 4 + wc] = sq; }
            asm volatile("" ::: "memory");
        }
#undef ERES_ISSUE
        return true;
    }
};
struct EpiSwiglu {
    static constexpr int IDEMP = 3; static constexpr bool NEEDS_RS = true;
    bf16_t* H; const float* ssq;
    __device__ __forceinline__ bool operator()(acc_t& acc, const pg8::Unit& u, int wr, int wc, int fr, int fq, LAS unsigned char* stg) const {
        const LAS float* rstab = (const LAS float*)(stg - (wr * 4 + wc) * STG_WAVE + 8 * STG_WAVE) + wr * 64 + fr;
#pragma unroll
        for (int ai = 0; ai < 2; ++ai)
#pragma unroll
            for (int m = 0; m < 4; ++m) {
                if (ai >= u.nai) continue;
                const int row = u.pm * 256 + u.rowoff + ai * 128 + wr * 64 + m * 16 + fr;
                const float rs = rstab[ai * 128 + m * 16];
                float h[8];
#pragma unroll
                for (int n = 0; n < 2; ++n) { const f32x4 a = acc[ai][0][m][n] * rs, b = acc[ai][1][m][n] * rs;
#pragma unroll
                    for (int e = 0; e < 4; ++e) h[4 * n + e] = a[e] * sigmoidf_(a[e]) * b[e]; }
                u32x4 w; w.x = cvt_pk_bf16(h[0], h[1]); w.y = cvt_pk_bf16(h[2], h[3]); w.z = cvt_pk_bf16(h[4], h[5]); w.w = cvt_pk_bf16(h[6], h[7]);
                store16_wt(H + (size_t)row * DFF + 128 * u.pn + 32 * wc + 8 * fq, w);
                asm volatile("" ::: "memory");
            }
        return true;
    }
};

namespace att {
typedef LAS const char* lds_cptr;
__device__ __forceinline__ int crow(int r, int hi) { return (r & 3) + 8 * (r >> 2) + 4 * hi; }
constexpr int NSLOT = 5, SLOTB = 8192, LDS_K = 0, LDS_V = NSLOT * SLOTB, LDS_WS = 2 * NSLOT * SLOTB, LDS_OST = LDS_WS + 8 * 256, LDS_TAB = LDS_OST + 8 * 4096, LDS_END = LDS_TAB + 8192;
static_assert(LDS_END <= RING_BYTES, "attention LDS");
__device__ __forceinline__ void glds16(const void* gsrc, unsigned lds_dst) { unsigned keep;
    asm volatile("s_mov_b32 %0, m0\n\ts_mov_b32 m0, %2\n\ts_nop 0\n\tglobal_load_lds_dwordx4 %1, off\n\ts_mov_b32 m0, %0" : "=&s"(keep) : "v"(gsrc), "s"(lds_dst) : "memory"); }
#define ATT_WAIT_BAR(N) asm volatile("s_waitcnt vmcnt(" #N ") lgkmcnt(0)\n\ts_barrier" ::: "memory")
#define ATT_LBAR() asm volatile("s_waitcnt lgkmcnt(0)\n\ts_barrier" ::: "memory")
#define MFMA32(a, b, c) __builtin_amdgcn_mfma_f32_32x32x16_bf16(a, b, c, 0, 0, 0)
__device__ __forceinline__ void qkt(f32x16& p0, f32x16& p1, lds_cptr kb, const bf16x8* qr, const f32x16& c0, const f32x16& c1) {
#pragma unroll
    for (int d0 = 0; d0 < 4; ++d0) {
        const bf16x8 b0 = *(const LAS bf16x8*)(kb + d0 * 2048);
        const bf16x8 b1 = *(const LAS bf16x8*)(kb + d0 * 2048 + 512);
        if (d0 == 0) { p0 = MFMA32(b0, qr[0], c0); p1 = MFMA32(b1, qr[0], c1); }
        else { p0 = MFMA32(b0, qr[d0], p0); p1 = MFMA32(b1, qr[d0], p1); } }
}
__device__ __forceinline__ float rowmax(const f32x16& p0, const f32x16& p1) {
    float a = fmaxf(p0[0], p1[0]);
#pragma unroll
    for (int r = 1; r < 16; ++r) a = fmaxf(a, fmaxf(p0[r], p1[r]));
    auto rr = __builtin_amdgcn_permlane32_swap(__float_as_uint(a), __float_as_uint(a), false, false);
    return fmaxf(__uint_as_float(rr[0]), __uint_as_float(rr[1]));
}
template <unsigned KS> __device__ __forceinline__ void pv(f32x16* o, int vb, int vbB, bf16x8 pa0, bf16x8 pa1, bf16x8 pa2, bf16x8 pa3) {
#pragma unroll
    for (int d0 = 0; d0 < 2; ++d0) { s16x4 lo[4], hi[4];
#pragma unroll
        for (int ks = 0; ks < 4; ++ks) if ((KS >> ks) & 1u) {
            asm volatile("ds_read_b64_tr_b16 %0,%1 offset:%c2" : "=&v"(lo[ks]) : "v"(ks < 2 ? vb : vbB), "i"(d0 * 4096 + (ks & 1) * 1024) : "memory");
            asm volatile("ds_read_b64_tr_b16 %0,%1 offset:%c2" : "=&v"(hi[ks]) : "v"(ks < 2 ? vb : vbB), "i"(d0 * 4096 + (ks & 1) * 1024 + 512) : "memory"); }
        asm volatile("s_waitcnt lgkmcnt(0)" ::: "memory"); __builtin_amdgcn_sched_barrier(0);
#define PK(k) (bf16x8){lo[k][0], lo[k][1], lo[k][2], lo[k][3], hi[k][0], hi[k][1], hi[k][2], hi[k][3]}
        if (KS & 1u) o[d0] = MFMA32(pa0, PK(0), o[d0]);
        if (KS & 2u) o[d0] = MFMA32(pa1, PK(1), o[d0]);
        if (KS & 4u) o[d0] = MFMA32(pa2, PK(2), o[d0]);
        if (KS & 8u) o[d0] = MFMA32(pa3, PK(3), o[d0]);
#undef PK
    }
}
template <unsigned L0, unsigned L1, bool HASCM, class P> __device__ __forceinline__ void att_step(const P& p, int j, int wid, f32x16& cm0, f32x16& cm1, lds_cptr kb, lds_cptr kbB, int vb, int vbB, const bf16x8* qr,
                                                                             float& mhat, float& lrun, f32x16* o, LAS float* wsf, bool& first, int r32, int hi) {
    f32x16 p0, p1, c0, c1;
    p.template cinit<L0, L1>(c0, c1, cm0, cm1, mhat, j, wid, r32, hi);
#pragma unroll
    for (int d0 = 0; d0 < 4; ++d0) {
        if (L0) { const bf16x8 b0 = *(const LAS bf16x8*)(kb + d0 * 2048); p0 = MFMA32(b0, qr[d0], d0 == 0 ? c0 : p0); }
        if (L1) { const bf16x8 b1 = *(const LAS bf16x8*)(kbB + d0 * 2048); p1 = MFMA32(b1, qr[d0], d0 == 0 ? c1 : p1); }
        if (HASCM && d0 == 1) __builtin_amdgcn_sched_barrier(0); }
    float s4[4] = {0.f, 0.f, 0.f, 0.f};
#pragma unroll
    for (int r = 0; r < 16; ++r) { if ((L0 >> r) & 1u) { p0[r] = fast_exp2(p0[r]); s4[r & 3] += p0[r]; } else p0[r] = 0.f; if ((L1 >> r) & 1u) { p1[r] = fast_exp2(p1[r]); s4[r & 3] += p1[r]; } else p1[r] = 0.f; }
    lrun += (s4[0] + s4[1]) + (s4[2] + s4[3]);
    u32x4 pw0, pw1, pw2, pw3;
    pw0 = (u32x4){cvt_pk_bf16(p0[0], p0[1]), cvt_pk_bf16(p0[2], p0[3]), cvt_pk_bf16(p0[4], p0[5]), cvt_pk_bf16(p0[6], p0[7])};
    pw1 = (u32x4){cvt_pk_bf16(p0[8], p0[9]), cvt_pk_bf16(p0[10], p0[11]), cvt_pk_bf16(p0[12], p0[13]), cvt_pk_bf16(p0[14], p0[15])};
    pw2 = (u32x4){cvt_pk_bf16(p1[0], p1[1]), cvt_pk_bf16(p1[2], p1[3]), cvt_pk_bf16(p1[4], p1[5]), cvt_pk_bf16(p1[6], p1[7])};
    pw3 = (u32x4){cvt_pk_bf16(p1[8], p1[9]), cvt_pk_bf16(p1[10], p1[11]), cvt_pk_bf16(p1[12], p1[13]), cvt_pk_bf16(p1[14], p1[15])};
    constexpr unsigned KS = ((L0 & 0x00FFu) ? 1u : 0u) | ((L0 & 0xFF00u) ? 2u : 0u) | ((L1 & 0x00FFu) ? 4u : 0u) | ((L1 & 0xFF00u) ? 8u : 0u);
    pv<KS>(o, vb, vbB, __builtin_bit_cast(bf16x8, pw0), __builtin_bit_cast(bf16x8, pw1), __builtin_bit_cast(bf16x8, pw2), __builtin_bit_cast(bf16x8, pw3));
}
template <class P> __device__ __forceinline__ void unit_simple(const P& p, bool prestaged, const P& pn, bool has_next, const float Bref, LAS char* shm) {
    int tid = threadIdx.x; asm volatile("" : "+v"(tid));
    const int lane = tid & 63, r32 = lane & 31, hi = lane >> 5; const int wid = __builtin_amdgcn_readfirstlane(tid >> 6);
    const unsigned lds0 = (unsigned)(uintptr_t)shm;
    LAS float* wsf = (LAS float*)(shm + LDS_WS) + wid * 64;
    const unsigned kdst = lds0 + LDS_K + wid * 1024, vdst = lds0 + LDS_V + wid * 1024;
    const int vb0 = (int)(lds0 + LDS_V) + ((lane >> 4) & 1) * 32 + (lane & 3) * 8 + (4 * hi + ((lane & 15) >> 2)) * 64;
    const lds_cptr kp0 = (lds_cptr)shm + LDS_K + hi * 1024 + r32 * 16;
    const int NT = p.ntiles();
#define ATT_STAGE_P(pp, j, slot) do { const bf16_t* kp_ = (pp).kptr((j), lane) + wid * 8; const bf16_t* vp_ = (pp).vptr((j), 16 * (wid & 3) + (lane >> 2)) + (wid >> 2) * 32 + (lane & 3) * 8; \
        glds16(kp_, (unsigned)__builtin_amdgcn_readfirstlane(kdst + (slot) * SLOTB)); glds16(vp_, (unsigned)__builtin_amdgcn_readfirstlane(vdst + (slot) * SLOTB)); } while (0)
#define ATT_STAGE(j, slot) ATT_STAGE_P(p, j, slot)
    constexpr int NPRE = (P::KIND == 2) ? 5 : 4;
    bf16x8 qr[4];
    { const bf16_t* qrow = p.qrow(wid, r32);
#pragma unroll
      for (int d0 = 0; d0 < 4; ++d0) qr[d0] = *(const bf16x8*)(qrow + d0 * 16 + hi * 8); }
    asm volatile("" ::: "memory");
    if (!prestaged) {
#pragma unroll
        for (int j0 = 0; j0 < NPRE; ++j0) if (j0 < NT) ATT_STAGE(j0, j0); }
    float mrun = Bref, lrun = 0.f; f32x16 o[2]; o[0] = f32x16{}; o[1] = f32x16{}; bool first = false;
    f32x16 cm0 = f32x16{}, cm1 = f32x16{}; p.prep(cm0, cm1, wid, r32, hi);
    if constexpr (P::KIND == 2) {
#pragma unroll
        for (int st = 0; st < 3; ++st) {
            if (st == 0) { ATT_WAIT_BAR(2); } else { ATT_WAIT_BAR(0); }
            if (st == 1) ATT_STAGE(5, 0);
            const int t = (wid >> 1) + st, sl = (t == 5) ? 0 : t;
            if (p.active(t, wid)) {
                const lds_cptr kb = kp0 + sl * SLOTB; const int vb = vb0 + sl * SLOTB;
                if (st == 0 && (wid & 1))       att_step<0x0000u, 0xFFFFu, false>(p, t, wid, cm0, cm1, kb, kb + 512, vb, vb + 2048, qr, mrun, lrun, o, wsf, first, r32, hi);
                else if (st == 2 && !(wid & 1)) att_step<0xFFFFu, 0x0000u, false>(p, t, wid, cm0, cm1, kb, kb + 512, vb, vb + 2048, qr, mrun, lrun, o, wsf, first, r32, hi);
                else                            att_step<0xFFFFu, 0xFFFFu, false>(p, t, wid, cm0, cm1, kb, kb + 512, vb, vb + 2048, qr, mrun, lrun, o, wsf, first, r32, hi);
            }
        }
    } else {
    int slot = 0, slot4 = 4;
    for (int j = 0; j < NT; ++j) {
        const int rem = NT - 1 - j;
        if (rem >= 3) { ATT_WAIT_BAR(6); } else if (rem == 2) { ATT_WAIT_BAR(4); } else if (rem == 1) { ATT_WAIT_BAR(2); } else { ATT_WAIT_BAR(0); }
        if (j + 4 < NT) ATT_STAGE(j + 4, slot4);
        if (p.active(j, wid)) {
            const lds_cptr kb = kp0 + slot * SLOTB; const int vb = vb0 + slot * SLOTB;
            const int pat = p.pattern(j, wid);
            if constexpr (P::KIND == 1) {
                if (pat == 1) att_step<0xFFFFu, 0x000Fu, true>(p, j, wid, cm0, cm1, kb, kb + 512, vb, vb + 2048, qr, mrun, lrun, o, wsf, first, r32, hi);
                else          att_step<0xF000u, 0xFFFFu, true>(p, j, wid, cm0, cm1, kb, kb + 512, vb, vb + 2048, qr, mrun, lrun, o, wsf, first, r32, hi);
            } else if constexpr (P::KIND == 2) {
                if (pat == 3)      att_step<0x0000u, 0xFFFFu, false>(p, j, wid, cm0, cm1, kb, kb + 512, vb, vb + 2048, qr, mrun, lrun, o, wsf, first, r32, hi);
                else if (pat == 4) att_step<0xFFFFu, 0x0000u, false>(p, j, wid, cm0, cm1, kb, kb + 512, vb, vb + 2048, qr, mrun, lrun, o, wsf, first, r32, hi);
                else               att_step<0xFFFFu, 0xFFFFu, false>(p, j, wid, cm0, cm1, kb, kb + 512, vb, vb + 2048, qr, mrun, lrun, o, wsf, first, r32, hi);
            } else att_step<0xFFFFu, 0xFFFFu, false>(p, j, wid, cm0, cm1, kb, kb + 512, vb, vb + 2048, qr, mrun, lrun, o, wsf, first, r32, hi);
        }
        slot = (slot == NSLOT - 1) ? 0 : slot + 1; slot4 = (slot4 == NSLOT - 1) ? 0 : slot4 + 1;
    }
    }
    ATT_LBAR();
    if (has_next) { const int NTn = pn.ntiles();
#pragma unroll
        for (int j0 = 0; j0 < NPRE; ++j0) if (j0 < NTn) ATT_STAGE_P(pn, j0, j0); }
    { auto rr = __builtin_amdgcn_permlane32_swap(__float_as_uint(lrun), __float_as_uint(lrun), false, false); lrun = __uint_as_float(rr[0]) + __uint_as_float(rr[1]); }
    if (p.skip_out()) return;
    p.store_lse(wid, r32, hi, mrun, lrun);
    if (hi == 0) wsf[32 + r32] = lrun;
    asm volatile("s_waitcnt lgkmcnt(0)" ::: "memory");
    float rli[16];
#pragma unroll
    for (int r = 0; r < 16; ++r) rli[r] = fast_rcp(wsf[32 + crow(r, hi)]);
    { LAS bf16_t* stg = (LAS bf16_t*)(shm + LDS_OST) + wid * 2048;
#pragma unroll
      for (int r = 0; r < 16; ++r) { const int orow = crow(r, hi);
#pragma unroll
        for (int d0 = 0; d0 < 2; ++d0) { const float v = o[d0][r] * rli[r]; stg[orow * 64 + d0 * 32 + r32] = (bf16_t)(cvt_pk_bf16(v, v) & 0xffffu); } }
      asm volatile("s_waitcnt lgkmcnt(0)" ::: "memory");
#pragma unroll
      for (int i = 0; i < 4; ++i) { const int row = i * 8 + (lane >> 3), ch = lane & 7; const u32x4 v = *(const LAS u32x4*)(stg + row * 64 + ch * 8); *(u32x4*)(p.optr(wid, row) + ch * 8) = v; } }
#undef ATT_STAGE
#undef ATT_STAGE_P
}

struct PolC {
    static constexpr int KIND = 0;
    const bf16_t* Z; bf16_t* O; int b, h, qb;
    __device__ __forceinline__ int ntiles() const { return SEQ / 64; }
    __device__ __forceinline__ const bf16_t* qrow(int wid, int r32) const { return Z + (size_t)(b * SEQ + qb * 256 + wid * 32 + r32) * ZP + ZQC + 64 * h; }
    __device__ __forceinline__ const bf16_t* kptr(int j, int row) const { return Z + (size_t)(b * SEQ + 64 * j + row) * ZP + ZKC + 64 * (h >> 2); }
    __device__ __forceinline__ const bf16_t* vptr(int j, int row) const { return Z + (size_t)(b * SEQ + 64 * j + row) * ZP + ZVC + 64 * (h >> 2); }
    __device__ __forceinline__ bool active(int, int) const { return true; }
    __device__ __forceinline__ void prep(f32x16&, f32x16&, int, int, int) const {}
    template <unsigned L0, unsigned L1> __device__ __forceinline__ void cinit(f32x16& c0, f32x16& c1, const f32x16&, const f32x16&, float mhat, int, int, int, int) const {
#pragma unroll
        for (int r = 0; r < 16; ++r) { c0[r] = -mhat; c1[r] = -mhat; } }
    __device__ __forceinline__ bool skip_out() const { return false; }
    __device__ __forceinline__ int pattern(int, int) const { return 0; }
    __device__ __forceinline__ void store_lse(int, int, int, float, float) const {}
    __device__ __forceinline__ bf16_t* optr(int wid, int row) const { return O + (size_t)(b * SEQ + qb * 256 + wid * 32 + row) * OP + 768 + 64 * h; }
};
struct PolB {
    static constexpr int KIND = 1;
    const bf16_t* Z; bf16_t* O; const LAS float* tab; int b, h, i0, kr0, nt;
    __device__ __forceinline__ int ntiles() const { return nt; }
    __device__ __forceinline__ const bf16_t* qrow(int wid, int r32) const { return Z + (size_t)(b * SEQ + (i0 + (wid >> 1)) * 64 + 32 * (wid & 1) + r32) * ZP + ZQB + 64 * h; }
    __device__ __forceinline__ const bf16_t* kptr(int j, int row) const { return Z + (size_t)(b * SEQ + (kr0 + j) * 64 + row) * ZP + ZKB + 64 * h; }
    __device__ __forceinline__ const bf16_t* vptr(int j, int row) const { return Z + (size_t)(b * SEQ + (kr0 + j) * 64 + row) * ZP + ZVB + 64 * h; }
    __device__ __forceinline__ bool active(int j, int wid) const { const int gi = i0 + (wid >> 1); int rs = gi - 4; rs = rs < 0 ? 0 : (rs > 120 ? 120 : rs); const int kr = kr0 + j; return kr >= rs && kr <= rs + 7; }
    __device__ __forceinline__ void prep(f32x16& cm0, f32x16& cm1, int wid, int r32, int hi) const {
        const int c = 32 * (wid & 1) + r32; int c0 = c - 8; c0 = c0 < 0 ? 0 : (c0 > 48 ? 48 : c0);
#pragma unroll
        for (int r = 0; r < 16; ++r) { const int k0 = crow(r, hi), k1 = k0 + 32; cm0[r] = (k0 >= c0 && k0 < c0 + 16) ? 0.f : NEGBIG; cm1[r] = (k1 >= c0 && k1 < c0 + 16) ? 0.f : NEGBIG; }
    }
    template <unsigned L0, unsigned L1> __device__ __forceinline__ void cinit(f32x16& c0, f32x16& c1, const f32x16& cm0, const f32x16& cm1, float, int j, int wid, int r32, int hi) const {
        const int gi = i0 + (wid >> 1), c = 32 * (wid & 1) + r32; const int dr = kr0 + j - gi + 7;
        const LAS float* base = tab + dr * 128 + (48 + 15 + 4 * hi - c);
#pragma unroll
        for (int r = 0; r < 16; ++r) { const int kc = (r & 3) + 8 * (r >> 2); c0[r] = ((L0 >> r) & 1u) ? base[kc] + cm0[r] : 0.f; c1[r] = ((L1 >> r) & 1u) ? base[kc + 32] + cm1[r] : 0.f; }
    }
    __device__ __forceinline__ bool skip_out() const { return false; }
    __device__ __forceinline__ int pattern(int, int wid) const { return (wid & 1) ? 2 : 1; }
    __device__ __forceinline__ void store_lse(int, int, int, float, float) const {}
    __device__ __forceinline__ bf16_t* optr(int wid, int row) const { return O + (size_t)(b * SEQ + (i0 + (wid >> 1)) * 64 + 32 * (wid & 1) + row) * OP + 256 + 64 * h; }
};
constexpr int B2_NSLOT = 4, B2_K = 0, B2_V = B2_NSLOT * SLOTB, B2_WS = 2 * B2_NSLOT * SLOTB, B2_OST = B2_WS + 8 * 256, B2_TAB = B2_OST + 8 * 4096, B2_END = B2_TAB + 16 * 128 * 4;
static_assert(B2_END <= RING_BYTES, "mixer B LDS");
struct PolB2 {
    const LAS float* tab; int i0, R0;
    template <unsigned L0, unsigned L1> __device__ __forceinline__ void cinit(f32x16& c0, f32x16& c1, const f32x16& cm0, const f32x16&, float, int s, int wid, int r32, int hi) const {
        const int p = wid >> 2, mb = wid & 3; int cs = 16 * mb - 8; cs = cs < 0 ? 0 : (cs > 32 ? 32 : cs);
        const int qrow = i0 + 2 * p + (r32 >> 4), qcol = 16 * mb + (r32 & 15); int rsq = qrow - 4; rsq = rsq < 0 ? 0 : (rsq > 120 ? 120 : rsq);
        const int krA = R0 + 2 * s, krB = krA + 1;
        const int drA = (krA >= rsq && krA <= rsq + 7) ? krA - qrow + 7 : 15, drB = (krB >= rsq && krB <= rsq + 7) ? krB - qrow + 7 : 15;
        const int off = 48 + 15 + cs + 4 * hi - qcol;
        const LAS float* bA = tab + drA * 128 + off; const LAS float* bB = tab + drB * 128 + off;
#pragma unroll
        for (int r = 0; r < 16; ++r) { const int kc = (r & 3) + 8 * (r >> 2); c0[r] = ((L0 >> r) & 1u) ? bA[kc] + cm0[r] : 0.f; c1[r] = ((L1 >> r) & 1u) ? bB[kc] + cm0[r] : 0.f; }
    }
};
__device__ __forceinline__ void unit_b2(const bf16_t* Z, bf16_t* O, const LAS float* tab, int b, int h, int i0, const float Bref, LAS char* shm) {
    int tid = threadIdx.x; asm volatile("" : "+v"(tid));
    const int lane = tid & 63, r32 = lane & 31, hi = lane >> 5; const int wid = __builtin_amdgcn_readfirstlane(tid >> 6);
    const int p = wid >> 2, mb = wid & 3; int cs = 16 * mb - 8; cs = cs < 0 ? 0 : (cs > 32 ? 32 : cs);
    int R0 = i0 - 4; R0 = R0 < 0 ? 0 : (R0 > 120 ? 120 : R0); int rs3 = i0 - 1; rs3 = rs3 < 0 ? 0 : (rs3 > 120 ? 120 : rs3);
    const int NS = (rs3 + 8 - R0 + 1) >> 1, NR = 2 * NS;
    const unsigned lds0 = (unsigned)(uintptr_t)shm;
    LAS float* wsf = (LAS float*)(shm + B2_WS) + wid * 64;
    const unsigned kdst = lds0 + B2_K + wid * 1024, vdst = lds0 + B2_V + wid * 1024;
    const int vbl = (int)(lds0 + B2_V) + cs * 64 + ((lane >> 4) & 1) * 32 + (lane & 3) * 8 + (4 * hi + ((lane & 15) >> 2)) * 64;
    const lds_cptr kpl = (lds_cptr)shm + B2_K + hi * 1024 + (cs + r32) * 16;
    const bf16_t* Zb = Z + (size_t)(b * SEQ) * ZP + 64 * h;
#define B2_STAGE(ri) do { int kr_ = R0 + (ri); kr_ = kr_ > 127 ? 127 : kr_; const int sl_ = (ri) & (B2_NSLOT - 1); \
        const bf16_t* kp_ = Zb + (size_t)(kr_ * 64 + lane) * ZP + ZKB + wid * 8; const bf16_t* vp_ = Zb + (size_t)(kr_ * 64 + 16 * (wid & 3) + (lane >> 2)) * ZP + ZVB + (wid >> 2) * 32 + (lane & 3) * 8; \
        glds16(kp_, (unsigned)__builtin_amdgcn_readfirstlane(kdst + sl_ * SLOTB)); glds16(vp_, (unsigned)__builtin_amdgcn_readfirstlane(vdst + sl_ * SLOTB)); } while (0)
#pragma unroll
    for (int ri = 0; ri < 4; ++ri) B2_STAGE(ri);
    const int qrow = i0 + 2 * p + (r32 >> 4), qcol = 16 * mb + (r32 & 15);
    bf16x8 qr[4];
    { const bf16_t* qp = Zb + (size_t)(qrow * 64 + qcol) * ZP + ZQB;
#pragma unroll
      for (int d0 = 0; d0 < 4; ++d0) qr[d0] = *(const bf16x8*)(qp + d0 * 16 + hi * 8); }
    float mrun = Bref, lrun = 0.f; f32x16 o[2]; o[0] = f32x16{}; o[1] = f32x16{}; bool first = false;
    f32x16 cm0, cm1 = f32x16{};
    { int c0w = qcol - 8; c0w = c0w < 0 ? 0 : (c0w > 48 ? 48 : c0w);
#pragma unroll
      for (int r = 0; r < 16; ++r) { const int kc = cs + crow(r, hi); cm0[r] = (kc >= c0w && kc < c0w + 16) ? -Bref : NEGBIG; } }
    const PolB2 P{tab, i0, R0};
    int rs0p = i0 + 2 * p - 4; rs0p = rs0p < 0 ? 0 : (rs0p > 120 ? 120 : rs0p); int rs1p = i0 + 2 * p - 3; rs1p = rs1p < 0 ? 0 : (rs1p > 120 ? 120 : rs1p);
    for (int s = 0; s < NS; ++s) {
        if (s == 0) { ATT_WAIT_BAR(4); } else { ATT_WAIT_BAR(0); }
        if (s >= 1 && 2 * s + 2 < NR) { B2_STAGE(2 * s + 2); B2_STAGE(2 * s + 3); }
        const int krA = R0 + 2 * s;
        if (krA + 1 >= rs0p && krA <= rs1p + 7) {
            const int slA = (2 * s) & (B2_NSLOT - 1), slB = (2 * s + 1) & (B2_NSLOT - 1);
            const lds_cptr kbA = kpl + slA * SLOTB, kbB = kpl + slB * SLOTB; const int vbA = vbl + slA * SLOTB, vbB = vbl + slB * SLOTB;
            if (mb == 0)      att_step<0x0FFFu, 0x0FFFu, true>(P, s, wid, cm0, cm1, kbA, kbB, vbA, vbB, qr, mrun, lrun, o, wsf, first, r32, hi);
            else if (mb == 3) att_step<0xFFF0u, 0xFFF0u, true>(P, s, wid, cm0, cm1, kbA, kbB, vbA, vbB, qr, mrun, lrun, o, wsf, first, r32, hi);
            else              att_step<0xFFFFu, 0xFFFFu, true>(P, s, wid, cm0, cm1, kbA, kbB, vbA, vbB, qr, mrun, lrun, o, wsf, first, r32, hi);
        }
    }
    ATT_LBAR();
    { auto rr = __builtin_amdgcn_permlane32_swap(__float_as_uint(lrun), __float_as_uint(lrun), false, false); lrun = __uint_as_float(rr[0]) + __uint_as_float(rr[1]); }
    if (hi == 0) wsf[32 + r32] = lrun;
    asm volatile("s_waitcnt lgkmcnt(0)" ::: "memory");
    float rli[16];
#pragma unroll
    for (int r = 0; r < 16; ++r) rli[r] = fast_rcp(wsf[32 + crow(r, hi)]);
    { LAS bf16_t* stg = (LAS bf16_t*)(shm + B2_OST) + wid * 2048;
#pragma unroll
      for (int r = 0; r < 16; ++r) { const int orow = crow(r, hi);
#pragma unroll
        for (int d0 = 0; d0 < 2; ++d0) { const float v = o[d0][r] * rli[r]; stg[orow * 64 + d0 * 32 + r32] = (bf16_t)(cvt_pk_bf16(v, v) & 0xffffu); } }
      asm volatile("s_waitcnt lgkmcnt(0)" ::: "memory");
      bf16_t* Ob = O + (size_t)(b * SEQ) * OP + 256 + 64 * h;
#pragma unroll
      for (int i = 0; i < 4; ++i) { const int row = i * 8 + (lane >> 3), ch = lane & 7; const u32x4 v = *(const LAS u32x4*)(stg + row * 64 + ch * 8);
          *(u32x4*)(Ob + (size_t)((i0 + 2 * p + (row >> 4)) * 64 + 16 * mb + (row & 15)) * OP + ch * 8) = v; } }
    ATT_LBAR();
#undef B2_STAGE
}
__device__ __forceinline__ void unit_b8(const bf16_t* Z, bf16_t* O, const LAS float* tab, int b, int h, int i0, const float Bref, LAS char* shm) {
    int tid = threadIdx.x; asm volatile("" : "+v"(tid));
    const int lane = tid & 63, r32 = lane & 31, hi = lane >> 5; const int wid = __builtin_amdgcn_readfirstlane(tid >> 6);
    const int p = wid >> 2, mb = wid & 3; int cs = 16 * mb - 8; cs = cs < 0 ? 0 : (cs > 32 ? 32 : cs);
    int R0 = i0 - 4; R0 = R0 < 0 ? 0 : (R0 > 120 ? 120 : R0); int rsl = i0 + 3; rsl = rsl < 0 ? 0 : (rsl > 120 ? 120 : rsl);
    const int NS = (rsl + 8 - R0 + 1) >> 1, NR = 2 * NS;
    const unsigned lds0 = (unsigned)(uintptr_t)shm;
    LAS float* wsf = (LAS float*)(shm + B2_WS) + wid * 64;
    const unsigned kdst = lds0 + B2_K + wid * 1024, vdst = lds0 + B2_V + wid * 1024;
    const int vbl = (int)(lds0 + B2_V) + cs * 64 + ((lane >> 4) & 1) * 32 + (lane & 3) * 8 + (4 * hi + ((lane & 15) >> 2)) * 64;
    const lds_cptr kpl = (lds_cptr)shm + B2_K + hi * 1024 + (cs + r32) * 16;
    const bf16_t* ZbQ = Z + zplane(36 + h) + (size_t)(b * SEQ) * ZSL; const bf16_t* ZbK = Z + zplane(44 + h) + (size_t)(b * SEQ) * ZSL; const bf16_t* ZbV = Z + zplane(52 + h) + (size_t)(b * SEQ) * ZSL;
#define B8_STAGE(ri) do { int kr_ = R0 + (ri); kr_ = kr_ > 127 ? 127 : kr_; const int sl_ = (ri) & (B2_NSLOT - 1); \
        const bf16_t* kp_ = ZbK + (size_t)(kr_ * 64 + lane) * ZSL + wid * 8; const bf16_t* vp_ = ZbV + (size_t)(kr_ * 64 + 16 * (wid & 3) + (lane >> 2)) * ZSL + (wid >> 2) * 32 + (lane & 3) * 8; \
        glds16(kp_, (unsigned)__builtin_amdgcn_readfirstlane(kdst + sl_ * SLOTB)); glds16(vp_, (unsigned)__builtin_amdgcn_readfirstlane(vdst + sl_ * SLOTB)); } while (0)
    const int qcol = 16 * mb + (r32 & 15), qrowA = i0 + 2 * p + (r32 >> 4), qrowB = qrowA + 4;
    bf16x8 qa[4], qb[4];
    { const bf16_t* qp = ZbQ + (size_t)(qrowA * 64 + qcol) * ZSL; const bf16_t* qq = ZbQ + (size_t)(qrowB * 64 + qcol) * ZSL;
#pragma unroll
      for (int d0 = 0; d0 < 4; ++d0) { qa[d0] = *(const bf16x8*)(qp + d0 * 16 + hi * 8); qb[d0] = *(const bf16x8*)(qq + d0 * 16 + hi * 8); } }
    asm volatile("" ::: "memory");
#pragma unroll
    for (int ri = 0; ri < 4; ++ri) B8_STAGE(ri);
    float mrun = Bref, lrA = 0.f, lrB = 0.f; f32x16 oa[2], ob[2]; oa[0] = f32x16{}; oa[1] = f32x16{}; ob[0] = f32x16{}; ob[1] = f32x16{}; bool first = false;
    f32x16 cm0, cm1 = f32x16{};
    { int c0w = qcol - 8; c0w = c0w < 0 ? 0 : (c0w > 48 ? 48 : c0w);
#pragma unroll
      for (int r = 0; r < 16; ++r) { const int kc = cs + crow(r, hi); cm0[r] = (kc >= c0w && kc < c0w + 16) ? -Bref : NEGBIG; } }
    const PolB2 PA{tab, i0, R0}, PB{tab, i0 + 4, R0};
    int a0 = i0 + 2 * p - 4; a0 = a0 < 0 ? 0 : (a0 > 120 ? 120 : a0); int a1 = i0 + 2 * p - 3; a1 = a1 < 0 ? 0 : (a1 > 120 ? 120 : a1);
    int b0 = i0 + 2 * p;     b0 = b0 < 0 ? 0 : (b0 > 120 ? 120 : b0); int b1 = i0 + 2 * p + 1; b1 = b1 < 0 ? 0 : (b1 > 120 ? 120 : b1);
#define B8_STEP(PP, QQ, LR, OO) do { __builtin_amdgcn_sched_barrier(0); \
        if (mb == 0)      att_step<0x0FFFu, 0x0FFFu, true>(PP, s, wid, cm0, cm1, kbA, kbB, vbA, vbB, QQ, mrun, LR, OO, wsf, first, r32, hi); \
        else if (mb == 3) att_step<0xFFF0u, 0xFFF0u, true>(PP, s, wid, cm0, cm1, kbA, kbB, vbA, vbB, QQ, mrun, LR, OO, wsf, first, r32, hi); \
        else              att_step<0xFFFFu, 0xFFFFu, true>(PP, s, wid, cm0, cm1, kbA, kbB, vbA, vbB, QQ, mrun, LR, OO, wsf, first, r32, hi); \
        __builtin_amdgcn_sched_barrier(0); } while (0)
#pragma unroll 1
    for (int s = 0; s < NS; ++s) {
        if (s == 0) { ATT_WAIT_BAR(4); } else { ATT_WAIT_BAR(0); }
        if (s >= 1 && 2 * s + 2 < NR) { B8_STAGE(2 * s + 2); B8_STAGE(2 * s + 3); }
        const int krA = R0 + 2 * s;
        const int slA = (2 * s) & (B2_NSLOT - 1), slB = (2 * s + 1) & (B2_NSLOT - 1);
        const lds_cptr kbA = kpl + slA * SLOTB, kbB = kpl + slB * SLOTB; const int vbA = vbl + slA * SLOTB, vbB = vbl + slB * SLOTB;
        if (krA + 1 >= a0 && krA <= a1 + 7) B8_STEP(PA, qa, lrA, oa);
        if (krA + 1 >= b0 && krA <= b1 + 7) B8_STEP(PB, qb, lrB, ob);
    }
    ATT_LBAR();
    bf16_t* Ob = O + (size_t)(b * SEQ) * OP + 256 + 64 * h;
    LAS bf16_t* stg = (LAS bf16_t*)(shm + B2_OST) + wid * 2048;
#define B8_OUT(LR, OO, ROW0) do { float l_ = LR; \
        { auto rr = __builtin_amdgcn_permlane32_swap(__float_as_uint(l_), __float_as_uint(l_), false, false); l_ = __uint_as_float(rr[0]) + __uint_as_float(rr[1]); } \
        if (hi == 0) wsf[32 + r32] = l_; \
        asm volatile("s_waitcnt lgkmcnt(0)" ::: "memory"); \
        _Pragma("unroll") for (int r = 0; r < 16; ++r) { const int orow = crow(r, hi); const float rl_ = fast_rcp(wsf[32 + orow]); \
            _Pragma("unroll") for (int d0 = 0; d0 < 2; ++d0) { const float v = OO[d0][r] * rl_; stg[orow * 64 + d0 * 32 + r32] = (bf16_t)(cvt_pk_bf16(v, v) & 0xffffu); } } \
        asm volatile("s_waitcnt lgkmcnt(0)" ::: "memory"); \
        _Pragma("unroll") for (int i = 0; i < 4; ++i) { const int row = i * 8 + (lane >> 3), ch = lane & 7; const u32x4 v = *(const LAS u32x4*)(stg + row * 64 + ch * 8); \
            *(u32x4*)(Ob + (size_t)(((ROW0) + (row >> 4)) * 64 + 16 * mb + (row & 15)) * OP + ch * 8) = v; } \
        asm volatile("s_waitcnt lgkmcnt(0)" ::: "memory"); } while (0)
    B8_OUT(lrA, oa, i0 + 2 * p);
    B8_OUT(lrB, ob, i0 + 4 + 2 * p);
    ATT_LBAR();
#undef B8_STAGE
#undef B8_STEP
#undef B8_OUT
}
struct PolA {
    static constexpr int KIND = 2;
    bf16_t* Z; float* LSE; const LAS float* tab; int b, g, h, rate, rho, u, nblk; bool dry;
    __device__ __forceinline__ int ntiles() const { return 6; }
    __device__ __forceinline__ size_t tokrow(int didx) const { return (size_t)(b * SEQ + didx * rate + rho); }
    __device__ __forceinline__ size_t zrow(int didx) const { return (size_t)(b * SEQ + rho * (SEQ / rate) + didx); }
    __device__ __forceinline__ const bf16_t* qrow(int wid, int r32) const { return Z + zplane(4 * g + h) + zrow(256 * u + 32 * wid + r32) * ZSL; }
    __device__ __forceinline__ int blk(int j) const { int bj = 4 * u - 1 + j; return bj < 0 ? 0 : (bj >= nblk ? nblk - 1 : bj); }
    __device__ __forceinline__ const bf16_t* kptr(int j, int row) const { return Z + zplane(12 + 4 * g + h) + zrow(64 * blk(j) + row) * ZSL; }
    __device__ __forceinline__ const bf16_t* vptr(int j, int row) const { return Z + zplane(24 + 4 * g + h) + zrow(64 * blk(j) + row) * ZSL; }
    __device__ __forceinline__ bool active(int j, int wid) const { const int bj = 4 * u - 1 + j, d = bj - (4 * u + (wid >> 1)); return bj >= 0 && bj < nblk && d >= -1 && d <= 1; }
    __device__ __forceinline__ void prep(f32x16&, f32x16&, int, int, int) const {}
    template <unsigned L0, unsigned L1> __device__ __forceinline__ void cinit(f32x16& c0, f32x16& c1, const f32x16&, const f32x16&, float mhat, int j, int wid, int r32, int hi) const {
        const int qi = 256 * u + 32 * wid + r32; const LAS float* base = tab + (64 * (4 * u - 1 + j) - qi + 4 * hi + 127);
#pragma unroll
        for (int r = 0; r < 16; ++r) { const int kc = (r & 3) + 8 * (r >> 2); c0[r] = L0 ? base[kc] - mhat : 0.f; c1[r] = L1 ? base[kc + 32] - mhat : 0.f; }
    }
    __device__ __forceinline__ bool skip_out() const { return dry; }
    __device__ __forceinline__ int pattern(int j, int wid) const { const int d = (4 * u - 1 + j) - (4 * u + (wid >> 1)); return (d < 0 && (wid & 1)) ? 3 : ((d > 0 && !(wid & 1)) ? 4 : 0); }
    __device__ __forceinline__ void store_lse(int wid, int r32, int hi, float m, float l) const {
        if (hi == 0) LSE[tokrow(256 * u + 32 * wid + r32) * 12 + g * 4 + h] = (m + __builtin_amdgcn_logf(l)) * 0.6931471805599453f;
    }
    __device__ __forceinline__ bf16_t* optr(int wid, int row) const { return Z + zplane(4 * g + h) + zrow(256 * u + 32 * wid + row) * ZSL; }
};
__device__ __forceinline__ int t5_bucket(int rel) {
    const int ret = rel > 0 ? 16 : 0; const int n = rel < 0 ? -rel : rel;
    const float nf = (float)(n < 1 ? 1 : n);
    int large = 8 + (int)(__logf(nf / 8.0f) / 4.852030263919617f * 8.0f);
    large = large > 15 ? 15 : large;
    return ret + (n < 8 ? n : large);
}
}

namespace attp {
using bf16=__hip_bfloat16;
__device__ __forceinline__ int crow(int r,int hi){return (r&3)+8*(r>>2)+4*hi;}
#define SBAR() __builtin_amdgcn_sched_barrier(0)
constexpr int NSLOT=3, SLOTB=8192;
constexpr int NW=8, QBLK=32, KVBLK=64; constexpr int LDS_K=0, LDS_V=NSLOT*SLOTB, LDS_WS=2*NSLOT*SLOTB, LDS_OST=LDS_WS+NW*64*4, LDS_BYTES=LDS_OST+NW*4096;
__device__ __forceinline__ void glds16(const void*gsrc,unsigned lds_dst){unsigned keep;
  asm volatile("s_mov_b32 %0, m0\n\ts_mov_b32 m0, %2\n\ts_nop 0\n\tglobal_load_lds_dwordx4 %1, off\n\ts_mov_b32 m0, %0":"=&s"(keep):"v"(gsrc),"s"(lds_dst):"memory");}
__device__ __forceinline__ float max3f(float a,float b,float c){float r;asm("v_max3_f32 %0, %1, %2, %3":"=v"(r):"v"(a),"v"(b),"v"(c));return r;}
__device__ __forceinline__ float max2f(float a,float b){float r;asm("v_max_f32_e32 %0, %1, %2":"=v"(r):"v"(a),"v"(b));return r;}
__device__ __forceinline__ float fadd_s(float a,float b){float r;asm("v_add_f32_e32 %0, %1, %2":"=v"(r):"v"(a),"v"(b));return r;}
__device__ __forceinline__ float fsub_s(float a,float b){float r;asm("v_sub_f32_e32 %0, %1, %2":"=v"(r):"v"(a),"v"(b));return r;}
typedef float f32x2_t __attribute__((ext_vector_type(2)));
__device__ __forceinline__ unsigned cvtpk_s(float lo,float hi){f32x2_t v={lo,hi};bf16x2_t b=__builtin_convertvector(v,bf16x2_t);return __builtin_bit_cast(unsigned,b);}
#define WAIT_BAR(N) asm volatile("s_waitcnt vmcnt(" #N ") lgkmcnt(0)\n\ts_barrier":::"memory")

typedef __attribute__((address_space(3))) const char* lds_cptr;
__device__ __forceinline__ void qkt(f32x16&p0,f32x16&p1,lds_cptr Kslot,const bf16x8*qr,const f32x16&negm,int r32,int hi){
  lds_cptr kb=Kslot+hi*1024+r32*16;
  #pragma unroll
  for(int d0=0;d0<4;++d0){
    const bf16x8 b0=*(const __attribute__((address_space(3))) bf16x8*)(kb+d0*2048);
    const bf16x8 b1=*(const __attribute__((address_space(3))) bf16x8*)(kb+d0*2048+512);
    if(d0==0){p0=__builtin_amdgcn_mfma_f32_32x32x16_bf16(b0,qr[0],negm,0,0,0);p1=__builtin_amdgcn_mfma_f32_32x32x16_bf16(b1,qr[0],negm,0,0,0);}
    else{p0=__builtin_amdgcn_mfma_f32_32x32x16_bf16(b0,qr[d0],p0,0,0,0);p1=__builtin_amdgcn_mfma_f32_32x32x16_bf16(b1,qr[d0],p1,0,0,0);}}
}
typedef short v4i16_t __attribute__((ext_vector_type(4)));
__device__ __forceinline__ void kload8(bf16x8*kf,lds_cptr kp){
  kf[0]=*(const __attribute__((address_space(3))) bf16x8*)(kp);      kf[1]=*(const __attribute__((address_space(3))) bf16x8*)(kp+512);
  kf[2]=*(const __attribute__((address_space(3))) bf16x8*)(kp+2048); kf[3]=*(const __attribute__((address_space(3))) bf16x8*)(kp+2560);
  kf[4]=*(const __attribute__((address_space(3))) bf16x8*)(kp+4096); kf[5]=*(const __attribute__((address_space(3))) bf16x8*)(kp+4608);
  kf[6]=*(const __attribute__((address_space(3))) bf16x8*)(kp+6144); kf[7]=*(const __attribute__((address_space(3))) bf16x8*)(kp+6656);
}
__device__ __forceinline__ void kload2(bf16x8*kf,lds_cptr kp,int j){ kf[2*j]=*(const __attribute__((address_space(3))) bf16x8*)(kp+j*2048); kf[2*j+1]=*(const __attribute__((address_space(3))) bf16x8*)(kp+j*2048+512); }
__device__ __forceinline__ s16x4 vtr(lds_cptr p){ return __builtin_bit_cast(s16x4,__builtin_amdgcn_ds_read_tr16_b64_v4i16((__attribute__((address_space(3))) v4i16_t*)p)); }
__device__ __forceinline__ float rowmax(const f32x16&p0,const f32x16&p1){
  float a=max3f(p0[0],p0[1],p1[0]),b=max3f(p0[2],p0[3],p1[1]);a=max3f(a,p1[2],p1[3]);
  #pragma unroll
  for(int r=4;r<16;r+=4){a=max3f(a,p0[r],p0[r+1]);b=max3f(b,p0[r+2],p0[r+3]);a=max3f(a,p1[r],p1[r+1]);b=max3f(b,p1[r+2],p1[r+3]);}
  const float m=max2f(a,b);
  auto rr=__builtin_amdgcn_permlane32_swap(__float_as_uint(m),__float_as_uint(m),false,false);
  return max2f(__uint_as_float(rr[0]),__uint_as_float(rr[1]));
}
__device__ __forceinline__ void pv(f32x16*o,int vb,bf16x8 pa0,bf16x8 pa1,bf16x8 pa2,bf16x8 pa3){
  #pragma unroll
  for(int d0=0;d0<2;++d0){s16x4 lo[4],hi[4];
    #pragma unroll
    for(int ks=0;ks<4;++ks){
      asm volatile("ds_read_b64_tr_b16 %0,%1 offset:%c2":"=&v"(lo[ks]):"v"(vb),"i"(d0*4096+ks*1024):"memory");
      asm volatile("ds_read_b64_tr_b16 %0,%1 offset:%c2":"=&v"(hi[ks]):"v"(vb),"i"(d0*4096+ks*1024+512):"memory");}
    asm volatile("s_waitcnt lgkmcnt(0)":::"memory");SBAR();
    #define PK(k) (bf16x8){lo[k][0],lo[k][1],lo[k][2],lo[k][3],hi[k][0],hi[k][1],hi[k][2],hi[k][3]}
    o[d0]=__builtin_amdgcn_mfma_f32_32x32x16_bf16(pa0,PK(0),o[d0],0,0,0);
    o[d0]=__builtin_amdgcn_mfma_f32_32x32x16_bf16(pa1,PK(1),o[d0],0,0,0);
    o[d0]=__builtin_amdgcn_mfma_f32_32x32x16_bf16(pa2,PK(2),o[d0],0,0,0);
    o[d0]=__builtin_amdgcn_mfma_f32_32x32x16_bf16(pa3,PK(3),o[d0],0,0,0);
    #undef PK
  }
}
#ifndef ATTN_STORE16
#define ATTN_STORE16(p,v) (*(u32x4*)(p)=(v))
#endif
template<int THRL,int KP,int OPITCH,bool FIXREF> __device__ __forceinline__ void attn_unit(const bf16*Qw,const bf16*__restrict__ Kh,const bf16*__restrict__ Vh,bf16*Ow,const int NT,const float Bref,__attribute__((address_space(3))) char*shm){
  int tid=threadIdx.x; asm volatile("":"+v"(tid)); const int lane=tid&63,r32=lane&31,hi=lane>>5; const int wid=__builtin_amdgcn_readfirstlane(tid>>6);
  const unsigned lds0=(unsigned)(uintptr_t)shm;
  __attribute__((address_space(3))) float*wsf=(__attribute__((address_space(3))) float*)(shm+LDS_WS)+wid*64;
  const bf16*ksrc=Kh+(long)lane*KP+wid*8;
  const bf16*vsrc=Vh+(long)(16*(wid&3)+(lane>>2))*KP+(wid>>2)*32+(lane&3)*8;
  const unsigned kdst=lds0+LDS_K+wid*1024, vdst=lds0+LDS_V+wid*1024;
  #define DMA_K(t,slot) glds16(ksrc+(long)(t)*KVBLK*KP,(unsigned)__builtin_amdgcn_readfirstlane(kdst+(slot)))
  #define DMA_V(t,slot) glds16(vsrc+(long)(t)*KVBLK*KP,(unsigned)__builtin_amdgcn_readfirstlane(vdst+(slot)))
  const int vb0=(int)(lds0+LDS_V)+((lane>>4)&1)*32+(lane&3)*8+(4*hi+((lane&15)>>2))*64;
  bf16x8 kf[8];
  const lds_cptr shm3=(lds_cptr)shm; const lds_cptr kp0=shm3+LDS_K+hi*1024+r32*16; const lds_cptr vp0=shm3+LDS_V+((lane>>4)&1)*32+(lane&3)*8+(4*hi+((lane&15)>>2))*64;
  DMA_K(0,0);DMA_V(0,0);DMA_K(1,SLOTB);
  bf16x8 qr[4];
  #pragma unroll
  for(int d0=0;d0<4;++d0)qr[d0]=*reinterpret_cast<const bf16x8*>(&Qw[(long)r32*KP+d0*16+hi*8]);
  float mhat=FIXREF?Bref:0.f,l_reg=0.f;f32x16 o[2];o[0]=f32x16{};o[1]=f32x16{};f32x16 negm=f32x16{};
  if constexpr(FIXREF){ _Pragma("unroll") for(int r=0;r<16;++r)negm[r]=-Bref; }
  asm volatile("":"+v"(negm));
  #define CMASK(P0,P1,t) do{}while(0)
  bool resc=false;
  #define START(P0,P1) do{ resc=false; if constexpr(!FIXREF) { const float rm=rowmax(P0,P1); \
    { const float dl=rm; mhat=fadd_s(mhat,dl); \
      _Pragma("unroll") for(int r=0;r<16;++r){P0[r]=fsub_s(P0[r],dl);P1[r]=fsub_s(P1[r],dl);} \
      _Pragma("unroll") for(int r=0;r<16;++r)negm[r]=-mhat; asm volatile("":"+v"(negm)); } } \
    _Pragma("unroll") for(int r=0;r<16;++r)P0[r]=__builtin_amdgcn_exp2f(P0[r]); }while(0)
  #define RESC() do{ if(resc){ asm volatile("s_waitcnt lgkmcnt(0)":::"memory"); \
      _Pragma("unroll") for(int d_=0;d_<2;++d_) _Pragma("unroll") for(int r=0;r<16;++r)o[d_][r]*=wsf[crow(r,hi)]; } }while(0)
  f32x16 pA0,pA1,pB0,pB1;
  int sl_prev=0,sl_cur=0,sl_next=SLOTB;
  #define ROT() do{sl_prev=sl_cur;sl_cur=sl_next;sl_next=(sl_next==(NSLOT-1)*SLOTB)?0:sl_next+SLOTB;}while(0)
  DMA_K(2,2*SLOTB);
  WAIT_BAR(3);
  qkt(pA0,pA1,shm3+LDS_K,qr,negm,r32,hi);asm volatile("s_nop 15\n\ts_nop 7":"+v"(pA0),"+v"(pA1));CMASK(pA0,pA1,0);
  START(pA0,pA1);
  _Pragma("unroll") for(int r=0;r<16;++r)pA1[r]=__builtin_amdgcn_exp2f(pA1[r]);
  WAIT_BAR(0);
  DMA_K(3,0);DMA_V(1,SLOTB);
  ROT();
  kload8(kf,kp0+sl_cur);
  WAIT_BAR(2);
  s16x4 vlo[8],vhi[8]; u32x4 pw0,pw1,pw2,pw3;
  #define PKW(P,B) cvtpk_s(P[B],P[B+1])
  #define PAF(k) __builtin_bit_cast(bf16x8,pw##k)
  #define VFR(i) (bf16x8){vlo[i][0],vlo[i][1],vlo[i][2],vlo[i][3],vhi[i][0],vhi[i][1],vhi[i][2],vhi[i][3]}
  #define PIN(x) asm volatile("":"+v"(x))
  #define MX3(a,b,c) __builtin_fmaxf(__builtin_fmaxf((a),(b)),(c))
  #define GAPA(MF,A0,A1,A2,A3,W0,W1,PW) do{ MF; sacc+=A0; sacc+=A1; sacc+=A2; sacc+=A3; PIN(sacc); W0; W1; PIN(PW); SBAR(); }while(0)
  #define EX(v) __builtin_amdgcn_exp2f(v)
  #define GAPB(MF,X,B) do{ MF; X[B]=EX(X[B]); X[B+1]=EX(X[B+1]); X[B+2]=EX(X[B+2]); X[B+3]=EX(X[B+3]); PIN(X); SBAR(); }while(0)
  #define VRD(i) do{ vlo[i]=vtr(vp_+(((i)>>2)*4096+((i)&3)*1024)); vhi[i]=vtr(vp_+(((i)>>2)*4096+((i)&3)*1024+512)); }while(0)
  #define KRD(G,j) do{ if(G){ kload2(kf,kp0+sl_next,j); SBAR(); } }while(0)
  #define STEP(C0,C1,P0,P1,t,GK,GV,GL) do{ SBAR(); \
    const lds_cptr vp_=vp0+sl_prev; \
    VRD(0); SBAR(); float sacc=(P0[0]+P0[1]); \
    GAPA(C0=__builtin_amdgcn_mfma_f32_32x32x16_bf16(kf[0],qr[0],negm,0,0,0), P0[2],P0[3],P0[4],P0[5],     pw0[0]=PKW(P0,0), pw0[1]=PKW(P0,2), pw0); \
    VRD(4); SBAR(); GAPA(C1=__builtin_amdgcn_mfma_f32_32x32x16_bf16(kf[1],qr[0],negm,0,0,0), P0[6],P0[7],P0[8],P0[9],     pw0[2]=PKW(P0,4), pw0[3]=PKW(P0,6), pw0); \
    VRD(1); SBAR(); GAPA(C0=__builtin_amdgcn_mfma_f32_32x32x16_bf16(kf[2],qr[1],C0,0,0,0),   P0[10],P0[11],P0[12],P0[13], pw1[0]=PKW(P0,8), pw1[1]=PKW(P0,10), pw1); \
    VRD(5); SBAR(); GAPA(C1=__builtin_amdgcn_mfma_f32_32x32x16_bf16(kf[3],qr[1],C1,0,0,0),   P0[14],P0[15],P1[0],P1[1],   pw1[2]=PKW(P0,12),pw1[3]=PKW(P0,14), pw1); \
    VRD(2); SBAR(); GAPA(C0=__builtin_amdgcn_mfma_f32_32x32x16_bf16(kf[4],qr[2],C0,0,0,0),   P1[2],P1[3],P1[4],P1[5],     pw2[0]=PKW(P1,0), pw2[1]=PKW(P1,2), pw2); \
    VRD(6); SBAR(); GAPA(C1=__builtin_amdgcn_mfma_f32_32x32x16_bf16(kf[5],qr[2],C1,0,0,0),   P1[6],P1[7],P1[8],P1[9],     pw2[2]=PKW(P1,4), pw2[3]=PKW(P1,6), pw2); \
    VRD(3); SBAR(); GAPA(C0=__builtin_amdgcn_mfma_f32_32x32x16_bf16(kf[6],qr[3],C0,0,0,0),   P1[10],P1[11],P1[12],P1[13], pw3[0]=PKW(P1,8), pw3[1]=PKW(P1,10), pw3); \
    VRD(7); SBAR(); GAPA(C1=__builtin_amdgcn_mfma_f32_32x32x16_bf16(kf[7],qr[3],C1,0,0,0),   P1[14],P1[15],0.f,0.f,       pw3[2]=PKW(P1,12),pw3[3]=PKW(P1,14), pw3); \
    l_reg+=sacc; \
    if(GK){DMA_K((t)+3,sl_cur);} if(GV){DMA_V((t)+1,sl_next);} \
    CMASK(C0,C1,t); \
    resc=false; \
    if constexpr(!FIXREF) { float a=MX3(C0[0],C0[1],C1[0]),b=MX3(C0[2],C0[3],C1[1]); a=MX3(a,C1[2],C1[3]); \
      _Pragma("unroll") for(int r=4;r<16;r+=4){a=MX3(a,C0[r],C0[r+1]);b=MX3(b,C0[r+2],C0[r+3]);a=MX3(a,C1[r],C1[r+1]);b=MX3(b,C1[r+2],C1[r+3]);} \
      float rm=__builtin_fmaxf(a,b); { auto rr=__builtin_amdgcn_permlane32_swap(__float_as_uint(rm),__float_as_uint(rm),false,false); rm=__builtin_fmaxf(__uint_as_float(rr[0]),__uint_as_float(rr[1])); } \
      resc=false; \
      if(__builtin_expect(__any(rm>(float)THRL),0)){ const float dl=__builtin_fmaxf(rm,0.f); mhat+=dl; \
        _Pragma("unroll") for(int r=0;r<16;++r){C0[r]-=dl;C1[r]-=dl;} \
        _Pragma("unroll") for(int r=0;r<16;++r)negm[r]=-mhat; asm volatile("":"+v"(negm)); \
        const float f=__builtin_amdgcn_exp2f(-dl); l_reg*=f; if(hi==0)wsf[r32]=f; resc=true; } } \
    SBAR(); \
    GAPB(o[0]=__builtin_amdgcn_mfma_f32_32x32x16_bf16(PAF(0),VFR(0),o[0],0,0,0), C0,0); \
    GAPB(o[1]=__builtin_amdgcn_mfma_f32_32x32x16_bf16(PAF(0),VFR(4),o[1],0,0,0), C0,4); \
    KRD(GL,0); GAPB(o[0]=__builtin_amdgcn_mfma_f32_32x32x16_bf16(PAF(1),VFR(1),o[0],0,0,0), C0,8); \
    KRD(GL,1); GAPB(o[1]=__builtin_amdgcn_mfma_f32_32x32x16_bf16(PAF(1),VFR(5),o[1],0,0,0), C0,12); \
    KRD(GL,2); GAPB(o[0]=__builtin_amdgcn_mfma_f32_32x32x16_bf16(PAF(2),VFR(2),o[0],0,0,0), C1,0); \
    KRD(GL,3); GAPB(o[1]=__builtin_amdgcn_mfma_f32_32x32x16_bf16(PAF(2),VFR(6),o[1],0,0,0), C1,4); \
    GAPB(o[0]=__builtin_amdgcn_mfma_f32_32x32x16_bf16(PAF(3),VFR(3),o[0],0,0,0), C1,8); \
    GAPB(o[1]=__builtin_amdgcn_mfma_f32_32x32x16_bf16(PAF(3),VFR(7),o[1],0,0,0), C1,12); \
    }while(0)
  int t=1;
  for(;t+5<NT;t+=2){
    STEP(pB0,pB1,pA0,pA1,t,true,true,true);     WAIT_BAR(2); RESC(); ROT();
    STEP(pA0,pA1,pB0,pB1,t+1,true,true,true);   WAIT_BAR(2); RESC(); ROT();
  }
  #define ENDW(tt) do{ if((tt)+3<NT){WAIT_BAR(2);} else if((tt)+2<NT){WAIT_BAR(1);} else {WAIT_BAR(0);} }while(0)
  for(;t+1<NT;t+=2){
    STEP(pB0,pB1,pA0,pA1,t,(t+3<NT),(t+1<NT),(t+1<NT));       ENDW(t);   RESC(); ROT();
    STEP(pA0,pA1,pB0,pB1,t+1,(t+4<NT),(t+2<NT),(t+2<NT));     ENDW(t+1); RESC(); ROT();
  }
  STEP(pB0,pB1,pA0,pA1,NT-1,false,false,false); RESC();
  { float sacc=pB0[0]+pB0[1]; _Pragma("unroll") for(int r=2;r<16;++r)sacc+=pB0[r]; _Pragma("unroll") for(int r=0;r<16;++r)sacc+=pB1[r]; l_reg+=sacc;
    pw0=(u32x4){PKW(pB0,0),PKW(pB0,2),PKW(pB0,4),PKW(pB0,6)};pw1=(u32x4){PKW(pB0,8),PKW(pB0,10),PKW(pB0,12),PKW(pB0,14)};pw2=(u32x4){PKW(pB1,0),PKW(pB1,2),PKW(pB1,4),PKW(pB1,6)};pw3=(u32x4){PKW(pB1,8),PKW(pB1,10),PKW(pB1,12),PKW(pB1,14)};
    SBAR(); pv(o,vb0+sl_cur,PAF(0),PAF(1),PAF(2),PAF(3)); }
  #undef PKW
  #undef PAF
  #undef VFR
  #undef PIN
  #undef MX3
  #undef GAPA
  #undef GAPB
  #undef EX
  #undef VRD
  #undef KRD
  #undef STEP
  #undef ENDW
  {auto rr=__builtin_amdgcn_permlane32_swap(__float_as_uint(l_reg),__float_as_uint(l_reg),false,false);l_reg=__uint_as_float(rr[0])+__uint_as_float(rr[1]);}
  if(hi==0)wsf[32+r32]=l_reg;asm volatile("s_waitcnt lgkmcnt(0)":::"memory");
  float rli[16];
  #pragma unroll
  for(int r=0;r<16;++r)rli[r]=__builtin_amdgcn_rcpf(wsf[32+crow(r,hi)]);
  { __attribute__((address_space(3))) unsigned short*stg=(__attribute__((address_space(3))) unsigned short*)(shm+LDS_OST)+wid*2048;
    #pragma unroll
    for(int r=0;r<16;++r){const int orow=crow(r,hi);
      #pragma unroll
      for(int d0=0;d0<2;++d0){const float v_=o[d0][r]*rli[r]; stg[orow*64+d0*32+r32]=(unsigned short)(cvtpk_s(v_,v_)&0xffffu);}}
    asm volatile("s_waitcnt lgkmcnt(0)":::"memory");
    #pragma unroll
    for(int i=0;i<4;++i){const int row=i*8+(lane>>3),ch=lane&7; const u32x4 v=*(const __attribute__((address_space(3))) u32x4*)(stg+row*64+ch*8); ATTN_STORE16(Ow+(long)row*OPITCH+ch*8,v);} }
  asm volatile("s_waitcnt lgkmcnt(0)\n\ts_barrier":::"memory");
  #undef DMA_K
  #undef DMA_V
  #undef CMASK
  #undef START
  #undef RESC
  #undef ROT
}
constexpr int ATTN_LDS_BYTES=LDS_BYTES;
#undef SBAR
#undef WAIT_BAR
}

#define XB_TMO      128
#define XB_XCNT(j)  (256  + 64 * (j))
#define XB_XSUB(j)  (1280 + 64 * (j))
#define XB_XGEN(j)  (2304 + 64 * (j))
#define XB_TOP      3328
#define XB_TOPGEN   3392
#define XCD_BAR_WORDS 3456
#define XB_SPIN_CAP (1u << 22)
__device__ __forceinline__ unsigned xb_ld(unsigned* p)              { return __hip_atomic_load(p, __ATOMIC_RELAXED, __HIP_MEMORY_SCOPE_AGENT); }
__device__ __forceinline__ unsigned xb_add(unsigned* p, unsigned v) { return __hip_atomic_fetch_add(p, v, __ATOMIC_RELAXED, __HIP_MEMORY_SCOPE_AGENT); }
__device__ __forceinline__ unsigned xb_xcc_id() { return (unsigned)__builtin_amdgcn_s_getreg((3 << 11) | 20) & 0xFu; }
#define XB_SPIN(cond, bar) do { unsigned _sp = 0; while (cond) { __builtin_amdgcn_s_sleep(1); \
    if ((++_sp & 255u) == 0u) { if (xb_ld(&(bar)[XB_TMO])) break; if (_sp > XB_SPIN_CAP) { atomicAdd(&(bar)[XB_TMO], 1u); break; } } } } while (0)
struct XcdBarrier { unsigned* bar; unsigned x; volatile LAS unsigned* st; };
__device__ __forceinline__ XcdBarrier xcd_barrier_post(unsigned* bar, volatile LAS unsigned* st) {
    XcdBarrier b; b.bar = bar; b.x = xb_xcc_id(); b.st = st;
    if (threadIdx.x == 0) (void)xb_add(&bar[XB_XCNT(b.x)], 1u);
    return b;
}
__device__ __forceinline__ void xcd_barrier_complete(unsigned* bar, unsigned x, unsigned& nloc, unsigned& nx) {
    const unsigned G = gridDim.x * gridDim.y * gridDim.z;
    unsigned sum, cnt, mine, sp = 0u;
    for (;;) {
        sum = 0u; cnt = 0u; mine = 0u;
#pragma unroll
        for (unsigned j = 0; j < 16; ++j) { const unsigned c = xb_ld(&bar[XB_XCNT(j)]); sum += c; cnt += (c > 0u) ? 1u : 0u; mine = (j == x) ? c : mine; }
        if (sum == G) break;
        __builtin_amdgcn_s_sleep(1);
        if ((++sp & 255u) == 0u) { if (xb_ld(&bar[XB_TMO])) break; if (sp > XB_SPIN_CAP) { atomicAdd(&bar[XB_TMO], 1u); break; } }
    }
    nloc = mine > 0u ? mine : 1u; nx = cnt > 0u ? cnt : 1u;
}
__device__ __forceinline__ void xcd_barrier(const XcdBarrier& b) {
    asm volatile("s_waitcnt vmcnt(0)" ::: "memory");
    __syncthreads();
    if (threadIdx.x == 0) {
        unsigned* bar = b.bar;
        __builtin_amdgcn_s_waitcnt(0);
        unsigned nloc = b.st[0], nx = b.st[1];
        if (nloc == 0u) { xcd_barrier_complete(bar, b.x, nloc, nx); b.st[0] = nloc; b.st[1] = nx; }
        asm volatile("buffer_inv sc1" ::: "memory");
        const unsigned old = xb_add(&bar[XB_XSUB(b.x)], 1u);
        const unsigned gen = old / nloc;
        if (old + 1u == (gen + 1u) * nloc) {
            __builtin_amdgcn_fence(__ATOMIC_RELEASE, "agent");
            asm volatile("s_waitcnt vmcnt(0)" ::: "memory");
            const unsigned og = xb_add(&bar[XB_TOP], 1u);
            const unsigned tg = og / nx;
            if (og + 1u == (tg + 1u) * nx) xb_add(&bar[XB_TOPGEN], 1u);
            else XB_SPIN(xb_ld(&bar[XB_TOPGEN]) == tg, bar);
            asm volatile("" ::: "memory");
            xb_add(&bar[XB_XGEN(b.x)], 1u);
            asm volatile("s_waitcnt vmcnt(0)" ::: "memory");
        } else {
            XB_SPIN(xb_ld(&bar[XB_XGEN(b.x)]) == gen, bar);
            asm volatile("s_waitcnt vmcnt(0)" ::: "memory");
        }
    }
    __syncthreads();
}

__device__ __forceinline__ unsigned f2bf(float f) { unsigned u = __builtin_bit_cast(unsigned, f); return (u + 0x7fffu + ((u >> 16) & 1u)) >> 16; }
__device__ __forceinline__ unsigned pk2(float lo, float hi) { return f2bf(lo) | (f2bf(hi) << 16); }
__device__ __forceinline__ int perm32_inv(int s) { return 16 * ((s >> 2) & 1) + 4 * (s >> 3) + (s & 3); }
__device__ __forceinline__ int rowmap(int kind, int c) {
    if (kind == 0) {
        const int pn = c >> 8, wc = (c >> 6) & 3, bj = (c >> 5) & 1, low = c & 31;
        if (c < NQKV) return 256 * pn + 128 * bj + 32 * wc + low;
        return 256 * pn + 128 * bj + 32 * wc + perm32_inv(low);
    }
    if (kind == 1) { const int pn = c >> 8, wc = (c >> 6) & 3, bj = (c >> 5) & 1, low = c & 31; return 256 * pn + 128 * bj + 32 * wc + perm32_inv(low); }
    if (kind == 3) { const int half = c >= DFF ? 1 : 0, cc = c - DFF * half, pn = cc >> 7, q = cc & 127; return 256 * pn + 128 * half + (q & ~31) + perm32_inv(q & 31); }
    if (kind == 4) { const int pn = c >> 8, wc = (c >> 6) & 3, bj = (c >> 5) & 1, low = c & 31; return 256 * pn + 128 * bj + 32 * wc + low; }
    return c;
}
__device__ __forceinline__ void p0_transpose_item(const float* W, int N, const float* scale, bf16_t* WT, int ldk, int koff, int kind, LAS float* scr, int item, int lane) {
    const int nblk = N / 32, kb = item / nblk, nb = item % nblk, k0 = 64 * kb, n0 = 32 * nb;
    float wv[32];
#pragma unroll
    for (int i = 0; i < 32; ++i) wv[i] = __builtin_nontemporal_load(&W[(size_t)(k0 + 2 * i + (lane >> 5)) * N + n0 + (lane & 31)]);
    if (scale) {
#pragma unroll
        for (int i = 0; i < 32; ++i) wv[i] *= scale[k0 + 2 * i + (lane >> 5)];
    }
#pragma unroll
    for (int i = 0; i < 32; ++i) scr[(2 * i + (lane >> 5)) * 33 + (lane & 31)] = wv[i];
    asm volatile("s_waitcnt lgkmcnt(0)" ::: "memory");
    const int c = lane & 7;
#pragma unroll
    for (int j = 0; j < 4; ++j) { const int n = (lane >> 3) + 8 * j; const LAS float* s = scr + (8 * c) * 33 + n;
        u32x4 o; o.x = pk2(s[0 * 33], s[1 * 33]); o.y = pk2(s[2 * 33], s[3 * 33]); o.z = pk2(s[4 * 33], s[5 * 33]); o.w = pk2(s[6 * 33], s[7 * 33]);
        *(u32x4*)(WT + (size_t)rowmap(kind, n0 + n) * ldk + koff + k0 + 8 * c) = o; }
    asm volatile("s_waitcnt lgkmcnt(0)" ::: "memory");
}

struct Args { const float* in[13]; float* out; unsigned char* ws; int ph_lo, ph_hi, li, pad; };
constexpr int NPHASE = 1 + 8 * DEPTH;

__device__ __forceinline__ void convert_weights(const Args& args, int l, LAS unsigned char* lds, int gw, int NGW, int wave, int lane) {
    unsigned char* ws = args.ws;
    LAS float* scr = (LAS float*)(lds + wave * 16384);
    const float* w_in = args.in[3] + (size_t)l * DM * INW; const float* n1 = args.in[2] + l * DM;
    const float* pa = args.in[6] + (size_t)l * 256 * DM; const float* pb = args.in[7] + (size_t)l * 512 * DM; const float* pc = args.in[8] + (size_t)l * 512 * DM;
    const float* w_o = args.in[9] + (size_t)l * DM * DM; const float* n2 = args.in[10] + l * DM;
    const float* w_up = args.in[11] + (size_t)l * DM * 2 * DFF; const float* w_dn = args.in[12] + (size_t)l * DFF * DM;
    constexpr int I_IN = (DM / 64) * (INW / 32), I_PA = (256 / 64) * (DM / 32), I_PB = (512 / 64) * (DM / 32), I_O = (DM / 64) * (DM / 32), I_UP = (DM / 64) * (2 * DFF / 32), I_DN = (DFF / 64) * (DM / 32);
    constexpr int NITEMS = I_IN + I_PA + 2 * I_PB + I_O + I_UP + I_DN;
    for (int it = gw; it < NITEMS; it += NGW) {
        int r = it;
        if (r < I_IN) { p0_transpose_item(w_in, INW, n1, (bf16_t*)(ws + WS_WIN), DM, 0, 0, scr, r, lane); continue; } r -= I_IN;
        if (r < I_PA) { p0_transpose_item(pa, DM, nullptr, (bf16_t*)(ws + WS_PCAT), OP, 0, 1, scr, r, lane); continue; } r -= I_PA;
        if (r < I_PB) { p0_transpose_item(pb, DM, nullptr, (bf16_t*)(ws + WS_PCAT), OP, 256, 1, scr, r, lane); continue; } r -= I_PB;
        if (r < I_PB) { p0_transpose_item(pc, DM, nullptr, (bf16_t*)(ws + WS_PCAT), OP, 768, 1, scr, r, lane); continue; } r -= I_PB;
        if (r < I_O) { p0_transpose_item(w_o, DM, nullptr, (bf16_t*)(ws + WS_WO), DM, 0, 4, scr, r, lane); continue; } r -= I_O;
        if (r < I_UP) { p0_transpose_item(w_up, 2 * DFF, n2, (bf16_t*)(ws + WS_WUP), DM, 0, 3, scr, r, lane); continue; } r -= I_UP;
        p0_transpose_item(w_dn, DM, nullptr, (bf16_t*)(ws + WS_WDN), DFF, 0, 4, scr, r, lane);
    }
}

struct MergeA {
    const bf16_t* Z; bf16_t* OB; const float* LSE; int gw, NGW, lane;
    __device__ __forceinline__ void operator()() const {
#pragma unroll 1
        for (int t2 = 4 * gw; t2 < MTOK / 2; t2 += 4 * NGW) {
            u32x4 a[4], b[4], c[4]; float l0[4], l1[4], l2[4];
            const int q = lane & 31, h = q >> 3;
#pragma unroll
            for (int k = 0; k < 4; ++k) { const int tok = 2 * (t2 + k) + (lane >> 5);
                const float* ls = LSE + (size_t)tok * 12 + h; l0[k] = ls[0]; l1[k] = ls[4]; l2[k] = ls[8];
                const int dq = 8 * (q & 7);
                a[k] = __builtin_nontemporal_load((const u32x4*)(Z + zplane(h) + (size_t)tok * ZSL + dq));
                b[k] = __builtin_nontemporal_load((const u32x4*)(Z + zplane(4 + h) + (size_t)zperm(tok, 2) * ZSL + dq));
                c[k] = __builtin_nontemporal_load((const u32x4*)(Z + zplane(8 + h) + (size_t)zperm(tok, 4) * ZSL + dq)); }
#pragma unroll
            for (int k = 0; k < 4; ++k) { const int tok = 2 * (t2 + k) + (lane >> 5);
                const float mx = fmaxf(l0[k], fmaxf(l1[k], l2[k])); float w0 = fast_exp2((l0[k] - mx) * LOG2E), w1 = fast_exp2((l1[k] - mx) * LOG2E), w2 = fast_exp2((l2[k] - mx) * LOG2E);
                const float inv = fast_rcp(w0 + w1 + w2); w0 *= inv; w1 *= inv; w2 *= inv;
                u32x4 o;
                o.x = cvt_pk_bf16(w0 * bf_lo(a[k].x) + w1 * bf_lo(b[k].x) + w2 * bf_lo(c[k].x), w0 * bf_hi(a[k].x) + w1 * bf_hi(b[k].x) + w2 * bf_hi(c[k].x));
                o.y = cvt_pk_bf16(w0 * bf_lo(a[k].y) + w1 * bf_lo(b[k].y) + w2 * bf_lo(c[k].y), w0 * bf_hi(a[k].y) + w1 * bf_hi(b[k].y) + w2 * bf_hi(c[k].y));
                o.z = cvt_pk_bf16(w0 * bf_lo(a[k].z) + w1 * bf_lo(b[k].z) + w2 * bf_lo(c[k].z), w0 * bf_hi(a[k].z) + w1 * bf_hi(b[k].z) + w2 * bf_hi(c[k].z));
                o.w = cvt_pk_bf16(w0 * bf_lo(a[k].w) + w1 * bf_lo(b[k].w) + w2 * bf_lo(c[k].w), w0 * bf_hi(a[k].w) + w1 * bf_hi(b[k].w) + w2 * bf_hi(c[k].w));
                *(u32x4*)(OB + (size_t)tok * OP + 8 * q) = o; }
        }
    }
};
__device__ __forceinline__ float block_max8(float v, LAS float* scr, int tid) {
#pragma unroll
    for (int o = 1; o < 64; o <<= 1) v = fmaxf(v, shx(v, o));
    if ((tid & 63) == 0) scr[tid >> 6] = v;
    __syncthreads();
    float r = scr[0];
#pragma unroll
    for (int i = 1; i < 8; ++i) r = fmaxf(r, scr[i]);
    __syncthreads();
    return r;
}
#ifndef ATT_DO_A
#define ATT_DO_A 1
#endif
#ifndef ATT_DO_B
#define ATT_DO_B 1
#endif
#ifndef ATT_DO_C
#define ATT_DO_C 1
#endif
#ifndef TIME_G3
#define TIME_G3 1
#endif
#ifndef TIME_A
#define TIME_A 1
#endif
#ifndef TIME_G1A
#define TIME_G1A 1
#endif
#ifndef TIME_G1B
#define TIME_G1B 1
#endif
#ifndef TIME_G2
#define TIME_G2 1
#endif
#ifndef TIME_G4
#define TIME_G4 1
#endif
#ifndef TIME_C
#define TIME_C 1
#endif
#ifndef TIME_B
#define TIME_B 1
#endif
#ifndef PHMASK
#define PHMASK 0x1FF
#endif
#define PHON(j) (((PHMASK) >> (j)) & 1)
#define OPAQUE_S(x) asm volatile("" : "+s"(x))
#define OPAQUE_V(x) asm volatile("" : "+v"(x))
__global__ void __launch_bounds__(512, 2) fwd_megakernel(Args args) {
    extern __shared__ __attribute__((aligned(16))) unsigned char lds_raw[];
    LAS unsigned char* lds = (LAS unsigned char*)lds_raw;
    volatile LAS unsigned* MISC = (volatile LAS unsigned*)(lds + MISC_OFF);
    const int G = gridDim.x; const int bx = blockIdx.x;
    { const int tid0 = threadIdx.x; for (int u = tid0; u < (STG_OFF - LDSCTL_OFF) / 4; u += 512) ((LAS unsigned*)(lds + LDSCTL_OFF))[u] = 0u; }
    __syncthreads();
    const int lo = args.ph_lo, hi = args.ph_hi;
    const bool multi = (hi - lo) > 1;
    XcdBarrier bar; bar.bar = (unsigned*)(args.ws + WS_CTL) + CW_BAR + args.li * XCD_BAR_WORDS; bar.x = 0; bar.st = nullptr;
    if (multi) bar = xcd_barrier_post((unsigned*)(args.ws + WS_CTL) + CW_BAR + args.li * XCD_BAR_WORDS, MISC + 8);
#define IN(k) (lo <= (k) && (k) < hi)
#define SEAM(k) do { if (IN(k) && IN((k) + 1)) xcd_barrier(bar); } while (0)
#define PHASE_LOCALS() unsigned zoff_ = 0u; OPAQUE_S(zoff_); unsigned char* ws = args.ws + zoff_; int tid = threadIdx.x; OPAQUE_V(tid); const int lane = tid & 63, wave = __builtin_amdgcn_readfirstlane(tid >> 6); \
    const int vcu = (G % 8 == 0) ? (bx % 8) * (G / 8) + bx / 8 : bx; const int gw = vcu * 8 + wave, NGW = G * 8; (void)lane; (void)gw; (void)NGW; (void)vcu

    if (PHON(0) && IN(0)) {
        PHASE_LOCALS();
        convert_weights(args, 0, lds, gw, NGW, wave, lane);
        float* ssq = (float*)(ws + WS_SSQ); bf16_t* XB0 = (bf16_t*)(ws + WS_XB0); const float* xin0 = args.in[0];
#pragma unroll 1
        for (int m0 = 4 * gw; m0 < MTOK; m0 += 4 * NGW) {
            f32x4 v[4][4];
#pragma unroll
            for (int rr = 0; rr < 4; ++rr) { const f32x4* xr = (const f32x4*)(xin0 + (size_t)(m0 + rr) * DM) + lane;
#pragma unroll
                for (int j = 0; j < 4; ++j) v[rr][j] = __builtin_nontemporal_load(&xr[64 * j]); }
#pragma unroll
            for (int rr = 0; rr < 4; ++rr) { float s = 0.f;
#pragma unroll
                for (int j = 0; j < 4; ++j) s += (v[rr][j].x * v[rr][j].x + v[rr][j].y * v[rr][j].y) + (v[rr][j].z * v[rr][j].z + v[rr][j].w * v[rr][j].w);
#pragma unroll
                for (int o = 1; o < 64; o <<= 1) s += shx(s, o);
                u32x2* o8 = (u32x2*)(XB0 + (size_t)(m0 + rr) * DM) + lane;
#pragma unroll
                for (int j = 0; j < 4; ++j) { u32x2 w; w.x = cvt_pk_bf16(v[rr][j].x, v[rr][j].y); w.y = cvt_pk_bf16(v[rr][j].z, v[rr][j].w); o8[64 * j] = w; }
                if (lane < 16) ssq[(size_t)(m0 + rr) * 16 + lane] = (lane == 0) ? s : 0.f; }
        }
    }
    SEAM(0);

#pragma unroll 1
    for (int l = 0; l < DEPTH; ++l) {
        const int pb = 1 + 8 * l;
        if (PHON(0) && IN(pb)) { if (l > 0) { PHASE_LOCALS(); (void)ws; convert_weights(args, l, lds, gw, NGW, wave, lane); } }
        if (l > 0) SEAM(pb);
        if (PHON(1) && IN(pb + 1)) {
            PHASE_LOCALS();
            const pg8::Order<1> S = pg8::make_order<1>((l == 0) ? (const bf16_t*)(ws + WS_XB0) : (const bf16_t*)args.out, DM, (const bf16_t*)(ws + WS_WIN), DM, MTOK, NQKV, DM, G, bx);
            EpiQKV E{(bf16_t*)(ws + WS_BIG), (const float*)(ws + WS_SSQ), args.in[4] + l * 6 * 64};
            for (int rep = 0; rep < TIME_G1A; ++rep) {
                const int fullr = S.nwg / G, tailn = S.nwg - fullr * G;
                if (2 * tailn == G) { pg8::Order<1> S2 = S; S2.maxr = fullr;
                    pg8::Unit tu; S.tile_of(fullr * G + (bx % tailn), tu);
                    pg8::gemm_phase(lds, S2, DM, DM, E, S.A + (size_t)tu.pm * S.tstepA + (size_t)(bx / tailn) * 128 * DM * 2, S.Bt + (size_t)tu.pn * S.tstepB);
                    pg8::gemm_half_phase(lds, S, fullr * G + (bx % tailn), bx / tailn, DM, DM, E, true); }
                else pg8::gemm_phase(lds, S, DM, DM, E); }
        }
        SEAM(pb + 1);
        if (PHON(2) && IN(pb + 2)) {
            PHASE_LOCALS();
            bf16_t* Z = (bf16_t*)(ws + WS_BIG); bf16_t* OB = (bf16_t*)(ws + WS_OBUF); float* LSE = (float*)(ws + WS_LSE);
            LAS char* shm = (LAS char*)lds;
            float BrefA, BrefB, BrefC;
            LAS float* mxscr = (LAS float*)(shm + att::LDS_TAB + 4096);
            { const float* gq = args.in[4] + l * 6 * 64;
              if (tid < 64) { float v[6];
#pragma unroll
                  for (int t = 0; t < 6; ++t) v[t] = fabsf(gq[t * 64 + tid]);
#pragma unroll
                  for (int o = 1; o < 64; o <<= 1)
#pragma unroll
                      for (int t = 0; t < 6; ++t) v[t] = fmaxf(v[t], shx(v[t], o));
                  if (tid == 0) {
#pragma unroll
                      for (int t = 0; t < 6; ++t) mxscr[8 + t] = v[t]; } }
              __syncthreads();
              BrefA = 64.0f * mxscr[8] * mxscr[9] * C2 * 1.02f; BrefB = 64.0f * mxscr[10] * mxscr[11] * C2 * 1.02f; BrefC = 64.0f * mxscr[12] * mxscr[13] * C2 * 1.02f; }
#pragma unroll 1
            for (int i = 0; i < 2 * TIME_C * ATT_DO_C; ++i) { const int id = vcu * 2 + (i & 1); const int bh = id >> 5; const int b = bh >> 3, h = bh & 7, qb = id & 31;
                const bf16_t* Qw = Z + zplane(60 + h) + (size_t)(b * SEQ + qb * 256 + wave * 32) * ZSL;
                const bf16_t* Kh = Z + zplane(68 + (h >> 2)) + (size_t)(b * SEQ) * ZSL; const bf16_t* Vh = Z + zplane(70 + (h >> 2)) + (size_t)(b * SEQ) * ZSL;
                bf16_t* Ow = OB + (size_t)(b * SEQ + qb * 256 + wave * 32) * OP + 768 + 64 * h;
                attp::attn_unit<8, ZSL, OP, true>((const attp::bf16*)Qw, (const attp::bf16*)Kh, (const attp::bf16*)Vh, (attp::bf16*)Ow, SEQ / 64, BrefC, shm); }
            LAS float* tab = (LAS float*)(shm + att::LDS_TAB);
            const float* rpb = args.in[5] + (size_t)l * 8 * 15 * 31;
            for (int rep = 0; rep < TIME_B * ATT_DO_B; ++rep) { const int idb = vcu;
                const int hB = (idb >> 4) & 7;
                LAS float* tabB = (LAS float*)(shm + att::B2_TAB);
                float bmx = 0.f;
                for (int e = tid; e < 16 * 128; e += 512) { const int dr = e >> 7, dc = (e & 127) - 48; const float tv = dr == 15 ? NEGBIG : ((dc >= 0 && dc <= 30) ? rpb[hB * 465 + dr * 31 + dc] * LOG2E : 0.f); tabB[e] = tv; if (dr != 15) bmx = fmaxf(bmx, tv); }
                const float BrefBu = BrefB + block_max8(bmx, mxscr, tid);
                att::unit_b8(Z, OB, tabB, (idb >> 7) & 1, hB, 8 * (idb & 15), BrefBu, shm); }
            const float* rbt = args.in[1];
            { const float bv = (tid < 32 * 12) ? fabsf(rbt[tid]) * LOG2E : 0.f; BrefA += block_max8(bv, mxscr, tid); }
#define MK_POLA(ii, PA) const int ida_##PA = vcu * 3 + ((ii) % 3); const int bgh_##PA = ida_##PA >> 5, sub_##PA = ida_##PA & 31; const int g_##PA = (bgh_##PA % 12) >> 2; \
            const int rate_##PA = g_##PA == 0 ? 1 : (g_##PA == 1 ? 4 : 16); const int rho_##PA = g_##PA == 0 ? 0 : (g_##PA == 1 ? (sub_##PA >> 3) : (sub_##PA >> 1)); const int u_##PA = g_##PA == 0 ? sub_##PA : (g_##PA == 1 ? (sub_##PA & 7) : (sub_##PA & 1)); \
            const att::PolA PA{Z, LSE, tab, bgh_##PA / 12, g_##PA, bgh_##PA & 3, rate_##PA, rho_##PA, u_##PA, (SEQ / rate_##PA) / 64, (ii) >= 3}
            int tab_gh = -1;
#pragma unroll 1
            for (int i = 3 * (TIME_A - 1); i >= 0 && i < 3 * TIME_A * ATT_DO_A; i = (i == 5 ? 0 : (i == 2 ? 99 : i + 1))) { MK_POLA(i, Pc); MK_POLA((i % 3) + 1 < 3 ? i + 1 : i, Pn);
                if (Pc.g * 4 + Pc.h != tab_gh) { tab_gh = Pc.g * 4 + Pc.h;
                    if (tid < 255) { const int d = tid - 127; tab[tid] = (d >= -64 && d <= 64) ? rbt[att::t5_bucket(d * Pc.rate) * 12 + Pc.g * 4 + Pc.h] * LOG2E : NEGBIG; } }
                att::unit_simple<att::PolA>(Pc, (i % 3) > 0, Pn, (i % 3) + 1 < 3, BrefA, shm); }
#undef MK_POLA
        }
        SEAM(pb + 2);
        if (PHON(3) && IN(pb + 3)) {
            PHASE_LOCALS();
            const MergeA mrg{(const bf16_t*)(ws + WS_BIG), (bf16_t*)(ws + WS_OBUF), (const float*)(ws + WS_LSE), gw, NGW, lane};
            const pg8::Order<1> S = pg8::make_order<1>((l == 0) ? (const bf16_t*)(ws + WS_XB0) : (const bf16_t*)args.out, DM, (const bf16_t*)(ws + WS_WIN) + (size_t)NQKV * DM, DM, MTOK, NGATE, DM, G, bx);
            EpiGate E{(bf16_t*)(ws + WS_BIG) + ZGOFF, (const float*)(ws + WS_SSQ)};
            for (int rep = 0; rep < TIME_G1B; ++rep) pg8::gemm_phase(lds, S, DM, DM, E, nullptr, nullptr, mrg);
        }
        SEAM(pb + 3);
        if (PHON(4) && IN(pb + 4)) {
            PHASE_LOCALS();
            const pg8::Order<3> S = pg8::make_order<3>((const bf16_t*)(ws + WS_OBUF), OP, (const bf16_t*)(ws + WS_PCAT), OP, MTOK, DM, 256, G, bx);
            EpiBranch E{(const bf16_t*)(ws + WS_BIG) + ZGOFF, (bf16_t*)(ws + WS_XB0)};
            for (int rep = 0; rep < TIME_G2; ++rep) pg8::gemm_phase(lds, S, OP, OP, E);
        }
        SEAM(pb + 4);
        if (PHON(5) && IN(pb + 5)) {
            PHASE_LOCALS();
            const pg8::Order<1> S = pg8::make_order<1>((const bf16_t*)(ws + WS_XB0), DM, (const bf16_t*)(ws + WS_WO), DM, MTOK, DM, DM, G, bx);
            if (l == 0) { EpiRes<true, false> E{(const void*)args.in[0], nullptr, (bf16_t*)(ws + WS_OBUF), (float*)(ws + WS_SSQ)}; pg8::gemm_phase(lds, S, DM, DM, E); }
            else { EpiRes<false, false> E{(const void*)args.out, nullptr, (bf16_t*)(ws + WS_OBUF), (float*)(ws + WS_SSQ)}; pg8::gemm_phase(lds, S, DM, DM, E); }
        }
        SEAM(pb + 5);
        if (PHON(6) && IN(pb + 6)) {
            PHASE_LOCALS();
            const pg8::Order<1> S = pg8::make_order<1>((const bf16_t*)(ws + WS_OBUF), DM, (const bf16_t*)(ws + WS_WUP), DM, MTOK, 2 * DFF, DM, G, bx);
            EpiSwiglu E{(bf16_t*)(ws + WS_BIG), (const float*)(ws + WS_SSQ)};
            for (int rep = 0; rep < TIME_G4; ++rep) {
                const int fullr = S.nwg / G, tailn = S.nwg - fullr * G;
                if (2 * tailn == G) { pg8::Order<1> S2 = S; S2.maxr = fullr;
                    pg8::Unit tu; S.tile_of(fullr * G + (bx % tailn), tu);
                    pg8::gemm_phase(lds, S2, DM, DM, E, S.A + (size_t)tu.pm * S.tstepA + (size_t)(bx / tailn) * 128 * DM * 2, S.Bt + (size_t)tu.pn * S.tstepB);
                    pg8::gemm_half_phase(lds, S, fullr * G + (bx % tailn), bx / tailn, DM, DM, E, true); }
                else pg8::gemm_phase(lds, S, DM, DM, E); }
        }
        SEAM(pb + 6);
        if (PHON(7) && IN(pb + 7)) {
            PHASE_LOCALS();
            const pg8::Order<1> S = pg8::make_order<1>((const bf16_t*)(ws + WS_BIG), DFF, (const bf16_t*)(ws + WS_WDN), DFF, MTOK, DM, DFF, G, bx);
            if (l + 1 < DEPTH) { EpiRes<false, false> E{(const void*)(ws + WS_OBUF), nullptr, (bf16_t*)args.out, (float*)(ws + WS_SSQ)}; pg8::gemm_phase(lds, S, DFF, DFF, E); }
            else { EpiRes<false, true> E{(const void*)(ws + WS_OBUF), args.out, nullptr, (float*)(ws + WS_SSQ)}; pg8::gemm_phase(lds, S, DFF, DFF, E); }
        }
        SEAM(pb + 7);
    }
#undef IN
#undef SEAM
}

#ifndef MK_PER_PHASE
#define MK_PER_PHASE 0
#endif
extern "C" void kernel_launch(void* const* d_in, const int* in_sizes, int n_in, void* d_out, int out_size, void* d_ws, size_t ws_size, hipStream_t stream) {
    static int grid = 0;
    if (grid == 0) {
        if (n_in != 13 || out_size != MTOK * DM || ws_size < WS_END) { fprintf(stderr, "kernel_launch: unexpected shapes (n_in %d, out %d, ws %zu)\n", n_in, out_size, ws_size); grid = -1; return; }
        int dev = 0, cus = 0, per_cu = 0;
        if (hipGetDevice(&dev) != hipSuccess || hipDeviceGetAttribute(&cus, hipDeviceAttributeMultiprocessorCount, dev) != hipSuccess) { grid = -1; return; }
        if (hipFuncSetAttribute((const void*)fwd_megakernel, hipFuncAttributeMaxDynamicSharedMemorySize, LDS_BYTES) != hipSuccess) { fprintf(stderr, "kernel_launch: hipFuncSetAttribute failed\n"); grid = -1; return; }
        if (hipOccupancyMaxActiveBlocksPerMultiprocessor(&per_cu, (const void*)fwd_megakernel, 512, LDS_BYTES) != hipSuccess || per_cu < 1) { fprintf(stderr, "kernel_launch: occupancy query says %d blocks per CU\n", per_cu); grid = -1; (void)hipGetLastError(); return; }
        (void)hipGetLastError();
        grid = cus;
        if (grid != 256) fprintf(stderr, "kernel_launch: %d CUs (built for 256)\n", grid);
    }
    if (grid < 0) return;
    if (hipMemsetAsync((char*)d_ws + WS_CTL, 0, CTL_ZERO_BYTES, stream) != hipSuccess) return;
    Args a{};
    for (int i = 0; i < 13; ++i) a.in[i] = (const float*)d_in[i];
    a.out = (float*)d_out; a.ws = (unsigned char*)d_ws;
#if MK_PER_PHASE
    for (int p = 0; p < NPHASE; ++p) { a.ph_lo = p; a.ph_hi = p + 1; a.li = 0; hipLaunchKernelGGL(fwd_megakernel, dim3(grid), dim3(512), LDS_BYTES, stream, a); }
#else
    a.ph_lo = 0; a.ph_hi = NPHASE; a.li = 0;
    hipLaunchKernelGGL(fwd_megakernel, dim3(grid), dim3(512), LDS_BYTES, stream, a);
#endif
}
```

```cpp
#define ATT_PRE0 1
#include <hip/hip_runtime.h>
#include <hip/hip_bf16.h>
#include <cstdio>
#include <cstdint>

#define LAS __attribute__((address_space(3)))
#define GAS __attribute__((address_space(1)))
typedef unsigned short bf16_t;
typedef short bf16x8 __attribute__((ext_vector_type(8)));
typedef short s16x4 __attribute__((ext_vector_type(4)));
typedef float f32x4 __attribute__((ext_vector_type(4)));
typedef float f32x2 __attribute__((ext_vector_type(2)));
typedef float f32x16 __attribute__((ext_vector_type(16)));
typedef unsigned u32x4 __attribute__((ext_vector_type(4)));
typedef unsigned u32x2 __attribute__((ext_vector_type(2)));

constexpr int BATCH = 2, SEQ = 8192, MTOK = BATCH * SEQ, DM = 1024, DEPTH = 2;
constexpr int ZP = 4608;
constexpr int ZQA = 0, ZKA = 768, ZVA = 1536, ZQB = 2304, ZKB = 2816, ZVB = 3328, ZQC = 3840, ZKC = 4352, ZVC = 4480;
constexpr int ZSL = 64;
constexpr size_t ZGOFF = (size_t)12 * 16384 * 64;
constexpr int ZGP = 3072;
constexpr int ZGATE = 768;
constexpr int INW = 7680, NQKV = 4608, NGATE = 3072;
constexpr int OP = 1280;
constexpr int DFF = 2816;
constexpr float RMS_EPS = 1e-6f;
constexpr float LOG2E = 1.4426950408889634f;
constexpr float C2 = 0.125f * LOG2E;
constexpr float NEGBIG = -1e30f;

constexpr size_t MiB = 1u << 20;
constexpr size_t WS_CTL = 0, CTL_ZERO_BYTES = 64 * 1024;
constexpr size_t WS_SSQ = 1 * MiB;
constexpr size_t WS_WIN = 2 * MiB;
constexpr size_t WS_PCAT = 17 * MiB;
constexpr size_t WS_WO = WS_PCAT + 1024 * 1280 * 2;
constexpr size_t WS_WUP = WS_WO + 2 * MiB;
constexpr size_t WS_WDN = WS_WUP + 11 * MiB;
constexpr size_t WS_XB0 = 38 * MiB;
constexpr size_t WS_BIG = 70 * MiB;
constexpr size_t WS_OBUF = 214 * MiB;
constexpr size_t WS_LSE = 254 * MiB;
constexpr size_t WS_END = 256 * MiB;
static_assert(WS_WDN + (size_t)1024 * 2816 * 2 <= WS_XB0, "weights fit");
constexpr int CW_BAR = 4096;

constexpr int RING_BYTES = 131072;
constexpr int LDSCTL_OFF = RING_BYTES, MISC_OFF = LDSCTL_OFF + 320;
constexpr int STG_OFF = 132096, STG_ROW = 144, STG_WAVE = 16 * STG_ROW;
constexpr int RSTAB_OFF = STG_OFF + 8 * STG_WAVE;
constexpr int LDS_BYTES = 151552;
static_assert(MISC_OFF + 128 <= STG_OFF && RSTAB_OFF + 1024 <= LDS_BYTES, "LDS map");

typedef __bf16 bf16x2_t __attribute__((ext_vector_type(2)));
__device__ __forceinline__ unsigned cvt_pk_bf16(float lo, float hi) { f32x2 v = {lo, hi}; bf16x2_t b = __builtin_convertvector(v, bf16x2_t); return __builtin_bit_cast(unsigned, b); }
__device__ __forceinline__ float bf_lo(unsigned u) { return __uint_as_float(u << 16); }
__device__ __forceinline__ float bf_hi(unsigned u) { return __uint_as_float(u & 0xffff0000u); }
__device__ __forceinline__ float fast_exp2(float x) { return __builtin_amdgcn_exp2f(x); }
__device__ __forceinline__ float fast_rcp(float x) { return __builtin_amdgcn_rcpf(x); }
__device__ __forceinline__ float sigmoidf_(float x) { return fast_rcp(1.0f + fast_exp2(-x * LOG2E)); }

struct RsFill { f32x4 a, b, c, d; };
__device__ __forceinline__ void rs_fill_issue(RsFill& f, const float* ssq, int row0, int nrows, int tid) {
    if (tid < nrows) { const f32x4* p = (const f32x4*)(ssq + (size_t)(row0 + tid) * 16); f.a = p[0]; f.b = p[1]; f.c = p[2]; f.d = p[3]; }
}
__device__ __forceinline__ void rs_fill_finish(const RsFill& f, LAS float* tab, int nrows, int tid) {
    if (tid < nrows) { const float sm = ((f.a.x + f.a.y) + (f.a.z + f.a.w)) + ((f.b.x + f.b.y) + (f.b.z + f.b.w)) + ((f.c.x + f.c.y) + (f.c.z + f.c.w)) + ((f.d.x + f.d.y) + (f.d.z + f.d.w));
        tab[tid] = __builtin_amdgcn_rsqf(sm * (1.0f / 1024.0f) + RMS_EPS); }
}
__device__ __forceinline__ void fill_rs_table(LAS float* tab, const float* ssq, int row0, int nrows, int tid) { RsFill f; rs_fill_issue(f, ssq, row0, nrows, tid); rs_fill_finish(f, tab, nrows, tid); }
namespace pg8 {
constexpr int BM = 256, BK = 64, HALF = 128, HTB = HALF * BK * 2, STAGE_BYTES = 8 * HTB, NXCD = 8, WGM = 8;
__host__ __device__ __forceinline__ int lds_byte(int r, int c) { const int st = (r >> 4) * 2 + (c >> 5), rr = r & 15, cc = c & 31, ob = rr * 64 + cc * 2; return st * 1024 + (ob ^ (((ob >> 9) & 1) << 5)); }
__host__ __device__ __forceinline__ void stage_rc(int b, int& R, int& C) { const int st = b / 1024, sb = b % 1024, swz = sb ^ (((sb >> 9) & 1) << 5); R = (st >> 1) * 16 + swz / 64; C = (st & 1) * 32 + (swz % 64) / 2; }

struct Unit { int pm, pn, seg, rowoff, nai; };
template <int NSEG> struct Order {
    int nM, nN, nwg, G, c, ntk, maxr;
    const char* A; const char* Bt; size_t tstepA, tstepB;
    __device__ __forceinline__ void tile_of(int L, Unit& u) const {
        int wgid = L; { const int q = nwg / NXCD, r = nwg % NXCD, xcd = wgid % NXCD, off = wgid / NXCD; wgid = (xcd < r ? xcd * (q + 1) : r * (q + 1) + (xcd - r) * q) + off; }
        const int nig = WGM * nN, gid = wgid / nig, fm = gid * WGM, gsz = (nM - fm) < WGM ? (nM - fm) : WGM;
        u.pm = fm + ((wgid % nig) % gsz); u.pn = (wgid % nig) / gsz; u.rowoff = 0; u.nai = 2;
    }
    __device__ __forceinline__ bool next(int i, Unit& u) const {
        const int ti = i / NSEG; u.seg = i - ti * NSEG;
        if (ti >= maxr) return false;
        const long L = (long)ti * G + c; if (L >= nwg) return false;
        tile_of((int)L, u); return true;
    }
    static __device__ __forceinline__ int koff(int seg) { return NSEG == 1 ? 0 : (seg == 0 ? 0 : (seg == 1 ? 512 : 1536)); }
    __device__ __forceinline__ const char* aptr(const Unit& u) const { return A + (size_t)u.pm * tstepA + koff(u.seg); }
    __device__ __forceinline__ const char* bptr(const Unit& u) const { return Bt + (size_t)u.pn * tstepB + koff(u.seg); }
    __device__ __forceinline__ int nt(const Unit& u) const { return NSEG == 1 ? ntk : (u.seg == 0 ? 4 : 8); }
};
template <int NSEG> __device__ __forceinline__ Order<NSEG> make_order(const bf16_t* A, int lda, const bf16_t* Bt, int ldb, int M, int N, int K, int G, int c) {
    Order<NSEG> o; o.nM = M / BM; o.nN = N / BM; o.nwg = o.nM * o.nN; o.G = G; o.c = c; o.ntk = K / BK; o.maxr = 1 << 20;
    o.A = (const char*)A; o.Bt = (const char*)Bt; o.tstepA = (size_t)BM * lda * 2; o.tstepB = (size_t)BM * ldb * 2; return o;
}

struct NoPre { __device__ __forceinline__ void operator()() const {} };
template <class Epi, class Ord, class Pre = NoPre>
__device__ __forceinline__ void gemm_phase(LAS unsigned char* lds, const Ord S, const int lda, const int ldb, const Epi E, const char* tailA = nullptr, const char* tailB = nullptr, const Pre pre = Pre()) {
    int tid = threadIdx.x; asm volatile("" : "+v"(tid));
    const int wid = __builtin_amdgcn_readfirstlane(tid >> 6), lane = tid & 63, wr = wid >> 2, wc = wid & 3, fr = lane & 15, fq = lane >> 4;
    unsigned voffA[2], voffB[2];
#pragma unroll
    for (int i = 0; i < 2; ++i) { int R, C; stage_rc(tid * 16 + i * 8192, R, C); voffA[i] = (unsigned)(R * lda + C) * 2u; voffB[i] = (unsigned)(R * ldb + C) * 2u; }
    const size_t kstep = (size_t)(BK * 2);
    const size_t hstepA = (size_t)HALF * lda * 2, hstepB = (size_t)HALF * ldb * 2;
    const unsigned ldsw = (unsigned)wid * 1024u;
    const int aoff = lds_byte(wr * 64 + fr, fq * 8), boff = lds_byte(wc * 32 + fr, fq * 8);
#define PG8_SA(b, h) (((b) * 2 + (h)) * HTB)
#define PG8_SB(b, h) ((4 + (b) * 2 + (h)) * HTB)
#define PG8_STAGE(bufoff, gbase, voff) do { _Pragma("unroll") for (int _i = 0; _i < 2; ++_i) \
        __builtin_amdgcn_global_load_lds((const unsigned*)((const char*)(gbase) + (voff)[_i]), (LAS unsigned*)(lds + (bufoff) + ldsw + _i * 8192), 16, 0, 0); } while (0)
#define PG8_LDA(dst, b, h) do { _Pragma("unroll") for (int m = 0; m < 4; ++m) _Pragma("unroll") for (int k = 0; k < 2; ++k) dst[m][k] = *(const LAS bf16x8*)(lds + PG8_SA(b, h) + aoff + m * 2048 + k * 1024); } while (0)
#define PG8_LDB(dst, b, h) do { _Pragma("unroll") for (int n = 0; n < 2; ++n) _Pragma("unroll") for (int k = 0; k < 2; ++k) dst[n][k] = *(const LAS bf16x8*)(lds + PG8_SB(b, h) + boff + n * 2048 + k * 1024); } while (0)
#define PG8_MMA(ai, bj, At, Bt) do { __builtin_amdgcn_s_setprio(1); _Pragma("unroll") for (int m = 0; m < 4; ++m) _Pragma("unroll") for (int n = 0; n < 2; ++n) _Pragma("unroll") for (int k = 0; k < 2; ++k) \
        acc[ai][bj][m][n] = __builtin_amdgcn_mfma_f32_16x16x32_bf16(Bt[n][k], At[m][k], acc[ai][bj][m][n], 0, 0, 0); __builtin_amdgcn_s_setprio(0); } while (0)
#define PG8_WAIT_V(n) asm volatile("s_waitcnt vmcnt(" #n ")" ::: "memory")
#define PG8_WAIT_L(n) asm volatile("s_waitcnt lgkmcnt(" #n ")" ::: "memory")
#define PG8_BAR __builtin_amdgcn_s_barrier()
#define PG8_SCHED __builtin_amdgcn_sched_barrier(0)
    Unit cur, nxt; int ui = 0;
    if (!S.next(0, cur)) return;
    f32x4 acc[2][2][4][2];
#pragma unroll
    for (int a = 0; a < 2; ++a)
#pragma unroll
        for (int b = 0; b < 2; ++b)
#pragma unroll
            for (int m = 0; m < 4; ++m)
#pragma unroll
                for (int n = 0; n < 2; ++n) acc[a][b][m][n] = (f32x4){0.f, 0.f, 0.f, 0.f};
    bf16x8 At[4][2], B0[2][2], B1[2][2];
    const char* cA = S.aptr(cur); const char* cB = S.bptr(cur); int nt = S.nt(cur);
    RsFill rsf; if constexpr (Epi::NEEDS_RS) rs_fill_issue(rsf, E.ssq, cur.pm * 256, 256, tid);
    PG8_STAGE(PG8_SB(0, 0), cB, voffB); PG8_STAGE(PG8_SB(0, 1), cB + hstepB, voffB); PG8_STAGE(PG8_SA(0, 0), cA, voffA); PG8_STAGE(PG8_SA(0, 1), cA + hstepA, voffA);
    if constexpr (Epi::NEEDS_RS) rs_fill_finish(rsf, (LAS float*)(lds + RSTAB_OFF), 256, tid);
    pre();
    if (wr == 1) PG8_BAR;
    PG8_WAIT_V(2); PG8_BAR;
    PG8_STAGE(PG8_SB(1, 0), cB + kstep, voffB); PG8_STAGE(PG8_SA(1, 0), cA + kstep, voffA); PG8_STAGE(PG8_SB(1, 1), cB + hstepB + kstep, voffB);
    PG8_WAIT_V(6); PG8_BAR;
    for (;;) {
        const bool has_next = S.next(ui + 1, nxt);
        const char* nA = has_next ? S.aptr(nxt) : (tailA ? tailA : cA); const char* nB = has_next ? S.bptr(nxt) : (tailB ? tailB : cB);
        for (int t = 0; t < nt; t += 2) {
            const bool last = (t == nt - 2);
            unsigned tk = (unsigned)t * (unsigned)kstep; asm volatile("" : "+s"(tk));
            asm volatile("" : "+v"(voffA[0]), "+v"(voffA[1]), "+v"(voffB[0]), "+v"(voffB[1]));
            const char* a1 = cA + tk + kstep;
            const char* a2 = last ? nA : cA + tk + 2 * kstep; const char* b2 = last ? nB : cB + tk + 2 * kstep;
            const char* a3 = a2 + kstep; const char* b3 = b2 + kstep;
            PG8_LDB(B0, 0, 0); PG8_LDB(B1, 0, 1); PG8_SCHED; PG8_LDA(At, 0, 0); PG8_STAGE(PG8_SA(1, 1), a1 + hstepA, voffA);
            PG8_WAIT_V(8); PG8_WAIT_L(0); PG8_BAR; PG8_MMA(0, 0, At, B0); PG8_MMA(0, 1, At, B1); PG8_BAR; PG8_SCHED;
            PG8_LDA(At, 0, 1); PG8_STAGE(PG8_SB(0, 0), b2, voffB); PG8_STAGE(PG8_SB(0, 1), b2 + hstepB, voffB); PG8_STAGE(PG8_SA(0, 0), a2, voffA);
            PG8_WAIT_V(8); PG8_WAIT_L(0); PG8_BAR; PG8_MMA(1, 0, At, B0); PG8_MMA(1, 1, At, B1); PG8_BAR; PG8_SCHED;
            PG8_LDB(B0, 1, 0); PG8_LDB(B1, 1, 1); PG8_SCHED; PG8_LDA(At, 1, 0); PG8_STAGE(PG8_SA(0, 1), a2 + hstepA, voffA);
            PG8_WAIT_V(8); PG8_WAIT_L(0); PG8_BAR; PG8_MMA(0, 0, At, B0); PG8_MMA(0, 1, At, B1); PG8_BAR; PG8_SCHED;
            PG8_LDA(At, 1, 1); PG8_STAGE(PG8_SB(1, 0), b3, voffB); PG8_STAGE(PG8_SB(1, 1), b3 + hstepB, voffB); PG8_STAGE(PG8_SA(1, 0), a3, voffA);
            PG8_WAIT_V(8); PG8_WAIT_L(0); PG8_BAR; PG8_MMA(1, 0, At, B0); PG8_MMA(1, 1, At, B1); PG8_BAR; PG8_SCHED;
        }
        if (wr == 0) PG8_BAR;
        int fr_ = fr, fq_ = fq; asm volatile("" : "+v"(fr_), "+v"(fq_));
#if defined(EPI_REP)
        if (Epi::IDEMP == EPI_REP) { (void)E(acc, cur, wr, wc, fr_, fq_, lds + STG_OFF + wid * STG_WAVE); }
#endif
        const bool zero = E(acc, cur, wr, wc, fr_, fq_, lds + STG_OFF + wid * STG_WAVE);
        if (!has_next) break;
        if (zero) {
#pragma unroll
        for (int a = 0; a < 2; ++a)
#pragma unroll
            for (int b = 0; b < 2; ++b)
#pragma unroll
                for (int m = 0; m < 4; ++m)
#pragma unroll
                    for (int n = 0; n < 2; ++n) acc[a][b][m][n] = (f32x4){0.f, 0.f, 0.f, 0.f};
        }
        if constexpr (Epi::NEEDS_RS) { if (nxt.pm != cur.pm) {
            asm volatile("s_waitcnt lgkmcnt(0)" ::: "memory"); PG8_BAR; fill_rs_table((LAS float*)(lds + RSTAB_OFF), E.ssq, nxt.pm * 256, 256, tid); asm volatile("s_waitcnt lgkmcnt(0)" ::: "memory"); PG8_BAR; } }
        cur = nxt; cA = nA; cB = nB; nt = S.nt(cur); ++ui;
        if (wr == 1) PG8_BAR;
    }
    PG8_WAIT_V(0);
    PG8_BAR;
#undef PG8_SA
#undef PG8_SB
#undef PG8_STAGE
#undef PG8_LDA
#undef PG8_LDB
#undef PG8_MMA
#undef PG8_WAIT_V
#undef PG8_WAIT_L
#undef PG8_BAR
#undef PG8_SCHED
}

template <class Epi, class Ord>
__device__ __forceinline__ void gemm_half_phase(LAS unsigned char* lds, const Ord S, const int L, const int half, const int lda, const int ldb, const Epi E, const bool prestaged = false) {
    int tid = threadIdx.x; asm volatile("" : "+v"(tid));
    const int wid = __builtin_amdgcn_readfirstlane(tid >> 6), lane = tid & 63, wr = wid >> 2, wc = wid & 3, fr = lane & 15, fq = lane >> 4;
    unsigned voffA[2], voffB[2];
#pragma unroll
    for (int i = 0; i < 2; ++i) { int R, C; stage_rc(tid * 16 + i * 8192, R, C); voffA[i] = (unsigned)(R * lda + C) * 2u; voffB[i] = (unsigned)(R * ldb + C) * 2u; }
    const size_t kstep = (size_t)(BK * 2);
    const size_t hstepA = (size_t)HALF * lda * 2, hstepB = (size_t)HALF * ldb * 2;
    const unsigned ldsw = (unsigned)wid * 1024u;
    const int aoff = lds_byte(wr * 64 + fr, fq * 8), boff = lds_byte(wc * 32 + fr, fq * 8);
#define PG8_SA(b, h) (((b) * 2 + (h)) * HTB)
#define PG8_SB(b, h) ((4 + (b) * 2 + (h)) * HTB)
#define PG8_STAGE(bufoff, gbase, voff) do { _Pragma("unroll") for (int _i = 0; _i < 2; ++_i) \
        __builtin_amdgcn_global_load_lds((const unsigned*)((const char*)(gbase) + (voff)[_i]), (LAS unsigned*)(lds + (bufoff) + ldsw + _i * 8192), 16, 0, 0); } while (0)
#define PG8_LDA(dst, b, h) do { _Pragma("unroll") for (int m = 0; m < 4; ++m) _Pragma("unroll") for (int k = 0; k < 2; ++k) dst[m][k] = *(const LAS bf16x8*)(lds + PG8_SA(b, h) + aoff + m * 2048 + k * 1024); } while (0)
#define PG8_LDB(dst, b, h) do { _Pragma("unroll") for (int n = 0; n < 2; ++n) _Pragma("unroll") for (int k = 0; k < 2; ++k) dst[n][k] = *(const LAS bf16x8*)(lds + PG8_SB(b, h) + boff + n * 2048 + k * 1024); } while (0)
#define PG8_MMA(ai, bj, At, Bt) do { __builtin_amdgcn_s_setprio(1); _Pragma("unroll") for (int m = 0; m < 4; ++m) _Pragma("unroll") for (int n = 0; n < 2; ++n) _Pragma("unroll") for (int k = 0; k < 2; ++k) \
        acc[ai][bj][m][n] = __builtin_amdgcn_mfma_f32_16x16x32_bf16(Bt[n][k], At[m][k], acc[ai][bj][m][n], 0, 0, 0); __builtin_amdgcn_s_setprio(0); } while (0)
#define PG8_WAIT_V(n) asm volatile("s_waitcnt vmcnt(" #n ")" ::: "memory")
#define PG8_WAIT_L(n) asm volatile("s_waitcnt lgkmcnt(" #n ")" ::: "memory")
#define PG8_BAR __builtin_amdgcn_s_barrier()
#define PG8_SCHED __builtin_amdgcn_sched_barrier(0)
    Unit u; S.tile_of(L, u); u.seg = 0; u.rowoff = 128 * half; u.nai = 1;
    f32x4 acc[2][2][4][2];
#pragma unroll
    for (int a = 0; a < 2; ++a)
#pragma unroll
        for (int b = 0; b < 2; ++b)
#pragma unroll
            for (int m = 0; m < 4; ++m)
#pragma unroll
                for (int n = 0; n < 2; ++n) acc[a][b][m][n] = (f32x4){0.f, 0.f, 0.f, 0.f};
    bf16x8 At[4][2], B0[2][2], B1[2][2], Au[4][2], C0[2][2], C1[2][2];
    const char* cA = S.A + (size_t)u.pm * S.tstepA + (size_t)half * hstepA; const char* cB = S.Bt + (size_t)u.pn * S.tstepB; const int nt = S.ntk;
    RsFill rsf; if constexpr (Epi::NEEDS_RS) rs_fill_issue(rsf, E.ssq, u.pm * 256 + 128 * half, 128, tid);
    if (!prestaged) {
        PG8_STAGE(PG8_SB(0, 0), cB, voffB); PG8_STAGE(PG8_SB(0, 1), cB + hstepB, voffB); PG8_STAGE(PG8_SA(0, 0), cA, voffA);
        PG8_STAGE(PG8_SB(1, 0), cB + kstep, voffB); PG8_STAGE(PG8_SB(1, 1), cB + hstepB + kstep, voffB); PG8_STAGE(PG8_SA(1, 0), cA + kstep, voffA);
        PG8_WAIT_V(6); PG8_BAR; }
    PG8_LDB(B0, 0, 0); PG8_LDB(B1, 0, 1); PG8_LDA(At, 0, 0); PG8_WAIT_L(0);
    for (int t = 0; t < nt; t += 2) {
        unsigned tk = (unsigned)t * (unsigned)kstep; asm volatile("" : "+s"(tk));
        asm volatile("" : "+v"(voffA[0]), "+v"(voffA[1]), "+v"(voffB[0]), "+v"(voffB[1]));
        const bool more = (t + 2 < nt);
        PG8_WAIT_V(0); PG8_BAR; PG8_SCHED;
        if (more) { PG8_STAGE(PG8_SB(0, 0), cB + tk + 2 * kstep, voffB); PG8_STAGE(PG8_SB(0, 1), cB + hstepB + tk + 2 * kstep, voffB); PG8_STAGE(PG8_SA(0, 0), cA + tk + 2 * kstep, voffA); }
        PG8_LDB(C0, 1, 0); PG8_LDB(C1, 1, 1); PG8_LDA(Au, 1, 0); PG8_SCHED;
        PG8_MMA(0, 0, At, B0); PG8_MMA(0, 1, At, B1);
        PG8_WAIT_L(0);
        if (more) { PG8_WAIT_V(0); PG8_BAR; PG8_SCHED;
            PG8_STAGE(PG8_SB(1, 0), cB + tk + 3 * kstep, voffB); PG8_STAGE(PG8_SB(1, 1), cB + hstepB + tk + 3 * kstep, voffB); PG8_STAGE(PG8_SA(1, 0), cA + tk + 3 * kstep, voffA);
            PG8_LDB(B0, 0, 0); PG8_LDB(B1, 0, 1); PG8_LDA(At, 0, 0); PG8_SCHED; }
        PG8_MMA(0, 0, Au, C0); PG8_MMA(0, 1, Au, C1);
        PG8_WAIT_L(0);
    }
    if constexpr (Epi::NEEDS_RS) { rs_fill_finish(rsf, (LAS float*)(lds + RSTAB_OFF), 128, tid); PG8_WAIT_L(0); PG8_BAR; }
    int fr_ = fr, fq_ = fq; asm volatile("" : "+v"(fr_), "+v"(fq_));
    (void)E(acc, u, wr, wc, fr_, fq_, lds + STG_OFF + wid * STG_WAVE);
    PG8_WAIT_V(0); PG8_BAR;
#undef PG8_SA
#undef PG8_SB
#undef PG8_STAGE
#undef PG8_LDA
#undef PG8_LDB
#undef PG8_MMA
#undef PG8_WAIT_V
#undef PG8_WAIT_L
#undef PG8_BAR
#undef PG8_SCHED
}
}

__device__ __forceinline__ int zperm(int tok, int lr) { return (tok & ~(SEQ - 1)) + ((tok & ((1 << lr) - 1)) << (13 - lr)) + ((tok & (SEQ - 1)) >> lr); }
__device__ __forceinline__ size_t zplane(int slot) { return (size_t)slot * MTOK * ZSL; }
__device__ __forceinline__ float shx(float v, int o) {
    int l; asm volatile("v_mbcnt_lo_u32_b32 %0, -1, 0\n\tv_mbcnt_hi_u32_b32 %0, -1, %0" : "=v"(l));
    return __int_as_float(__builtin_amdgcn_ds_bpermute((l ^ o) << 2, __float_as_int(v)));
}

__device__ __forceinline__ float row_rs(const float* ssq, int row, int fq) {
    const f32x4 a = *(const f32x4*)(ssq + (size_t)row * 16 + 4 * fq);
    float s = (a.x + a.y) + (a.z + a.w);
    s += shx(s, 16); s += shx(s, 32);
    return __builtin_amdgcn_rsqf(s * (1.0f / 1024.0f) + RMS_EPS);
}
__device__ __forceinline__ float sum_fq4(float x) {
    { auto r = __builtin_amdgcn_permlane32_swap(__float_as_uint(x), __float_as_uint(x), false, false); x = __uint_as_float(r[0]) + __uint_as_float(r[1]); }
    { auto r = __builtin_amdgcn_permlane16_swap(__float_as_uint(x), __float_as_uint(x), false, false); x = __uint_as_float(r[0]) + __uint_as_float(r[1]); }
    return x;
}
#ifndef WT_STORES
#define WT_STORES 1
#endif
__device__ __forceinline__ void store16_wt(void* p, u32x4 v) {
#if WT_STORES
    asm volatile("global_store_dwordx4 %0, %1, off sc1\n\ts_nop 1" :: "v"(p), "v"(v) : "memory");
#else
    *(u32x4*)p = v;
#endif
}
typedef f32x4 acc_t[2][2][4][2];
__device__ __forceinline__ void rows_rs(float (&rs)[8], const float* ssq, int row0, int fq, int nai) {
    f32x4 t[8];
#pragma unroll
    for (int k = 0; k < 8; ++k) t[k] = ((k >> 2) < nai) ? *(const f32x4*)(ssq + (size_t)(row0 + (k >> 2) * 128 + (k & 3) * 16) * 16 + 4 * fq) : (f32x4){1.f, 1.f, 1.f, 1.f};
#pragma unroll
    for (int k = 0; k < 8; ++k) { float s = (t[k].x + t[k].y) + (t[k].z + t[k].w); s += shx(s, 16); s += shx(s, 32); rs[k] = __builtin_amdgcn_rsqf(s * (1.0f / 1024.0f) + RMS_EPS); }
}

struct EpiQKV {
    static constexpr int IDEMP = 1; static constexpr bool NEEDS_RS = true;
    bf16_t* Z; const float* ssq; const float* qkg;
    __device__ __forceinline__ bool operator()(acc_t& acc, const pg8::Unit& u, int wr, int wc, int fr, int fq, LAS unsigned char* stg) const {
        const int pn = u.pn;
        int kind = 0, gi = 0; bool scale = false;
        if (pn < 3) { kind = 1; gi = 0; scale = true; } else if (pn < 6) { kind = 1; gi = 1; } else if (pn < 9) { kind = 0; }
        else if (pn < 11) { kind = 1; gi = 2; scale = true; } else if (pn < 13) { kind = 1; gi = 3; } else if (pn < 15) { kind = 0; }
        else if (pn < 17) { kind = 2; gi = 4; scale = true; } else { if (wc < 2) { kind = 2; gi = 5; } else kind = 0; }
        f32x4 g[2][2];
#pragma unroll
        for (int bj = 0; bj < 2; ++bj)
#pragma unroll
            for (int n = 0; n < 2; ++n) g[bj][n] = kind ? *(const f32x4*)(qkg + gi * 64 + 32 * bj + 16 * n + 4 * fq) * (scale ? C2 : 1.0f) : (f32x4){1.f, 1.f, 1.f, 1.f};
        float inv[4];
#pragma unroll
        for (int e = 0; e < 4; ++e) inv[e] = fast_exp2(-(float)(4 * fq + e) * (13.287712379549449f / 16.0f)) * 0.15915494309189535f;
        const LAS float* rstab = (const LAS float*)(stg - (wr * 4 + wc) * STG_WAVE + 8 * STG_WAVE) + wr * 64 + fr;
#pragma unroll
        for (int ai = 0; ai < 2; ++ai)
#pragma unroll
            for (int m = 0; m < 4; ++m) {
                if (ai >= u.nai) continue;
                const int row = u.pm * 256 + u.rowoff + ai * 128 + wr * 64 + m * 16 + fr;
                const float rs = rstab[ai * 128 + m * 16];
                f32x4 v[2][2];
#pragma unroll
                for (int bj = 0; bj < 2; ++bj)
#pragma unroll
                    for (int n = 0; n < 2; ++n) v[bj][n] = acc[ai][bj][m][n];
                if (kind) {
                    float ss = 0.f;
#pragma unroll
                    for (int bj = 0; bj < 2; ++bj)
#pragma unroll
                        for (int n = 0; n < 2; ++n) { const f32x4 x = v[bj][n]; ss += (x.x * x.x + x.y * x.y) + (x.z * x.z + x.w * x.w); }
                    ss = sum_fq4(ss);
                    const float r = __builtin_amdgcn_rsqf(ss * (rs * rs * (1.0f / 64.0f)) + RMS_EPS);
                    const float sr = rs * r;
#pragma unroll
                    for (int bj = 0; bj < 2; ++bj)
#pragma unroll
                        for (int n = 0; n < 2; ++n) v[bj][n] = v[bj][n] * sr * g[bj][n];
                } else {
#pragma unroll
                    for (int bj = 0; bj < 2; ++bj)
#pragma unroll
                        for (int n = 0; n < 2; ++n) v[bj][n] = v[bj][n] * rs;
                }
                if (kind == 2) {
                    const int t = row & (SEQ - 1); const float pr = (float)(t >> 6), pc = (float)(t & 63);
#pragma unroll
                    for (int bj = 0; bj < 2; ++bj) { const float pos = bj ? pc : pr;
#pragma unroll
                        for (int e = 0; e < 4; ++e) { const float rev = pos * inv[e]; const float c = __builtin_amdgcn_cosf(rev), s = __builtin_amdgcn_sinf(rev);
                            const float x1 = v[bj][0][e], x2 = v[bj][1][e]; v[bj][0][e] = x1 * c - x2 * s; v[bj][1][e] = x1 * s + x2 * c; } }
                }
#pragma unroll
                for (int bj = 0; bj < 2; ++bj)
#pragma unroll
                    for (int n = 0; n < 2; ++n) { const f32x4 x = v[bj][n]; u32x2 w; w.x = cvt_pk_bf16(x.x, x.y); w.y = cvt_pk_bf16(x.z, x.w); *(LAS u32x2*)(stg + fr * STG_ROW + 64 * bj + 32 * n + 8 * fq) = w; }
                { const int lane_ = fq * 16 + fr, r8 = lane_ >> 3, ch = lane_ & 7; const int rowg = row - fr;
                  const u32x4 w0 = *(const LAS u32x4*)(stg + r8 * STG_ROW + 16 * ch), w1 = *(const LAS u32x4*)(stg + (r8 + 8) * STG_ROW + 16 * ch);
                  const int lr_ = (pn < 9) ? 2 * (pn % 3) : 0;
                  bf16_t* zp_ = Z + zplane(4 * pn + wc) + 8 * ch;
                  store16_wt(zp_ + (size_t)zperm(rowg + r8, lr_) * ZSL, w0); store16_wt(zp_ + (size_t)zperm(rowg + r8 + 8, lr_) * ZSL, w1); }
                asm volatile("" ::: "memory");
            }
        return true;
    }
};
struct EpiGate {
    static constexpr int IDEMP = 2; static constexpr bool NEEDS_RS = true;
    bf16_t* G; const float* ssq;
    __device__ __forceinline__ bool operator()(acc_t& acc, const pg8::Unit& u, int wr, int wc, int fr, int fq, LAS unsigned char* stg) const {
        const LAS float* rstab = (const LAS float*)(stg - (wr * 4 + wc) * STG_WAVE + 8 * STG_WAVE) + wr * 64 + fr;
        const int lane_ = fq * 16 + fr, r8 = lane_ >> 3, ch = lane_ & 7;
#pragma unroll
        for (int ai = 0; ai < 2; ++ai)
#pragma unroll
            for (int m = 0; m < 4; ++m) {
                if (ai >= u.nai) continue;
                const int row = u.pm * 256 + u.rowoff + ai * 128 + wr * 64 + m * 16 + fr;
                const float rsn = rstab[ai * 128 + m * 16] * (-LOG2E);
#define GATE_E(v) (1.0f + fast_exp2((v) * rsn))
#pragma unroll
                for (int bj = 0; bj < 2; ++bj) { const f32x4 a = acc[ai][bj][m][0], b = acc[ai][bj][m][1]; u32x4 w;
                    w.x = cvt_pk_bf16(GATE_E(a.x), GATE_E(a.y)); w.y = cvt_pk_bf16(GATE_E(a.z), GATE_E(a.w));
                    w.z = cvt_pk_bf16(GATE_E(b.x), GATE_E(b.y)); w.w = cvt_pk_bf16(GATE_E(b.z), GATE_E(b.w));
                    *(LAS u32x4*)(stg + fr * STG_ROW + 64 * bj + 16 * fq) = w; }
#undef GATE_E
                { const u32x4 w0 = *(const LAS u32x4*)(stg + r8 * STG_ROW + 16 * ch), w1 = *(const LAS u32x4*)(stg + (r8 + 8) * STG_ROW + 16 * ch);
                  bf16_t* gp = G + (size_t)(row - fr + r8) * ZGP + 256 * u.pn + 64 * wc + 8 * ch;
                  store16_wt(gp, w0); store16_wt(gp + (size_t)8 * ZGP, w1); }
                asm volatile("" ::: "memory");
            }
        return true;
    }
};
struct EpiBranch {
    static constexpr int IDEMP = 0; static constexpr bool NEEDS_RS = false;
    const bf16_t* G; bf16_t* Mg;
    __device__ __forceinline__ bool operator()(acc_t& acc, const pg8::Unit& u, int wr, int wc, int fr, int fq, LAS unsigned char* stg) const {
        const int seg = u.seg; const int rowb = u.pm * 256 + wr * 64; const int colw = 256 * u.pn + 64 * wc;
        const int lane_ = fq * 16 + fr, r8 = lane_ >> 3, ch = lane_ & 7;
        constexpr int NBG = 4, LAG = NBG - 1;
        u32x4 gbuf[NBG][4];
#define EBR_ISSUE(k, pp) do { const bf16_t* gp_ = G + (size_t)(rowb + ((k) >> 2) * 128 + ((k) & 3) * 16 + r8) * ZGP + seg * 1024 + colw + 8 * ch; \
            gbuf[pp][0] = __builtin_nontemporal_load((const u32x4*)gp_); gbuf[pp][1] = __builtin_nontemporal_load((const u32x4*)(gp_ + (size_t)8 * ZGP)); \
            if (seg < 2) { gbuf[pp][2] = __builtin_nontemporal_load((const u32x4*)(gp_ + 1024)); gbuf[pp][3] = __builtin_nontemporal_load((const u32x4*)(gp_ + (size_t)8 * ZGP + 1024)); } } while (0)
#pragma unroll
        for (int k0 = 0; k0 < LAG; ++k0) EBR_ISSUE(k0, k0 % NBG);
#pragma unroll
        for (int k = 0; k < 8; ++k) {
            if (k + LAG < 8) EBR_ISSUE(k + LAG, (k + LAG) % NBG);
            const int ai = k >> 2, m = k & 3; const int rowg = rowb + ai * 128 + m * 16;
            u32x4 gc[2], gn[2];
            *(LAS u32x4*)(stg + r8 * STG_ROW + 16 * ch) = gbuf[k % NBG][0]; *(LAS u32x4*)(stg + (r8 + 8) * STG_ROW + 16 * ch) = gbuf[k % NBG][1];
            gc[0] = *(const LAS u32x4*)(stg + fr * STG_ROW + 16 * fq); gc[1] = *(const LAS u32x4*)(stg + fr * STG_ROW + 64 + 16 * fq);
            if (seg < 2) {
                *(LAS u32x4*)(stg + r8 * STG_ROW + 16 * ch) = gbuf[k % NBG][2]; *(LAS u32x4*)(stg + (r8 + 8) * STG_ROW + 16 * ch) = gbuf[k % NBG][3];
                gn[0] = *(const LAS u32x4*)(stg + fr * STG_ROW + 16 * fq); gn[1] = *(const LAS u32x4*)(stg + fr * STG_ROW + 64 + 16 * fq); }
#pragma unroll
            for (int bj = 0; bj < 2; ++bj) {
                const u32x4 gw = gc[bj];
#define ECL(x) fminf((x), 1.152921504606847e18f)
                float f0 = fast_rcp(ECL(bf_lo(gw.x))), f1 = fast_rcp(ECL(bf_hi(gw.x))), f2 = fast_rcp(ECL(bf_lo(gw.y))), f3 = fast_rcp(ECL(bf_hi(gw.y))), f4 = fast_rcp(ECL(bf_lo(gw.z))), f5 = fast_rcp(ECL(bf_hi(gw.z))), f6 = fast_rcp(ECL(bf_lo(gw.w))), f7 = fast_rcp(ECL(bf_hi(gw.w)));
                if (seg < 2) { const u32x4 nw = gn[bj];
                    f0 *= ECL(bf_lo(nw.x)); f1 *= ECL(bf_hi(nw.x)); f2 *= ECL(bf_lo(nw.y)); f3 *= ECL(bf_hi(nw.y));
                    f4 *= ECL(bf_lo(nw.z)); f5 *= ECL(bf_hi(nw.z)); f6 *= ECL(bf_lo(nw.w)); f7 *= ECL(bf_hi(nw.w)); }
#undef ECL
                f32x4 a = acc[ai][bj][m][0], b = acc[ai][bj][m][1];
                a.x *= f0; a.y *= f1; a.z *= f2; a.w *= f3; b.x *= f4; b.y *= f5; b.z *= f6; b.w *= f7;
                if (seg < 2) { acc[ai][bj][m][0] = a; acc[ai][bj][m][1] = b; }
                else { u32x4 w; w.x = cvt_pk_bf16(a.x, a.y); w.y = cvt_pk_bf16(a.z, a.w); w.z = cvt_pk_bf16(b.x, b.y); w.w = cvt_pk_bf16(b.z, b.w);
                    *(LAS u32x4*)(stg + fr * STG_ROW + 64 * bj + 16 * fq) = w; } }
            if (seg == 2) { const u32x4 w0 = *(const LAS u32x4*)(stg + r8 * STG_ROW + 16 * ch), w1 = *(const LAS u32x4*)(stg + (r8 + 8) * STG_ROW + 16 * ch);
                bf16_t* mp = Mg + (size_t)(rowg + r8) * DM + colw + 8 * ch;
                store16_wt(mp, w0); store16_wt(mp + (size_t)8 * DM, w1); }
            asm volatile("" ::: "memory");
        }
#undef EBR_ISSUE
        return seg == 2;
    }
};
template <bool RES_F32, bool OUT_F32> struct EpiRes {
    static constexpr int IDEMP = 0; static constexpr bool NEEDS_RS = false;
    const void* xin; float* xout; bf16_t* xb; float* ssq;
    __device__ __forceinline__ bool operator()(acc_t& acc, const pg8::Unit& u, int wr, int wc, int fr, int fq, LAS unsigned char* stg) const {
        const int rowb = u.pm * 256 + wr * 64; const int colw = 256 * u.pn + 64 * wc;
        const int lane_ = fq * 16 + fr, r8 = lane_ >> 3, ch = lane_ & 7;
        constexpr int NB = RES_F32 ? 3 : 4, LA = NB - 1;
        f32x4 buf[RES_F32 ? NB : 1][4]; u32x4 bbuf[RES_F32 ? 1 : NB][2];
        const float* xf = (const float*)xin; const bf16_t* xh = (const bf16_t*)xin;
#define ERES_ISSUE(k, pp) do { const size_t row_ = (size_t)(rowb + ((k) >> 2) * 128 + ((k) & 3) * 16 + r8); \
            if (RES_F32) { const size_t off_ = row_ * DM + colw + 4 * ch; buf[pp][0] = __builtin_nontemporal_load((const f32x4*)(xf + off_)); buf[pp][1] = __builtin_nontemporal_load((const f32x4*)(xf + off_ + (size_t)8 * DM)); \
                buf[pp][2] = __builtin_nontemporal_load((const f32x4*)(xf + off_ + 32)); buf[pp][3] = __builtin_nontemporal_load((const f32x4*)(xf + off_ + (size_t)8 * DM + 32)); } \
            else { const size_t off_ = row_ * DM + colw + 8 * ch; bbuf[pp][0] = __builtin_nontemporal_load((const u32x4*)(xh + off_)); bbuf[pp][1] = __builtin_nontemporal_load((const u32x4*)(xh + off_ + (size_t)8 * DM)); } } while (0)
#pragma unroll
        for (int k0 = 0; k0 < LA; ++k0) ERES_ISSUE(k0, k0 % NB);
#pragma unroll
        for (int k = 0; k < 8; ++k) {
            if (k + LA < 8) ERES_ISSUE(k + LA, (k + LA) % NB);
            const int ai = k >> 2, m = k & 3; const int rowg = rowb + ai * 128 + m * 16;
            float sq = 0.f; f32x4 x[4];
            if (!RES_F32) {
                *(LAS u32x4*)(stg + r8 * STG_ROW + 16 * ch) = bbuf[k % NB][0]; *(LAS u32x4*)(stg + (r8 + 8) * STG_ROW + 16 * ch) = bbuf[k % NB][1];
#pragma unroll
                for (int q = 0; q < 4; ++q) { const u32x2 rw = *(const LAS u32x2*)(stg + fr * STG_ROW + 64 * (q >> 1) + 32 * (q & 1) + 8 * fq);
                    x[q] = (f32x4){bf_lo(rw.x), bf_hi(rw.x), bf_lo(rw.y), bf_hi(rw.y)} + acc[ai][q >> 1][m][q & 1]; } }
#pragma unroll
            for (int bj = 0; bj < 2; ++bj) {
                if (RES_F32) {
                    *(LAS f32x4*)(stg + r8 * STG_ROW + 16 * ch) = buf[k % NB][2 * bj]; *(LAS f32x4*)(stg + (r8 + 8) * STG_ROW + 16 * ch) = buf[k % NB][2 * bj + 1];
                    const f32x4 r0 = *(const LAS f32x4*)(stg + fr * STG_ROW + 16 * fq), r1 = *(const LAS f32x4*)(stg + fr * STG_ROW + 64 + 16 * fq);
                    x[2 * bj] = r0 + acc[ai][bj][m][0]; x[2 * bj + 1] = r1 + acc[ai][bj][m][1]; }
                if (OUT_F32) {
                    *(LAS f32x4*)(stg + fr * STG_ROW + 16 * fq) = x[2 * bj]; *(LAS f32x4*)(stg + fr * STG_ROW + 64 + 16 * fq) = x[2 * bj + 1];
                    const f32x4 w0 = *(const LAS f32x4*)(stg + r8 * STG_ROW + 16 * ch), w1 = *(const LAS f32x4*)(stg + (r8 + 8) * STG_ROW + 16 * ch);
                    float* gp = xout + (size_t)(rowg + r8) * DM + colw + 32 * bj + 4 * ch;
                    __builtin_nontemporal_store(w0, (f32x4*)gp); __builtin_nontemporal_store(w1, (f32x4*)(gp + (size_t)8 * DM)); } }
            if (xb) {
#pragma unroll
                for (int q = 0; q < 4; ++q) sq += (x[q].x * x[q].x + x[q].y * x[q].y) + (x[q].z * x[q].z + x[q].w * x[q].w);
#pragma unroll
                for (int q = 0; q < 4; ++q) { u32x2 w; w.x = cvt_pk_bf16(x[q].x, x[q].y); w.y = cvt_pk_bf16(x[q].z, x[q].w); *(LAS u32x2*)(stg + fr * STG_ROW + 64 * (q >> 1) + 32 * (q & 1) + 8 * fq) = w; }
                const u32x4 w0 = *(const LAS u32x4*)(stg + r8 * STG_ROW + 16 * ch), w1 = *(const LAS u32x4*)(stg + (r8 + 8) * STG_ROW + 16 * ch);
                bf16_t* gp = xb + (size_t)(rowg + r8) * DM + colw + 8 * ch;
                store16_wt(gp, w0); store16_wt(gp + (size_t)8 * DM, w1);
                sq = sum_fq4(sq); if (fq == 0) ssq[(size_t)(rowg + fr) * 16 + u.pn * 4 + wc] = sq; }
            asm volatile("" ::: "memory");
        }
#undef ERES_ISSUE
        return true;
    }
};
struct EpiSwiglu {
    static constexpr int IDEMP = 3; static constexpr bool NEEDS_RS = true;
    bf16_t* H; const float* ssq;
    __device__ __forceinline__ bool operator()(acc_t& acc, const pg8::Unit& u, int wr, int wc, int fr, int fq, LAS unsigned char* stg) const {
        const LAS float* rstab = (const LAS float*)(stg - (wr * 4 + wc) * STG_WAVE + 8 * STG_WAVE) + wr * 64 + fr;
#pragma unroll
        for (int ai = 0; ai < 2; ++ai)
#pragma unroll
            for (int m = 0; m < 4; ++m) {
                if (ai >= u.nai) continue;
                const int row = u.pm * 256 + u.rowoff + ai * 128 + wr * 64 + m * 16 + fr;
                const float rs = rstab[ai * 128 + m * 16];
                float h[8];
                const float rsn = rs * (-LOG2E), rs2 = rs * rs;
#pragma unroll
                for (int n = 0; n < 2; ++n) { const f32x4 a = acc[ai][0][m][n], b = acc[ai][1][m][n];
#pragma unroll
                    for (int e = 0; e < 4; ++e) h[4 * n + e] = (a[e] * b[e]) * rs2 * fast_rcp(1.0f + fast_exp2(a[e] * rsn)); }
                u32x4 w; w.x = cvt_pk_bf16(h[0], h[1]); w.y = cvt_pk_bf16(h[2], h[3]); w.z = cvt_pk_bf16(h[4], h[5]); w.w = cvt_pk_bf16(h[6], h[7]);
                store16_wt(H + (size_t)row * DFF + 128 * u.pn + 32 * wc + 8 * fq, w);
                asm volatile("" ::: "memory");
            }
        return true;
    }
};

namespace att {
typedef LAS const char* lds_cptr;
__device__ __forceinline__ int crow(int r, int hi) { return (r & 3) + 8 * (r >> 2) + 4 * hi; }
constexpr int NSLOT = 5, SLOTB = 8192, LDS_K = 0, LDS_V = NSLOT * SLOTB, LDS_WS = 2 * NSLOT * SLOTB, LDS_OST = LDS_WS + 8 * 256, LDS_TAB = LDS_OST + 8 * 4096, LDS_END = LDS_TAB + 8192;
static_assert(LDS_END <= RING_BYTES, "attention LDS");
__device__ __forceinline__ void glds16(const void* gsrc, unsigned lds_dst) { unsigned keep;
    asm volatile("s_mov_b32 %0, m0\n\ts_mov_b32 m0, %2\n\ts_nop 0\n\tglobal_load_lds_dwordx4 %1, off\n\ts_mov_b32 m0, %0" : "=&s"(keep) : "v"(gsrc), "s"(lds_dst) : "memory"); }
#define ATT_WAIT_BAR(N) asm volatile("s_waitcnt vmcnt(" #N ") lgkmcnt(0)\n\ts_barrier" ::: "memory")
#define ATT_LBAR() asm volatile("s_waitcnt lgkmcnt(0)\n\ts_barrier" ::: "memory")
#define MFMA32(a, b, c) __builtin_amdgcn_mfma_f32_32x32x16_bf16(a, b, c, 0, 0, 0)
__device__ __forceinline__ void qkt(f32x16& p0, f32x16& p1, lds_cptr kb, const bf16x8* qr, const f32x16& c0, const f32x16& c1) {
#pragma unroll
    for (int d0 = 0; d0 < 4; ++d0) {
        const bf16x8 b0 = *(const LAS bf16x8*)(kb + d0 * 2048);
        const bf16x8 b1 = *(const LAS bf16x8*)(kb + d0 * 2048 + 512);
        if (d0 == 0) { p0 = MFMA32(b0, qr[0], c0); p1 = MFMA32(b1, qr[0], c1); }
        else { p0 = MFMA32(b0, qr[d0], p0); p1 = MFMA32(b1, qr[d0], p1); } }
}
__device__ __forceinline__ float rowmax(const f32x16& p0, const f32x16& p1) {
    float a = fmaxf(p0[0], p1[0]);
#pragma unroll
    for (int r = 1; r < 16; ++r) a = fmaxf(a, fmaxf(p0[r], p1[r]));
    auto rr = __builtin_amdgcn_permlane32_swap(__float_as_uint(a), __float_as_uint(a), false, false);
    return fmaxf(__uint_as_float(rr[0]), __uint_as_float(rr[1]));
}
template <unsigned KS> __device__ __forceinline__ void pv(f32x16* o, int vb, int vbB, bf16x8 pa0, bf16x8 pa1, bf16x8 pa2, bf16x8 pa3) {
#pragma unroll
    for (int d0 = 0; d0 < 2; ++d0) { s16x4 lo[4], hi[4];
#pragma unroll
        for (int ks = 0; ks < 4; ++ks) if ((KS >> ks) & 1u) {
            asm volatile("ds_read_b64_tr_b16 %0,%1 offset:%c2" : "=&v"(lo[ks]) : "v"(ks < 2 ? vb : vbB), "i"(d0 * 4096 + (ks & 1) * 1024) : "memory");
            asm volatile("ds_read_b64_tr_b16 %0,%1 offset:%c2" : "=&v"(hi[ks]) : "v"(ks < 2 ? vb : vbB), "i"(d0 * 4096 + (ks & 1) * 1024 + 512) : "memory"); }
        asm volatile("s_waitcnt lgkmcnt(0)" ::: "memory"); __builtin_amdgcn_sched_barrier(0);
#define PK(k) (bf16x8){lo[k][0], lo[k][1], lo[k][2], lo[k][3], hi[k][0], hi[k][1], hi[k][2], hi[k][3]}
        if (KS & 1u) o[d0] = MFMA32(pa0, PK(0), o[d0]);
        if (KS & 2u) o[d0] = MFMA32(pa1, PK(1), o[d0]);
        if (KS & 4u) o[d0] = MFMA32(pa2, PK(2), o[d0]);
        if (KS & 8u) o[d0] = MFMA32(pa3, PK(3), o[d0]);
#undef PK
    }
}
template <unsigned L0, unsigned L1, bool HASCM, class P> __device__ __forceinline__ void att_step(const P& p, int j, int wid, f32x16& cm0, f32x16& cm1, lds_cptr kb, lds_cptr kbB, int vb, int vbB, const bf16x8* qr,
                                                                             float& mhat, float& lrun, f32x16* o, LAS float* wsf, bool& first, int r32, int hi) {
    f32x16 p0, p1, c0, c1;
    p.template cinit<L0, L1>(c0, c1, cm0, cm1, mhat, j, wid, r32, hi);
    constexpr int KBATCH = HASCM ? 2 : 4;
#pragma unroll
    for (int h0 = 0; h0 < 4; h0 += KBATCH) {
        bf16x8 f0[KBATCH], f1[KBATCH];
#pragma unroll
        for (int j = 0; j < KBATCH; ++j) { if (L0) f0[j] = *(const LAS bf16x8*)(kb + (h0 + j) * 2048); if (L1) f1[j] = *(const LAS bf16x8*)(kbB + (h0 + j) * 2048); }
        __builtin_amdgcn_sched_barrier(0);
#pragma unroll
        for (int j = 0; j < KBATCH; ++j) { const int d0 = h0 + j;
            if (L0) p0 = MFMA32(f0[j], qr[d0], d0 == 0 ? c0 : p0);
            if (L1) p1 = MFMA32(f1[j], qr[d0], d0 == 0 ? c1 : p1); }
        __builtin_amdgcn_sched_barrier(0); }
    float s4[4] = {0.f, 0.f, 0.f, 0.f};
#pragma unroll
    for (int r = 0; r < 16; ++r) { if ((L0 >> r) & 1u) { p0[r] = fast_exp2(p0[r]); s4[r & 3] += p0[r]; } else p0[r] = 0.f; if ((L1 >> r) & 1u) { p1[r] = fast_exp2(p1[r]); s4[r & 3] += p1[r]; } else p1[r] = 0.f; }
    lrun += (s4[0] + s4[1]) + (s4[2] + s4[3]);
    u32x4 pw0, pw1, pw2, pw3;
    pw0 = (u32x4){cvt_pk_bf16(p0[0], p0[1]), cvt_pk_bf16(p0[2], p0[3]), cvt_pk_bf16(p0[4], p0[5]), cvt_pk_bf16(p0[6], p0[7])};
    pw1 = (u32x4){cvt_pk_bf16(p0[8], p0[9]), cvt_pk_bf16(p0[10], p0[11]), cvt_pk_bf16(p0[12], p0[13]), cvt_pk_bf16(p0[14], p0[15])};
    pw2 = (u32x4){cvt_pk_bf16(p1[0], p1[1]), cvt_pk_bf16(p1[2], p1[3]), cvt_pk_bf16(p1[4], p1[5]), cvt_pk_bf16(p1[6], p1[7])};
    pw3 = (u32x4){cvt_pk_bf16(p1[8], p1[9]), cvt_pk_bf16(p1[10], p1[11]), cvt_pk_bf16(p1[12], p1[13]), cvt_pk_bf16(p1[14], p1[15])};
    constexpr unsigned KS = ((L0 & 0x00FFu) ? 1u : 0u) | ((L0 & 0xFF00u) ? 2u : 0u) | ((L1 & 0x00FFu) ? 4u : 0u) | ((L1 & 0xFF00u) ? 8u : 0u);
    pv<KS>(o, vb, vbB, __builtin_bit_cast(bf16x8, pw0), __builtin_bit_cast(bf16x8, pw1), __builtin_bit_cast(bf16x8, pw2), __builtin_bit_cast(bf16x8, pw3));
}
template <class P> __device__ __forceinline__ void unit_simple(const P& p, bool prestaged, const P& pn, bool has_next, const float Bref, LAS char* shm, bf16x8& qn0, bf16x8& qn1, bf16x8& qn2, bf16x8& qn3) {
    int tid = threadIdx.x; asm volatile("" : "+v"(tid));
    const int lane = tid & 63, r32 = lane & 31, hi = lane >> 5; const int wid = __builtin_amdgcn_readfirstlane(tid >> 6);
    const int lw = wid ^ ((wid >> 2) & 1);
    const unsigned lds0 = (unsigned)(uintptr_t)shm;
    LAS float* wsf = (LAS float*)(shm + LDS_WS) + wid * 64;
    const unsigned kdst = lds0 + LDS_K + wid * 1024, vdst = lds0 + LDS_V + wid * 1024;
    const int vb0 = (int)(lds0 + LDS_V) + ((lane >> 4) & 1) * 32 + (lane & 3) * 8 + (4 * hi + ((lane & 15) >> 2)) * 64;
    const lds_cptr kp0 = (lds_cptr)shm + LDS_K + hi * 1024 + r32 * 16;
    const int NT = p.ntiles();
#define ATT_STAGE_P(pp, j, slot) do { const bf16_t* kp_ = (pp).kptr((j), lane) + wid * 8; const bf16_t* vp_ = (pp).vptr((j), 16 * (wid & 3) + (lane >> 2)) + (wid >> 2) * 32 + (lane & 3) * 8; \
        glds16(kp_, (unsigned)__builtin_amdgcn_readfirstlane(kdst + (slot) * SLOTB)); glds16(vp_, (unsigned)__builtin_amdgcn_readfirstlane(vdst + (slot) * SLOTB)); } while (0)
#define ATT_STAGE(j, slot) ATT_STAGE_P(p, j, slot)
    constexpr int NPRE = (P::KIND == 2) ? 5 : 4;
    bf16x8 qr[4];
    if (prestaged) { qr[0] = qn0; qr[1] = qn1; qr[2] = qn2; qr[3] = qn3; }
    else { const bf16_t* qrow = p.qrow(lw, r32);
#pragma unroll
      for (int d0 = 0; d0 < 4; ++d0) qr[d0] = *(const bf16x8*)(qrow + d0 * 16 + hi * 8); }
    asm volatile("" ::: "memory");
    if (!prestaged) {
#pragma unroll
        for (int j0 = 0; j0 < NPRE; ++j0) if (j0 < NT) ATT_STAGE(j0, j0); }
    float mrun = Bref, lrun = 0.f; f32x16 o[2]; o[0] = f32x16{}; o[1] = f32x16{}; bool first = false;
    f32x16 cm0 = f32x16{}, cm1 = f32x16{}; p.prep(cm0, cm1, lw, r32, hi);
    if constexpr (P::KIND == 2) {
#pragma unroll
        for (int st = 0; st < 3; ++st) {
            if (st == 0) { ATT_WAIT_BAR(2); } else { ATT_WAIT_BAR(0); }
            if (st == 1) ATT_STAGE(5, 0);
            const int t = (lw >> 1) + st, sl = (t == 5) ? 0 : t;
            if (p.active(t, lw)) {
                const lds_cptr kb = kp0 + sl * SLOTB; const int vb = vb0 + sl * SLOTB;
                if (st == 0 && (lw & 1))        att_step<0x0000u, 0xFFFFu, false>(p, t, lw, cm0, cm1, kb, kb + 512, vb, vb + 2048, qr, mrun, lrun, o, wsf, first, r32, hi);
                else if (st == 2 && !(lw & 1))  att_step<0xFFFFu, 0x0000u, false>(p, t, lw, cm0, cm1, kb, kb + 512, vb, vb + 2048, qr, mrun, lrun, o, wsf, first, r32, hi);
                else                            att_step<0xFFFFu, 0xFFFFu, false>(p, t, lw, cm0, cm1, kb, kb + 512, vb, vb + 2048, qr, mrun, lrun, o, wsf, first, r32, hi);
            }
        }
    } else {
    int slot = 0, slot4 = 4;
    for (int j = 0; j < NT; ++j) {
        const int rem = NT - 1 - j;
        if (rem >= 3) { ATT_WAIT_BAR(6); } else if (rem == 2) { ATT_WAIT_BAR(4); } else if (rem == 1) { ATT_WAIT_BAR(2); } else { ATT_WAIT_BAR(0); }
        if (j + 4 < NT) ATT_STAGE(j + 4, slot4);
        if (p.active(j, lw)) {
            const lds_cptr kb = kp0 + slot * SLOTB; const int vb = vb0 + slot * SLOTB;
            const int pat = p.pattern(j, lw);
            if constexpr (P::KIND == 1) {
                if (pat == 1) att_step<0xFFFFu, 0x000Fu, true>(p, j, lw, cm0, cm1, kb, kb + 512, vb, vb + 2048, qr, mrun, lrun, o, wsf, first, r32, hi);
                else          att_step<0xF000u, 0xFFFFu, true>(p, j, lw, cm0, cm1, kb, kb + 512, vb, vb + 2048, qr, mrun, lrun, o, wsf, first, r32, hi);
            } else if constexpr (P::KIND == 2) {
                if (pat == 3)      att_step<0x0000u, 0xFFFFu, false>(p, j, lw, cm0, cm1, kb, kb + 512, vb, vb + 2048, qr, mrun, lrun, o, wsf, first, r32, hi);
                else if (pat == 4) att_step<0xFFFFu, 0x0000u, false>(p, j, lw, cm0, cm1, kb, kb + 512, vb, vb + 2048, qr, mrun, lrun, o, wsf, first, r32, hi);
                else               att_step<0xFFFFu, 0xFFFFu, false>(p, j, lw, cm0, cm1, kb, kb + 512, vb, vb + 2048, qr, mrun, lrun, o, wsf, first, r32, hi);
            } else att_step<0xFFFFu, 0xFFFFu, false>(p, j, lw, cm0, cm1, kb, kb + 512, vb, vb + 2048, qr, mrun, lrun, o, wsf, first, r32, hi);
        }
        slot = (slot == NSLOT - 1) ? 0 : slot + 1; slot4 = (slot4 == NSLOT - 1) ? 0 : slot4 + 1;
    }
    }
    ATT_LBAR();
    if (has_next) { const int NTn = pn.ntiles();
#pragma unroll
        for (int j0 = 0; j0 < NPRE; ++j0) if (j0 < NTn) ATT_STAGE_P(pn, j0, j0);
        { const bf16_t* qrown = pn.qrow(lw, r32) + hi * 8;
          qn0 = *(const bf16x8*)(qrown); qn1 = *(const bf16x8*)(qrown + 16); qn2 = *(const bf16x8*)(qrown + 32); qn3 = *(const bf16x8*)(qrown + 48); } }
    { auto rr = __builtin_amdgcn_permlane32_swap(__float_as_uint(lrun), __float_as_uint(lrun), false, false); lrun = __uint_as_float(rr[0]) + __uint_as_float(rr[1]); }
    if (p.skip_out()) return;
    p.store_lse(lw, r32, hi, mrun, lrun);
    if (hi == 0) wsf[32 + r32] = lrun;
    asm volatile("s_waitcnt lgkmcnt(0)" ::: "memory");
    float rli[16];
#pragma unroll
    for (int r = 0; r < 16; ++r) rli[r] = fast_rcp(wsf[32 + crow(r, hi)]);
    { LAS bf16_t* stg = (LAS bf16_t*)(shm + LDS_OST) + wid * 2048;
#pragma unroll
      for (int r = 0; r < 16; ++r) { const int orow = crow(r, hi);
#pragma unroll
        for (int d0 = 0; d0 < 2; ++d0) { const float v = o[d0][r] * rli[r]; stg[orow * 64 + d0 * 32 + r32] = (bf16_t)(cvt_pk_bf16(v, v) & 0xffffu); } }
      asm volatile("s_waitcnt lgkmcnt(0)" ::: "memory");
#pragma unroll
      for (int i = 0; i < 4; ++i) { const int row = i * 8 + (lane >> 3), ch = lane & 7; const u32x4 v = *(const LAS u32x4*)(stg + row * 64 + ch * 8); *(u32x4*)(p.optr(lw, row) + ch * 8) = v; } }
#undef ATT_STAGE
#undef ATT_STAGE_P
}

struct PolC {
    static constexpr int KIND = 0;
    const bf16_t* Z; bf16_t* O; int b, h, qb;
    __device__ __forceinline__ int ntiles() const { return SEQ / 64; }
    __device__ __forceinline__ const bf16_t* qrow(int wid, int r32) const { return Z + (size_t)(b * SEQ + qb * 256 + wid * 32 + r32) * ZP + ZQC + 64 * h; }
    __device__ __forceinline__ const bf16_t* kptr(int j, int row) const { return Z + (size_t)(b * SEQ + 64 * j + row) * ZP + ZKC + 64 * (h >> 2); }
    __device__ __forceinline__ const bf16_t* vptr(int j, int row) const { return Z + (size_t)(b * SEQ + 64 * j + row) * ZP + ZVC + 64 * (h >> 2); }
    __device__ __forceinline__ bool active(int, int) const { return true; }
    __device__ __forceinline__ void prep(f32x16&, f32x16&, int, int, int) const {}
    template <unsigned L0, unsigned L1> __device__ __forceinline__ void cinit(f32x16& c0, f32x16& c1, const f32x16&, const f32x16&, float mhat, int, int, int, int) const {
#pragma unroll
        for (int r = 0; r < 16; ++r) { c0[r] = -mhat; c1[r] = -mhat; } }
    __device__ __forceinline__ bool skip_out() const { return false; }
    __device__ __forceinline__ int pattern(int, int) const { return 0; }
    __device__ __forceinline__ void store_lse(int, int, int, float, float) const {}
    __device__ __forceinline__ bf16_t* optr(int wid, int row) const { return O + (size_t)(b * SEQ + qb * 256 + wid * 32 + row) * OP + 768 + 64 * h; }
};
struct PolB {
    static constexpr int KIND = 1;
    const bf16_t* Z; bf16_t* O; const LAS float* tab; int b, h, i0, kr0, nt;
    __device__ __forceinline__ int ntiles() const { return nt; }
    __device__ __forceinline__ const bf16_t* qrow(int wid, int r32) const { return Z + (size_t)(b * SEQ + (i0 + (wid >> 1)) * 64 + 32 * (wid & 1) + r32) * ZP + ZQB + 64 * h; }
    __device__ __forceinline__ const bf16_t* kptr(int j, int row) const { return Z + (size_t)(b * SEQ + (kr0 + j) * 64 + row) * ZP + ZKB + 64 * h; }
    __device__ __forceinline__ const bf16_t* vptr(int j, int row) const { return Z + (size_t)(b * SEQ + (kr0 + j) * 64 + row) * ZP + ZVB + 64 * h; }
    __device__ __forceinline__ bool active(int j, int wid) const { const int gi = i0 + (wid >> 1); int rs = gi - 4; rs = rs < 0 ? 0 : (rs > 120 ? 120 : rs); const int kr = kr0 + j; return kr >= rs && kr <= rs + 7; }
    __device__ __forceinline__ void prep(f32x16& cm0, f32x16& cm1, int wid, int r32, int hi) const {
        const int c = 32 * (wid & 1) + r32; int c0 = c - 8; c0 = c0 < 0 ? 0 : (c0 > 48 ? 48 : c0);
#pragma unroll
        for (int r = 0; r < 16; ++r) { const int k0 = crow(r, hi), k1 = k0 + 32; cm0[r] = (k0 >= c0 && k0 < c0 + 16) ? 0.f : NEGBIG; cm1[r] = (k1 >= c0 && k1 < c0 + 16) ? 0.f : NEGBIG; }
    }
    template <unsigned L0, unsigned L1> __device__ __forceinline__ void cinit(f32x16& c0, f32x16& c1, const f32x16& cm0, const f32x16& cm1, float, int j, int wid, int r32, int hi) const {
        const int gi = i0 + (wid >> 1), c = 32 * (wid & 1) + r32; const int dr = kr0 + j - gi + 7;
        const LAS float* base = tab + dr * 128 + (48 + 15 + 4 * hi - c);
#pragma unroll
        for (int r = 0; r < 16; ++r) { const int kc = (r & 3) + 8 * (r >> 2); c0[r] = ((L0 >> r) & 1u) ? base[kc] + cm0[r] : 0.f; c1[r] = ((L1 >> r) & 1u) ? base[kc + 32] + cm1[r] : 0.f; }
    }
    __device__ __forceinline__ bool skip_out() const { return false; }
    __device__ __forceinline__ int pattern(int, int wid) const { return (wid & 1) ? 2 : 1; }
    __device__ __forceinline__ void store_lse(int, int, int, float, float) const {}
    __device__ __forceinline__ bf16_t* optr(int wid, int row) const { return O + (size_t)(b * SEQ + (i0 + (wid >> 1)) * 64 + 32 * (wid & 1) + row) * OP + 256 + 64 * h; }
};
constexpr int B2_NSLOT = 4, B2_K = 0, B2_V = B2_NSLOT * SLOTB, B2_WS = 2 * B2_NSLOT * SLOTB, B2_OST = B2_WS + 8 * 256, B2_TAB = B2_OST + 8 * 4096, B2_END = B2_TAB + 16 * 128 * 4;
static_assert(B2_END <= RING_BYTES, "mixer B LDS");
struct PolB2 {
    const LAS float* tab; int i0, R0;
    template <unsigned L0, unsigned L1> __device__ __forceinline__ void cinit(f32x16& c0, f32x16& c1, const f32x16& cm0, const f32x16&, float, int s, int wid, int r32, int hi) const {
        const int p = wid >> 2, mb = wid & 3; int cs = 16 * mb - 8; cs = cs < 0 ? 0 : (cs > 32 ? 32 : cs);
        const int qrow = i0 + 2 * p + (r32 >> 4), qcol = 16 * mb + (r32 & 15); int rsq = qrow - 4; rsq = rsq < 0 ? 0 : (rsq > 120 ? 120 : rsq);
        const int krA = R0 + 2 * s, krB = krA + 1;
        const int drA = (krA >= rsq && krA <= rsq + 7) ? krA - qrow + 7 : 15, drB = (krB >= rsq && krB <= rsq + 7) ? krB - qrow + 7 : 15;
        const int off = 48 + 15 + cs + 4 * hi - qcol;
        const LAS float* bA = tab + drA * 128 + off; const LAS float* bB = tab + drB * 128 + off;
#pragma unroll
        for (int r = 0; r < 16; ++r) { const int kc = (r & 3) + 8 * (r >> 2); c0[r] = ((L0 >> r) & 1u) ? bA[kc] + cm0[r] : 0.f; c1[r] = ((L1 >> r) & 1u) ? bB[kc] + cm0[r] : 0.f; }
    }
};
__device__ __forceinline__ void unit_b2(const bf16_t* Z, bf16_t* O, const LAS float* tab, int b, int h, int i0, const float Bref, LAS char* shm) {
    int tid = threadIdx.x; asm volatile("" : "+v"(tid));
    const int lane = tid & 63, r32 = lane & 31, hi = lane >> 5; const int wid = __builtin_amdgcn_readfirstlane(tid >> 6);
    const int p = wid >> 2, mb = wid & 3; int cs = 16 * mb - 8; cs = cs < 0 ? 0 : (cs > 32 ? 32 : cs);
    int R0 = i0 - 4; R0 = R0 < 0 ? 0 : (R0 > 120 ? 120 : R0); int rs3 = i0 - 1; rs3 = rs3 < 0 ? 0 : (rs3 > 120 ? 120 : rs3);
    const int NS = (rs3 + 8 - R0 + 1) >> 1, NR = 2 * NS;
    const unsigned lds0 = (unsigned)(uintptr_t)shm;
    LAS float* wsf = (LAS float*)(shm + B2_WS) + wid * 64;
    const unsigned kdst = lds0 + B2_K + wid * 1024, vdst = lds0 + B2_V + wid * 1024;
    const int vbl = (int)(lds0 + B2_V) + cs * 64 + ((lane >> 4) & 1) * 32 + (lane & 3) * 8 + (4 * hi + ((lane & 15) >> 2)) * 64;
    const lds_cptr kpl = (lds_cptr)shm + B2_K + hi * 1024 + (cs + r32) * 16;
    const bf16_t* Zb = Z + (size_t)(b * SEQ) * ZP + 64 * h;
#define B2_STAGE(ri) do { int kr_ = R0 + (ri); kr_ = kr_ > 127 ? 127 : kr_; const int sl_ = (ri) & (B2_NSLOT - 1); \
        const bf16_t* kp_ = Zb + (size_t)(kr_ * 64 + lane) * ZP + ZKB + wid * 8; const bf16_t* vp_ = Zb + (size_t)(kr_ * 64 + 16 * (wid & 3) + (lane >> 2)) * ZP + ZVB + (wid >> 2) * 32 + (lane & 3) * 8; \
        glds16(kp_, (unsigned)__builtin_amdgcn_readfirstlane(kdst + sl_ * SLOTB)); glds16(vp_, (unsigned)__builtin_amdgcn_readfirstlane(vdst + sl_ * SLOTB)); } while (0)
#pragma unroll
    for (int ri = 0; ri < 4; ++ri) B2_STAGE(ri);
    const int qrow = i0 + 2 * p + (r32 >> 4), qcol = 16 * mb + (r32 & 15);
    bf16x8 qr[4];
    { const bf16_t* qp = Zb + (size_t)(qrow * 64 + qcol) * ZP + ZQB;
#pragma unroll
      for (int d0 = 0; d0 < 4; ++d0) qr[d0] = *(const bf16x8*)(qp + d0 * 16 + hi * 8); }
    float mrun = Bref, lrun = 0.f; f32x16 o[2]; o[0] = f32x16{}; o[1] = f32x16{}; bool first = false;
    f32x16 cm0, cm1 = f32x16{};
    { int c0w = qcol - 8; c0w = c0w < 0 ? 0 : (c0w > 48 ? 48 : c0w);
#pragma unroll
      for (int r = 0; r < 16; ++r) { const int kc = cs + crow(r, hi); cm0[r] = (kc >= c0w && kc < c0w + 16) ? -Bref : NEGBIG; } }
    const PolB2 P{tab, i0, R0};
    int rs0p = i0 + 2 * p - 4; rs0p = rs0p < 0 ? 0 : (rs0p > 120 ? 120 : rs0p); int rs1p = i0 + 2 * p - 3; rs1p = rs1p < 0 ? 0 : (rs1p > 120 ? 120 : rs1p);
    for (int s = 0; s < NS; ++s) {
        if (s == 0) { ATT_WAIT_BAR(4); } else { ATT_WAIT_BAR(0); }
        if (s >= 1 && 2 * s + 2 < NR) { B2_STAGE(2 * s + 2); B2_STAGE(2 * s + 3); }
        const int krA = R0 + 2 * s;
        if (krA + 1 >= rs0p && krA <= rs1p + 7) {
            const int slA = (2 * s) & (B2_NSLOT - 1), slB = (2 * s + 1) & (B2_NSLOT - 1);
            const lds_cptr kbA = kpl + slA * SLOTB, kbB = kpl + slB * SLOTB; const int vbA = vbl + slA * SLOTB, vbB = vbl + slB * SLOTB;
            if (mb == 0)      att_step<0x0FFFu, 0x0FFFu, true>(P, s, wid, cm0, cm1, kbA, kbB, vbA, vbB, qr, mrun, lrun, o, wsf, first, r32, hi);
            else if (mb == 3) att_step<0xFFF0u, 0xFFF0u, true>(P, s, wid, cm0, cm1, kbA, kbB, vbA, vbB, qr, mrun, lrun, o, wsf, first, r32, hi);
            else              att_step<0xFFFFu, 0xFFFFu, true>(P, s, wid, cm0, cm1, kbA, kbB, vbA, vbB, qr, mrun, lrun, o, wsf, first, r32, hi);
        }
    }
    ATT_LBAR();
    { auto rr = __builtin_amdgcn_permlane32_swap(__float_as_uint(lrun), __float_as_uint(lrun), false, false); lrun = __uint_as_float(rr[0]) + __uint_as_float(rr[1]); }
    if (hi == 0) wsf[32 + r32] = lrun;
    asm volatile("s_waitcnt lgkmcnt(0)" ::: "memory");
    float rli[16];
#pragma unroll
    for (int r = 0; r < 16; ++r) rli[r] = fast_rcp(wsf[32 + crow(r, hi)]);
    { LAS bf16_t* stg = (LAS bf16_t*)(shm + B2_OST) + wid * 2048;
#pragma unroll
      for (int r = 0; r < 16; ++r) { const int orow = crow(r, hi);
#pragma unroll
        for (int d0 = 0; d0 < 2; ++d0) { const float v = o[d0][r] * rli[r]; stg[orow * 64 + d0 * 32 + r32] = (bf16_t)(cvt_pk_bf16(v, v) & 0xffffu); } }
      asm volatile("s_waitcnt lgkmcnt(0)" ::: "memory");
      bf16_t* Ob = O + (size_t)(b * SEQ) * OP + 256 + 64 * h;
#pragma unroll
      for (int i = 0; i < 4; ++i) { const int row = i * 8 + (lane >> 3), ch = lane & 7; const u32x4 v = *(const LAS u32x4*)(stg + row * 64 + ch * 8);
          *(u32x4*)(Ob + (size_t)((i0 + 2 * p + (row >> 4)) * 64 + 16 * mb + (row & 15)) * OP + ch * 8) = v; } }
    ATT_LBAR();
#undef B2_STAGE
}
__device__ __forceinline__ void unit_b8(const bf16_t* Z, bf16_t* O, const LAS float* tab, int b, int h, int i0, const float Bref, LAS char* shm) {
    int tid = threadIdx.x; asm volatile("" : "+v"(tid));
    const int lane = tid & 63, r32 = lane & 31, hi = lane >> 5; const int wid = __builtin_amdgcn_readfirstlane(tid >> 6);
    const int p = wid >> 2, mb = (wid & 3) ^ p; const int lw = 4 * p + mb;
    int cs = 16 * mb - 8; cs = cs < 0 ? 0 : (cs > 32 ? 32 : cs);
    int R0 = i0 - 4; R0 = R0 < 0 ? 0 : (R0 > 120 ? 120 : R0); int rsl = i0 + 3; rsl = rsl < 0 ? 0 : (rsl > 120 ? 120 : rsl);
    const int NS = (rsl + 8 - R0 + 1) >> 1, NR = 2 * NS;
    const unsigned lds0 = (unsigned)(uintptr_t)shm;
    LAS float* wsf = (LAS float*)(shm + B2_WS) + wid * 64;
    const unsigned kdst = lds0 + B2_K + wid * 1024, vdst = lds0 + B2_V + wid * 1024;
    const int vbl = (int)(lds0 + B2_V) + cs * 64 + ((lane >> 4) & 1) * 32 + (lane & 3) * 8 + (4 * hi + ((lane & 15) >> 2)) * 64;
    const lds_cptr kpl = (lds_cptr)shm + B2_K + hi * 1024 + (cs + r32) * 16;
    const bf16_t* ZbQ = Z + zplane(36 + h) + (size_t)(b * SEQ) * ZSL; const bf16_t* ZbK = Z + zplane(44 + h) + (size_t)(b * SEQ) * ZSL; const bf16_t* ZbV = Z + zplane(52 + h) + (size_t)(b * SEQ) * ZSL;
#define B8_STAGE(ri) do { int kr_ = R0 + (ri); kr_ = kr_ > 127 ? 127 : kr_; const int sl_ = (ri) & (B2_NSLOT - 1); \
        const bf16_t* kp_ = ZbK + (size_t)(kr_ * 64 + lane) * ZSL + wid * 8; const bf16_t* vp_ = ZbV + (size_t)(kr_ * 64 + 16 * (wid & 3) + (lane >> 2)) * ZSL + (wid >> 2) * 32 + (lane & 3) * 8; \
        glds16(kp_, (unsigned)__builtin_amdgcn_readfirstlane(kdst + sl_ * SLOTB)); glds16(vp_, (unsigned)__builtin_amdgcn_readfirstlane(vdst + sl_ * SLOTB)); } while (0)
    const int qcol = 16 * mb + (r32 & 15), qrowA = i0 + 2 * p + (r32 >> 4), qrowB = qrowA + 4;
    bf16x8 qa[4], qb[4];
    { const bf16_t* qp = ZbQ + (size_t)(qrowA * 64 + qcol) * ZSL; const bf16_t* qq = ZbQ + (size_t)(qrowB * 64 + qcol) * ZSL;
#pragma unroll
      for (int d0 = 0; d0 < 4; ++d0) { qa[d0] = *(const bf16x8*)(qp + d0 * 16 + hi * 8); qb[d0] = *(const bf16x8*)(qq + d0 * 16 + hi * 8); } }
    asm volatile("" ::: "memory");
#pragma unroll
    for (int ri = 0; ri < 4; ++ri) B8_STAGE(ri);
    asm volatile("" : "+v"(qa[0]), "+v"(qa[1]), "+v"(qa[2]), "+v"(qa[3]), "+v"(qb[0]), "+v"(qb[1]), "+v"(qb[2]), "+v"(qb[3]));
    float mrun = Bref, lrA = 0.f, lrB = 0.f; f32x16 oa[2], ob[2]; oa[0] = f32x16{}; oa[1] = f32x16{}; ob[0] = f32x16{}; ob[1] = f32x16{}; bool first = false;
    f32x16 cm0, cm1 = f32x16{};
    { int c0w = qcol - 8; c0w = c0w < 0 ? 0 : (c0w > 48 ? 48 : c0w);
#pragma unroll
      for (int r = 0; r < 16; ++r) { const int kc = cs + crow(r, hi); cm0[r] = (kc >= c0w && kc < c0w + 16) ? -Bref : NEGBIG; } }
    const PolB2 PA{tab, i0, R0}, PB{tab, i0 + 4, R0};
    int a0 = i0 + 2 * p - 4; a0 = a0 < 0 ? 0 : (a0 > 120 ? 120 : a0); int a1 = i0 + 2 * p - 3; a1 = a1 < 0 ? 0 : (a1 > 120 ? 120 : a1);
    int b0 = i0 + 2 * p;     b0 = b0 < 0 ? 0 : (b0 > 120 ? 120 : b0); int b1 = i0 + 2 * p + 1; b1 = b1 < 0 ? 0 : (b1 > 120 ? 120 : b1);
#define B8_LOOP(L0V, L1V) do { _Pragma("unroll 1") \
    for (int s = 0; s < NS; ++s) { \
        if (s == 0) { ATT_WAIT_BAR(4); } else { ATT_WAIT_BAR(0); } \
        if (s >= 1 && 2 * s + 2 < NR) { B8_STAGE(2 * s + 2); B8_STAGE(2 * s + 3); } \
        const int krA = R0 + 2 * s; \
        const int slA = (2 * s) & (B2_NSLOT - 1), slB = (2 * s + 1) & (B2_NSLOT - 1); \
        const lds_cptr kbA = kpl + slA * SLOTB, kbB = kpl + slB * SLOTB; const int vbA = vbl + slA * SLOTB, vbB = vbl + slB * SLOTB; \
        if (krA + 1 >= a0 && krA <= a1 + 7) { __builtin_amdgcn_sched_barrier(0); att_step<L0V, L1V, true>(PA, s, lw, cm0, cm1, kbA, kbB, vbA, vbB, qa, mrun, lrA, oa, wsf, first, r32, hi); __builtin_amdgcn_sched_barrier(0); } \
        if (krA + 1 >= b0 && krA <= b1 + 7) { __builtin_amdgcn_sched_barrier(0); att_step<L0V, L1V, true>(PB, s, lw, cm0, cm1, kbA, kbB, vbA, vbB, qb, mrun, lrB, ob, wsf, first, r32, hi); __builtin_amdgcn_sched_barrier(0); } \
    } } while (0)
    if (mb == 0)      B8_LOOP(0x0FFFu, 0x0FFFu);
    else if (mb == 3) B8_LOOP(0xFFF0u, 0xFFF0u);
    else              B8_LOOP(0xFFFFu, 0xFFFFu);
    ATT_LBAR();
    bf16_t* Ob = O + (size_t)(b * SEQ) * OP + 256 + 64 * h;
    LAS bf16_t* stg = (LAS bf16_t*)(shm + B2_OST) + wid * 2048;
#define B8_OUT(LR, OO, ROW0) do { float l_ = LR; \
        { auto rr = __builtin_amdgcn_permlane32_swap(__float_as_uint(l_), __float_as_uint(l_), false, false); l_ = __uint_as_float(rr[0]) + __uint_as_float(rr[1]); } \
        if (hi == 0) wsf[32 + r32] = l_; \
        asm volatile("s_waitcnt lgkmcnt(0)" ::: "memory"); \
        _Pragma("unroll") for (int r = 0; r < 16; ++r) { const int orow = crow(r, hi); const float rl_ = fast_rcp(wsf[32 + orow]); \
            _Pragma("unroll") for (int d0 = 0; d0 < 2; ++d0) { const float v = OO[d0][r] * rl_; stg[orow * 64 + d0 * 32 + r32] = (bf16_t)(cvt_pk_bf16(v, v) & 0xffffu); } } \
        asm volatile("s_waitcnt lgkmcnt(0)" ::: "memory"); \
        _Pragma("unroll") for (int i = 0; i < 4; ++i) { const int row = i * 8 + (lane >> 3), ch = lane & 7; const u32x4 v = *(const LAS u32x4*)(stg + row * 64 + ch * 8); \
            *(u32x4*)(Ob + (size_t)(((ROW0) + (row >> 4)) * 64 + 16 * mb + (row & 15)) * OP + ch * 8) = v; } \
        asm volatile("s_waitcnt lgkmcnt(0)" ::: "memory"); } while (0)
    B8_OUT(lrA, oa, i0 + 2 * p);
    B8_OUT(lrB, ob, i0 + 4 + 2 * p);
    ATT_LBAR();
#undef B8_STAGE
#undef B8_LOOP
#undef B8_OUT
}
struct PolA {
    static constexpr int KIND = 2;
    bf16_t* Z; float* LSE; const LAS float* tab; int b, g, h, rate, rho, u, nblk; bool dry;
    __device__ __forceinline__ int ntiles() const { return 6; }
    __device__ __forceinline__ size_t tokrow(int didx) const { return (size_t)(b * SEQ + didx * rate + rho); }
    __device__ __forceinline__ size_t zrow(int didx) const { return (size_t)(b * SEQ + rho * (SEQ / rate) + didx); }
    __device__ __forceinline__ const bf16_t* qrow(int wid, int r32) const { return Z + zplane(4 * g + h) + zrow(256 * u + 32 * wid + r32) * ZSL; }
    __device__ __forceinline__ int blk(int j) const { int bj = 4 * u - 1 + j; return bj < 0 ? 0 : (bj >= nblk ? nblk - 1 : bj); }
    __device__ __forceinline__ const bf16_t* kptr(int j, int row) const { return Z + zplane(12 + 4 * g + h) + zrow(64 * blk(j) + row) * ZSL; }
    __device__ __forceinline__ const bf16_t* vptr(int j, int row) const { return Z + zplane(24 + 4 * g + h) + zrow(64 * blk(j) + row) * ZSL; }
    __device__ __forceinline__ bool active(int j, int wid) const { const int bj = 4 * u - 1 + j, d = bj - (4 * u + (wid >> 1)); return bj >= 0 && bj < nblk && d >= -1 && d <= 1; }
    __device__ __forceinline__ void prep(f32x16&, f32x16&, int, int, int) const {}
    template <unsigned L0, unsigned L1> __device__ __forceinline__ void cinit(f32x16& c0, f32x16& c1, const f32x16&, const f32x16&, float mhat, int j, int wid, int r32, int hi) const {
        const int qi = 256 * u + 32 * wid + r32; const LAS float* base = tab + (64 * (4 * u - 1 + j) - qi + 4 * hi + 127);
#pragma unroll
        for (int r = 0; r < 16; ++r) { const int kc = (r & 3) + 8 * (r >> 2); c0[r] = L0 ? base[kc] : 0.f; c1[r] = L1 ? base[kc + 32] : 0.f; }
    }
    __device__ __forceinline__ bool skip_out() const { return dry; }
    __device__ __forceinline__ int pattern(int j, int wid) const { const int d = (4 * u - 1 + j) - (4 * u + (wid >> 1)); return (d < 0 && (wid & 1)) ? 3 : ((d > 0 && !(wid & 1)) ? 4 : 0); }
    __device__ __forceinline__ void store_lse(int wid, int r32, int hi, float m, float l) const {
        if (hi == 0) LSE[tokrow(256 * u + 32 * wid + r32) * 12 + g * 4 + h] = (m + __builtin_amdgcn_logf(l)) * 0.6931471805599453f;
    }
    __device__ __forceinline__ bf16_t* optr(int wid, int row) const { return Z + zplane(4 * g + h) + zrow(256 * u + 32 * wid + row) * ZSL; }
};
__device__ __forceinline__ int t5_bucket(int rel) {
    const int ret = rel > 0 ? 16 : 0; const int n = rel < 0 ? -rel : rel;
    const float nf = (float)(n < 1 ? 1 : n);
    int large = 8 + (int)(__logf(nf / 8.0f) / 4.852030263919617f * 8.0f);
    large = large > 15 ? 15 : large;
    return ret + (n < 8 ? n : large);
}
}

namespace attp {
using bf16=__hip_bfloat16;
__device__ __forceinline__ int crow(int r,int hi){return (r&3)+8*(r>>2)+4*hi;}
#define SBAR() __builtin_amdgcn_sched_barrier(0)
constexpr int NSLOT=3, SLOTB=8192;
constexpr int NW=8, QBLK=32, KVBLK=64; constexpr int LDS_K=0, LDS_V=NSLOT*SLOTB, LDS_WS=2*NSLOT*SLOTB, LDS_OST=LDS_WS+NW*64*4, LDS_BYTES=LDS_OST+NW*4096;
__device__ __forceinline__ void glds16(const void*gsrc,unsigned lds_dst){unsigned keep;
  asm volatile("s_mov_b32 %0, m0\n\ts_mov_b32 m0, %2\n\ts_nop 0\n\tglobal_load_lds_dwordx4 %1, off\n\ts_mov_b32 m0, %0":"=&s"(keep):"v"(gsrc),"s"(lds_dst):"memory");}
__device__ __forceinline__ float max3f(float a,float b,float c){float r;asm("v_max3_f32 %0, %1, %2, %3":"=v"(r):"v"(a),"v"(b),"v"(c));return r;}
__device__ __forceinline__ float max2f(float a,float b){float r;asm("v_max_f32_e32 %0, %1, %2":"=v"(r):"v"(a),"v"(b));return r;}
__device__ __forceinline__ float fadd_s(float a,float b){float r;asm("v_add_f32_e32 %0, %1, %2":"=v"(r):"v"(a),"v"(b));return r;}
__device__ __forceinline__ float fsub_s(float a,float b){float r;asm("v_sub_f32_e32 %0, %1, %2":"=v"(r):"v"(a),"v"(b));return r;}
typedef float f32x2_t __attribute__((ext_vector_type(2)));
__device__ __forceinline__ unsigned cvtpk_s(float lo,float hi){f32x2_t v={lo,hi};bf16x2_t b=__builtin_convertvector(v,bf16x2_t);return __builtin_bit_cast(unsigned,b);}
#define WAIT_BAR(N) asm volatile("s_waitcnt vmcnt(" #N ") lgkmcnt(0)\n\ts_barrier":::"memory")

typedef __attribute__((address_space(3))) const char* lds_cptr;
__device__ __forceinline__ void qkt(f32x16&p0,f32x16&p1,lds_cptr Kslot,const bf16x8*qr,const f32x16&negm,int r32,int hi){
  lds_cptr kb=Kslot+hi*1024+r32*16;
  #pragma unroll
  for(int d0=0;d0<4;++d0){
    const bf16x8 b0=*(const __attribute__((address_space(3))) bf16x8*)(kb+d0*2048);
    const bf16x8 b1=*(const __attribute__((address_space(3))) bf16x8*)(kb+d0*2048+512);
    if(d0==0){p0=__builtin_amdgcn_mfma_f32_32x32x16_bf16(b0,qr[0],negm,0,0,0);p1=__builtin_amdgcn_mfma_f32_32x32x16_bf16(b1,qr[0],negm,0,0,0);}
    else{p0=__builtin_amdgcn_mfma_f32_32x32x16_bf16(b0,qr[d0],p0,0,0,0);p1=__builtin_amdgcn_mfma_f32_32x32x16_bf16(b1,qr[d0],p1,0,0,0);}}
}
typedef short v4i16_t __attribute__((ext_vector_type(4)));
__device__ __forceinline__ void kload8(bf16x8*kf,lds_cptr kp){
  kf[0]=*(const __attribute__((address_space(3))) bf16x8*)(kp);      kf[1]=*(const __attribute__((address_space(3))) bf16x8*)(kp+512);
  kf[2]=*(const __attribute__((address_space(3))) bf16x8*)(kp+2048); kf[3]=*(const __attribute__((address_space(3))) bf16x8*)(kp+2560);
  kf[4]=*(const __attribute__((address_space(3))) bf16x8*)(kp+4096); kf[5]=*(const __attribute__((address_space(3))) bf16x8*)(kp+4608);
  kf[6]=*(const __attribute__((address_space(3))) bf16x8*)(kp+6144); kf[7]=*(const __attribute__((address_space(3))) bf16x8*)(kp+6656);
}
__device__ __forceinline__ void kload2(bf16x8*kf,lds_cptr kp,int j){ kf[2*j]=*(const __attribute__((address_space(3))) bf16x8*)(kp+j*2048); kf[2*j+1]=*(const __attribute__((address_space(3))) bf16x8*)(kp+j*2048+512); }
__device__ __forceinline__ s16x4 vtr(lds_cptr p){ return __builtin_bit_cast(s16x4,__builtin_amdgcn_ds_read_tr16_b64_v4i16((__attribute__((address_space(3))) v4i16_t*)p)); }
__device__ __forceinline__ float rowmax(const f32x16&p0,const f32x16&p1){
  float a=max3f(p0[0],p0[1],p1[0]),b=max3f(p0[2],p0[3],p1[1]);a=max3f(a,p1[2],p1[3]);
  #pragma unroll
  for(int r=4;r<16;r+=4){a=max3f(a,p0[r],p0[r+1]);b=max3f(b,p0[r+2],p0[r+3]);a=max3f(a,p1[r],p1[r+1]);b=max3f(b,p1[r+2],p1[r+3]);}
  const float m=max2f(a,b);
  auto rr=__builtin_amdgcn_permlane32_swap(__float_as_uint(m),__float_as_uint(m),false,false);
  return max2f(__uint_as_float(rr[0]),__uint_as_float(rr[1]));
}
__device__ __forceinline__ void pv(f32x16*o,int vb,bf16x8 pa0,bf16x8 pa1,bf16x8 pa2,bf16x8 pa3){
  #pragma unroll
  for(int d0=0;d0<2;++d0){s16x4 lo[4],hi[4];
    #pragma unroll
    for(int ks=0;ks<4;++ks){
      asm volatile("ds_read_b64_tr_b16 %0,%1 offset:%c2":"=&v"(lo[ks]):"v"(vb),"i"(d0*4096+ks*1024):"memory");
      asm volatile("ds_read_b64_tr_b16 %0,%1 offset:%c2":"=&v"(hi[ks]):"v"(vb),"i"(d0*4096+ks*1024+512):"memory");}
    asm volatile("s_waitcnt lgkmcnt(0)":::"memory");SBAR();
    #define PK(k) (bf16x8){lo[k][0],lo[k][1],lo[k][2],lo[k][3],hi[k][0],hi[k][1],hi[k][2],hi[k][3]}
    o[d0]=__builtin_amdgcn_mfma_f32_32x32x16_bf16(pa0,PK(0),o[d0],0,0,0);
    o[d0]=__builtin_amdgcn_mfma_f32_32x32x16_bf16(pa1,PK(1),o[d0],0,0,0);
    o[d0]=__builtin_amdgcn_mfma_f32_32x32x16_bf16(pa2,PK(2),o[d0],0,0,0);
    o[d0]=__builtin_amdgcn_mfma_f32_32x32x16_bf16(pa3,PK(3),o[d0],0,0,0);
    #undef PK
  }
}
#ifndef ATTN_STORE16
#define ATTN_STORE16(p,v) (*(u32x4*)(p)=(v))
#endif
template<int KP> __device__ __forceinline__ void attn_prestage(const bf16*Qw,const bf16*Kh,const bf16*Vh,__attribute__((address_space(3))) char*shm,bf16x8&qn0,bf16x8&qn1,bf16x8&qn2,bf16x8&qn3){
  int tid=threadIdx.x; asm volatile("":"+v"(tid)); const int lane=tid&63,r32=lane&31,hi=lane>>5; const int wid=__builtin_amdgcn_readfirstlane(tid>>6);
  const unsigned lds0=(unsigned)(uintptr_t)shm;
  const bf16*ksrc=Kh+(long)lane*KP+wid*8;
  const bf16*vsrc=Vh+(long)(16*(wid&3)+(lane>>2))*KP+(wid>>2)*32+(lane&3)*8;
  const unsigned kdst=lds0+LDS_K+wid*1024, vdst=lds0+LDS_V+wid*1024;
  glds16(ksrc,(unsigned)__builtin_amdgcn_readfirstlane(kdst)); glds16(vsrc,(unsigned)__builtin_amdgcn_readfirstlane(vdst));
  glds16(ksrc+(long)KVBLK*KP,(unsigned)__builtin_amdgcn_readfirstlane(kdst+SLOTB)); glds16(ksrc+(long)2*KVBLK*KP,(unsigned)__builtin_amdgcn_readfirstlane(kdst+2*SLOTB));
  qn0=*reinterpret_cast<const bf16x8*>(&Qw[(long)r32*KP+hi*8]);qn1=*reinterpret_cast<const bf16x8*>(&Qw[(long)r32*KP+16+hi*8]);
  qn2=*reinterpret_cast<const bf16x8*>(&Qw[(long)r32*KP+32+hi*8]);qn3=*reinterpret_cast<const bf16x8*>(&Qw[(long)r32*KP+48+hi*8]);
}
template<int THRL,int KP,int OPITCH,bool FIXREF> __device__ __forceinline__ void attn_unit(const bf16*Qw,const bf16*__restrict__ Kh,const bf16*__restrict__ Vh,bf16*Ow,const int NT,const float Bref,__attribute__((address_space(3))) char*shm,
    const int pre,const bf16*Qn,bf16x8&qn0,bf16x8&qn1,bf16x8&qn2,bf16x8&qn3){
  const bool prestaged=pre!=0;
  int tid=threadIdx.x; asm volatile("":"+v"(tid)); const int lane=tid&63,r32=lane&31,hi=lane>>5; const int wid=__builtin_amdgcn_readfirstlane(tid>>6);
  const unsigned lds0=(unsigned)(uintptr_t)shm;
  __attribute__((address_space(3))) float*wsf=(__attribute__((address_space(3))) float*)(shm+LDS_WS)+wid*64;
  const bf16*ksrc=Kh+(long)lane*KP+wid*8;
  const bf16*vsrc=Vh+(long)(16*(wid&3)+(lane>>2))*KP+(wid>>2)*32+(lane&3)*8;
  const unsigned kdst=lds0+LDS_K+wid*1024, vdst=lds0+LDS_V+wid*1024;
  #define DMA_K(t,slot) glds16(ksrc+(long)(t)*KVBLK*KP,(unsigned)__builtin_amdgcn_readfirstlane(kdst+(slot)))
  #define DMA_V(t,slot) glds16(vsrc+(long)(t)*KVBLK*KP,(unsigned)__builtin_amdgcn_readfirstlane(vdst+(slot)))
  const int vb0=(int)(lds0+LDS_V)+((lane>>4)&1)*32+(lane&3)*8+(4*hi+((lane&15)>>2))*64;
  bf16x8 kf[8];
  const lds_cptr shm3=(lds_cptr)shm; const lds_cptr kp0=shm3+LDS_K+hi*1024+r32*16; const lds_cptr vp0=shm3+LDS_V+((lane>>4)&1)*32+(lane&3)*8+(4*hi+((lane&15)>>2))*64;
  if(!prestaged){DMA_K(0,0);DMA_V(0,0);DMA_K(1,SLOTB);}
  else if(pre==1){DMA_V(0,0);}
  bf16x8 qr[4];
  if(prestaged){qr[0]=qn0;qr[1]=qn1;qr[2]=qn2;qr[3]=qn3;}
  else{
  #pragma unroll
  for(int d0=0;d0<4;++d0)qr[d0]=*reinterpret_cast<const bf16x8*>(&Qw[(long)r32*KP+d0*16+hi*8]);}
  float mhat=FIXREF?Bref:0.f,l_reg=0.f;f32x16 o[2];o[0]=f32x16{};o[1]=f32x16{};f32x16 negm=f32x16{};
  if constexpr(FIXREF){ _Pragma("unroll") for(int r=0;r<16;++r)negm[r]=-Bref; }
  asm volatile("":"+v"(negm));
  #define CMASK(P0,P1,t) do{}while(0)
  bool resc=false;
  #define START(P0,P1) do{ resc=false; if constexpr(!FIXREF) { const float rm=rowmax(P0,P1); \
    { const float dl=rm; mhat=fadd_s(mhat,dl); \
      _Pragma("unroll") for(int r=0;r<16;++r){P0[r]=fsub_s(P0[r],dl);P1[r]=fsub_s(P1[r],dl);} \
      _Pragma("unroll") for(int r=0;r<16;++r)negm[r]=-mhat; asm volatile("":"+v"(negm)); } } \
    _Pragma("unroll") for(int r=0;r<16;++r)P0[r]=__builtin_amdgcn_exp2f(P0[r]); }while(0)
  #define RESC() do{ if(resc){ asm volatile("s_waitcnt lgkmcnt(0)":::"memory"); \
      _Pragma("unroll") for(int d_=0;d_<2;++d_) _Pragma("unroll") for(int r=0;r<16;++r)o[d_][r]*=wsf[crow(r,hi)]; } }while(0)
  f32x16 pA0,pA1,pB0,pB1;
  int sl_prev=0,sl_cur=0,sl_next=SLOTB;
  #define ROT() do{sl_prev=sl_cur;sl_cur=sl_next;sl_next=(sl_next==(NSLOT-1)*SLOTB)?0:sl_next+SLOTB;}while(0)
  if(!prestaged){DMA_K(2,2*SLOTB);
  WAIT_BAR(3);}else if(pre==1){WAIT_BAR(1);}else{WAIT_BAR(0);}
  qkt(pA0,pA1,shm3+LDS_K,qr,negm,r32,hi);asm volatile("s_nop 15\n\ts_nop 7":"+v"(pA0),"+v"(pA1));CMASK(pA0,pA1,0);
  START(pA0,pA1);
  _Pragma("unroll") for(int r=0;r<16;++r)pA1[r]=__builtin_amdgcn_exp2f(pA1[r]);
  WAIT_BAR(0);
  DMA_K(3,0);DMA_V(1,SLOTB);
  ROT();
  kload8(kf,kp0+sl_cur);
  WAIT_BAR(2);
  s16x4 vlo[8],vhi[8]; u32x4 pw0,pw1,pw2,pw3;
  #define PKW(P,B) cvtpk_s(P[B],P[B+1])
  #define PAF(k) __builtin_bit_cast(bf16x8,pw##k)
  #define VFR(i) (bf16x8){vlo[i][0],vlo[i][1],vlo[i][2],vlo[i][3],vhi[i][0],vhi[i][1],vhi[i][2],vhi[i][3]}
  #define PIN(x) asm volatile("":"+v"(x))
  #define MX3(a,b,c) __builtin_fmaxf(__builtin_fmaxf((a),(b)),(c))
  #define GAPA(MF,A0,A1,A2,A3,W0,W1,PW) do{ MF; sacc+=A0; sacc+=A1; sacc+=A2; sacc+=A3; PIN(sacc); W0; W1; PIN(PW); SBAR(); }while(0)
  #define EX(v) __builtin_amdgcn_exp2f(v)
  #define GAPB(MF,X,B) do{ MF; X[B]=EX(X[B]); X[B+1]=EX(X[B+1]); X[B+2]=EX(X[B+2]); X[B+3]=EX(X[B+3]); PIN(X); SBAR(); }while(0)
  #define VRD(i) do{ vlo[i]=vtr(vp_+(((i)>>2)*4096+((i)&3)*1024)); vhi[i]=vtr(vp_+(((i)>>2)*4096+((i)&3)*1024+512)); }while(0)
  #define KRD(G,j) do{ if(G){ kload2(kf,kp0+sl_next,j); SBAR(); } }while(0)
  #define STEP(C0,C1,P0,P1,t,GK,GV,GL) do{ SBAR(); \
    const lds_cptr vp_=vp0+sl_prev; \
    VRD(0); SBAR(); float sacc=(P0[0]+P0[1]); \
    GAPA(C0=__builtin_amdgcn_mfma_f32_32x32x16_bf16(kf[0],qr[0],negm,0,0,0), P0[2],P0[3],P0[4],P0[5],     pw0[0]=PKW(P0,0), pw0[1]=PKW(P0,2), pw0); \
    VRD(4); SBAR(); GAPA(C1=__builtin_amdgcn_mfma_f32_32x32x16_bf16(kf[1],qr[0],negm,0,0,0), P0[6],P0[7],P0[8],P0[9],     pw0[2]=PKW(P0,4), pw0[3]=PKW(P0,6), pw0); \
    VRD(1); SBAR(); GAPA(C0=__builtin_amdgcn_mfma_f32_32x32x16_bf16(kf[2],qr[1],C0,0,0,0),   P0[10],P0[11],P0[12],P0[13], pw1[0]=PKW(P0,8), pw1[1]=PKW(P0,10), pw1); \
    VRD(5); SBAR(); GAPA(C1=__builtin_amdgcn_mfma_f32_32x32x16_bf16(kf[3],qr[1],C1,0,0,0),   P0[14],P0[15],P1[0],P1[1],   pw1[2]=PKW(P0,12),pw1[3]=PKW(P0,14), pw1); \
    VRD(2); SBAR(); GAPA(C0=__builtin_amdgcn_mfma_f32_32x32x16_bf16(kf[4],qr[2],C0,0,0,0),   P1[2],P1[3],P1[4],P1[5],     pw2[0]=PKW(P1,0), pw2[1]=PKW(P1,2), pw2); \
    VRD(6); SBAR(); GAPA(C1=__builtin_amdgcn_mfma_f32_32x32x16_bf16(kf[5],qr[2],C1,0,0,0),   P1[6],P1[7],P1[8],P1[9],     pw2[2]=PKW(P1,4), pw2[3]=PKW(P1,6), pw2); \
    VRD(3); SBAR(); GAPA(C0=__builtin_amdgcn_mfma_f32_32x32x16_bf16(kf[6],qr[3],C0,0,0,0),   P1[10],P1[11],P1[12],P1[13], pw3[0]=PKW(P1,8), pw3[1]=PKW(P1,10), pw3); \
    VRD(7); SBAR(); GAPA(C1=__builtin_amdgcn_mfma_f32_32x32x16_bf16(kf[7],qr[3],C1,0,0,0),   P1[14],P1[15],0.f,0.f,       pw3[2]=PKW(P1,12),pw3[3]=PKW(P1,14), pw3); \
    l_reg+=sacc; \
    if(GK){DMA_K((t)+3,sl_cur);} if(GV){DMA_V((t)+1,sl_next);} \
    CMASK(C0,C1,t); \
    resc=false; \
    if constexpr(!FIXREF) { float a=MX3(C0[0],C0[1],C1[0]),b=MX3(C0[2],C0[3],C1[1]); a=MX3(a,C1[2],C1[3]); \
      _Pragma("unroll") for(int r=4;r<16;r+=4){a=MX3(a,C0[r],C0[r+1]);b=MX3(b,C0[r+2],C0[r+3]);a=MX3(a,C1[r],C1[r+1]);b=MX3(b,C1[r+2],C1[r+3]);} \
      float rm=__builtin_fmaxf(a,b); { auto rr=__builtin_amdgcn_permlane32_swap(__float_as_uint(rm),__float_as_uint(rm),false,false); rm=__builtin_fmaxf(__uint_as_float(rr[0]),__uint_as_float(rr[1])); } \
      resc=false; \
      if(__builtin_expect(__any(rm>(float)THRL),0)){ const float dl=__builtin_fmaxf(rm,0.f); mhat+=dl; \
        _Pragma("unroll") for(int r=0;r<16;++r){C0[r]-=dl;C1[r]-=dl;} \
        _Pragma("unroll") for(int r=0;r<16;++r)negm[r]=-mhat; asm volatile("":"+v"(negm)); \
        const float f=__builtin_amdgcn_exp2f(-dl); l_reg*=f; if(hi==0)wsf[r32]=f; resc=true; } } \
    SBAR(); \
    GAPB(o[0]=__builtin_amdgcn_mfma_f32_32x32x16_bf16(PAF(0),VFR(0),o[0],0,0,0), C0,0); \
    GAPB(o[1]=__builtin_amdgcn_mfma_f32_32x32x16_bf16(PAF(0),VFR(4),o[1],0,0,0), C0,4); \
    KRD(GL,0); GAPB(o[0]=__builtin_amdgcn_mfma_f32_32x32x16_bf16(PAF(1),VFR(1),o[0],0,0,0), C0,8); \
    KRD(GL,1); GAPB(o[1]=__builtin_amdgcn_mfma_f32_32x32x16_bf16(PAF(1),VFR(5),o[1],0,0,0), C0,12); \
    KRD(GL,2); GAPB(o[0]=__builtin_amdgcn_mfma_f32_32x32x16_bf16(PAF(2),VFR(2),o[0],0,0,0), C1,0); \
    KRD(GL,3); GAPB(o[1]=__builtin_amdgcn_mfma_f32_32x32x16_bf16(PAF(2),VFR(6),o[1],0,0,0), C1,4); \
    GAPB(o[0]=__builtin_amdgcn_mfma_f32_32x32x16_bf16(PAF(3),VFR(3),o[0],0,0,0), C1,8); \
    GAPB(o[1]=__builtin_amdgcn_mfma_f32_32x32x16_bf16(PAF(3),VFR(7),o[1],0,0,0), C1,12); \
    }while(0)
  int t=1;
  for(;t+5<NT;t+=2){
    STEP(pB0,pB1,pA0,pA1,t,true,true,true);     WAIT_BAR(2); RESC(); ROT();
    STEP(pA0,pA1,pB0,pB1,t+1,true,true,true);   WAIT_BAR(2); RESC(); ROT();
  }
  #define ENDW(tt) do{ if((tt)+3<NT){WAIT_BAR(2);} else if((tt)+2<NT){WAIT_BAR(1);} else {WAIT_BAR(0);} }while(0)
  for(;t+1<NT;t+=2){
    STEP(pB0,pB1,pA0,pA1,t,(t+3<NT),(t+1<NT),(t+1<NT));       ENDW(t);   RESC(); ROT();
    STEP(pA0,pA1,pB0,pB1,t+1,(t+4<NT),(t+2<NT),(t+2<NT));     ENDW(t+1); RESC(); ROT();
  }
  STEP(pB0,pB1,pA0,pA1,NT-1,false,false,false); RESC();
  if(Qn!=nullptr){ DMA_K(0,0);DMA_K(1,SLOTB);DMA_K(2,2*SLOTB);
    qn0=*reinterpret_cast<const bf16x8*>(&Qn[(long)r32*KP+hi*8]);qn1=*reinterpret_cast<const bf16x8*>(&Qn[(long)r32*KP+16+hi*8]);
    qn2=*reinterpret_cast<const bf16x8*>(&Qn[(long)r32*KP+32+hi*8]);qn3=*reinterpret_cast<const bf16x8*>(&Qn[(long)r32*KP+48+hi*8]); }
  { float sacc=pB0[0]+pB0[1]; _Pragma("unroll") for(int r=2;r<16;++r)sacc+=pB0[r]; _Pragma("unroll") for(int r=0;r<16;++r)sacc+=pB1[r]; l_reg+=sacc;
    pw0=(u32x4){PKW(pB0,0),PKW(pB0,2),PKW(pB0,4),PKW(pB0,6)};pw1=(u32x4){PKW(pB0,8),PKW(pB0,10),PKW(pB0,12),PKW(pB0,14)};pw2=(u32x4){PKW(pB1,0),PKW(pB1,2),PKW(pB1,4),PKW(pB1,6)};pw3=(u32x4){PKW(pB1,8),PKW(pB1,10),PKW(pB1,12),PKW(pB1,14)};
    SBAR(); pv(o,vb0+sl_cur,PAF(0),PAF(1),PAF(2),PAF(3)); }
  #undef PKW
  #undef PAF
  #undef VFR
  #undef PIN
  #undef MX3
  #undef GAPA
  #undef GAPB
  #undef EX
  #undef VRD
  #undef KRD
  #undef STEP
  #undef ENDW
  {auto rr=__builtin_amdgcn_permlane32_swap(__float_as_uint(l_reg),__float_as_uint(l_reg),false,false);l_reg=__uint_as_float(rr[0])+__uint_as_float(rr[1]);}
  if(hi==0)wsf[32+r32]=l_reg;asm volatile("s_waitcnt lgkmcnt(0)":::"memory");
  float rli[16];
  #pragma unroll
  for(int r=0;r<16;++r)rli[r]=__builtin_amdgcn_rcpf(wsf[32+crow(r,hi)]);
  { __attribute__((address_space(3))) unsigned short*stg=(__attribute__((address_space(3))) unsigned short*)(shm+LDS_OST)+wid*2048;
    #pragma unroll
    for(int r=0;r<16;++r){const int orow=crow(r,hi);
      #pragma unroll
      for(int d0=0;d0<2;++d0){const float v_=o[d0][r]*rli[r]; stg[orow*64+d0*32+r32]=(unsigned short)(cvtpk_s(v_,v_)&0xffffu);}}
    asm volatile("s_waitcnt lgkmcnt(0)":::"memory");
    #pragma unroll
    for(int i=0;i<4;++i){const int row=i*8+(lane>>3),ch=lane&7; const u32x4 v=*(const __attribute__((address_space(3))) u32x4*)(stg+row*64+ch*8); ATTN_STORE16(Ow+(long)row*OPITCH+ch*8,v);} }
  asm volatile("s_waitcnt lgkmcnt(0)\n\ts_barrier":::"memory");
  #undef DMA_K
  #undef DMA_V
  #undef CMASK
  #undef START
  #undef RESC
  #undef ROT
}
constexpr int ATTN_LDS_BYTES=LDS_BYTES;
#undef SBAR
#undef WAIT_BAR
}

#define XB_TMO      128
#define XB_XCNT(j)  (256  + 64 * (j))
#define XB_XSUB(j)  (1280 + 64 * (j))
#define XB_XGEN(j)  (2304 + 64 * (j))
#define XB_TOP      3328
#define XB_TOPGEN   3392
#define XCD_BAR_WORDS 3456
#define XB_SPIN_CAP (1u << 22)
__device__ __forceinline__ unsigned xb_ld(unsigned* p)              { return __hip_atomic_load(p, __ATOMIC_RELAXED, __HIP_MEMORY_SCOPE_AGENT); }
__device__ __forceinline__ unsigned xb_add(unsigned* p, unsigned v) { return __hip_atomic_fetch_add(p, v, __ATOMIC_RELAXED, __HIP_MEMORY_SCOPE_AGENT); }
__device__ __forceinline__ unsigned xb_xcc_id() { return (unsigned)__builtin_amdgcn_s_getreg((3 << 11) | 20) & 0xFu; }
#define XB_SPIN(cond, bar) do { unsigned _sp = 0; while (cond) { __builtin_amdgcn_s_sleep(1); \
    if ((++_sp & 255u) == 0u) { if (xb_ld(&(bar)[XB_TMO])) break; if (_sp > XB_SPIN_CAP) { atomicAdd(&(bar)[XB_TMO], 1u); break; } } } } while (0)
struct XcdBarrier { unsigned* bar; unsigned x; volatile LAS unsigned* st; };
__device__ __forceinline__ XcdBarrier xcd_barrier_post(unsigned* bar, volatile LAS unsigned* st) {
    XcdBarrier b; b.bar = bar; b.x = xb_xcc_id(); b.st = st;
    if (threadIdx.x == 0) (void)xb_add(&bar[XB_XCNT(b.x)], 1u);
    return b;
}
__device__ __forceinline__ void xcd_barrier_complete(unsigned* bar, unsigned x, unsigned& nloc, unsigned& nx) {
    const unsigned G = gridDim.x * gridDim.y * gridDim.z;
    unsigned sum, cnt, mine, sp = 0u;
    for (;;) {
        sum = 0u; cnt = 0u; mine = 0u;
#pragma unroll
        for (unsigned j = 0; j < 16; ++j) { const unsigned c = xb_ld(&bar[XB_XCNT(j)]); sum += c; cnt += (c > 0u) ? 1u : 0u; mine = (j == x) ? c : mine; }
        if (sum == G) break;
        __builtin_amdgcn_s_sleep(1);
        if ((++sp & 255u) == 0u) { if (xb_ld(&bar[XB_TMO])) break; if (sp > XB_SPIN_CAP) { atomicAdd(&bar[XB_TMO], 1u); break; } }
    }
    nloc = mine > 0u ? mine : 1u; nx = cnt > 0u ? cnt : 1u;
}
__device__ __forceinline__ void xcd_barrier(const XcdBarrier& b) {
    asm volatile("s_waitcnt vmcnt(0)" ::: "memory");
    __syncthreads();
    if (threadIdx.x == 0) {
        unsigned* bar = b.bar;
        __builtin_amdgcn_s_waitcnt(0);
        unsigned nloc = b.st[0], nx = b.st[1];
        if (nloc == 0u) { xcd_barrier_complete(bar, b.x, nloc, nx); b.st[0] = nloc; b.st[1] = nx; }
        asm volatile("buffer_inv sc1" ::: "memory");
        const unsigned old = xb_add(&bar[XB_XSUB(b.x)], 1u);
        const unsigned gen = old / nloc;
        if (old + 1u == (gen + 1u) * nloc) {
            __builtin_amdgcn_fence(__ATOMIC_RELEASE, "agent");
            asm volatile("s_waitcnt vmcnt(0)" ::: "memory");
            const unsigned og = xb_add(&bar[XB_TOP], 1u);
            const unsigned tg = og / nx;
            if (og + 1u == (tg + 1u) * nx) xb_add(&bar[XB_TOPGEN], 1u);
            else XB_SPIN(xb_ld(&bar[XB_TOPGEN]) == tg, bar);
            asm volatile("" ::: "memory");
            xb_add(&bar[XB_XGEN(b.x)], 1u);
            asm volatile("s_waitcnt vmcnt(0)" ::: "memory");
        } else {
            XB_SPIN(xb_ld(&bar[XB_XGEN(b.x)]) == gen, bar);
            asm volatile("s_waitcnt vmcnt(0)" ::: "memory");
        }
    }
    __syncthreads();
}

__device__ __forceinline__ unsigned f2bf(float f) { unsigned u = __builtin_bit_cast(unsigned, f); return (u + 0x7fffu + ((u >> 16) & 1u)) >> 16; }
__device__ __forceinline__ unsigned pk2(float lo, float hi) { return f2bf(lo) | (f2bf(hi) << 16); }
__device__ __forceinline__ int perm32_inv(int s) { return 16 * ((s >> 2) & 1) + 4 * (s >> 3) + (s & 3); }
__device__ __forceinline__ int rowmap(int kind, int c) {
    if (kind == 0) {
        const int pn = c >> 8, wc = (c >> 6) & 3, bj = (c >> 5) & 1, low = c & 31;
        if (c < NQKV) return 256 * pn + 128 * bj + 32 * wc + low;
        return 256 * pn + 128 * bj + 32 * wc + perm32_inv(low);
    }
    if (kind == 1) { const int pn = c >> 8, wc = (c >> 6) & 3, bj = (c >> 5) & 1, low = c & 31; return 256 * pn + 128 * bj + 32 * wc + perm32_inv(low); }
    if (kind == 3) { const int half = c >= DFF ? 1 : 0, cc = c - DFF * half, pn = cc >> 7, q = cc & 127; return 256 * pn + 128 * half + (q & ~31) + perm32_inv(q & 31); }
    if (kind == 4) { const int pn = c >> 8, wc = (c >> 6) & 3, bj = (c >> 5) & 1, low = c & 31; return 256 * pn + 128 * bj + 32 * wc + low; }
    return c;
}
__device__ __forceinline__ void p0_transpose_item(const float* W, int N, const float* scale, bf16_t* WT, int ldk, int koff, int kind, LAS float* scr, int item, int lane) {
    const int nblk = N / 32, kb = item / nblk, nb = item % nblk, k0 = 64 * kb, n0 = 32 * nb;
    float wv[32];
#pragma unroll
    for (int i = 0; i < 32; ++i) wv[i] = __builtin_nontemporal_load(&W[(size_t)(k0 + 2 * i + (lane >> 5)) * N + n0 + (lane & 31)]);
    if (scale) {
#pragma unroll
        for (int i = 0; i < 32; ++i) wv[i] *= scale[k0 + 2 * i + (lane >> 5)];
    }
#pragma unroll
    for (int i = 0; i < 32; ++i) scr[(2 * i + (lane >> 5)) * 33 + (lane & 31)] = wv[i];
    asm volatile("s_waitcnt lgkmcnt(0)" ::: "memory");
    const int c = lane & 7;
#pragma unroll
    for (int j = 0; j < 4; ++j) { const int n = (lane >> 3) + 8 * j; const LAS float* s = scr + (8 * c) * 33 + n;
        u32x4 o; o.x = pk2(s[0 * 33], s[1 * 33]); o.y = pk2(s[2 * 33], s[3 * 33]); o.z = pk2(s[4 * 33], s[5 * 33]); o.w = pk2(s[6 * 33], s[7 * 33]);
        *(u32x4*)(WT + (size_t)rowmap(kind, n0 + n) * ldk + koff + k0 + 8 * c) = o; }
    asm volatile("s_waitcnt lgkmcnt(0)" ::: "memory");
}

struct Args { const float* in[13]; float* out; unsigned char* ws; int ph_lo, ph_hi, li, pad; };
constexpr int NPHASE = 1 + 8 * DEPTH;

__device__ __forceinline__ void convert_weights(const Args& args, int l, LAS unsigned char* lds, int gw, int NGW, int wave, int lane) {
    unsigned char* ws = args.ws;
    LAS float* scr = (LAS float*)(lds + wave * 16384);
    const float* w_in = args.in[3] + (size_t)l * DM * INW; const float* n1 = args.in[2] + l * DM;
    const float* pa = args.in[6] + (size_t)l * 256 * DM; const float* pb = args.in[7] + (size_t)l * 512 * DM; const float* pc = args.in[8] + (size_t)l * 512 * DM;
    const float* w_o = args.in[9] + (size_t)l * DM * DM; const float* n2 = args.in[10] + l * DM;
    const float* w_up = args.in[11] + (size_t)l * DM * 2 * DFF; const float* w_dn = args.in[12] + (size_t)l * DFF * DM;
    constexpr int I_IN = (DM / 64) * (INW / 32), I_PA = (256 / 64) * (DM / 32), I_PB = (512 / 64) * (DM / 32), I_O = (DM / 64) * (DM / 32), I_UP = (DM / 64) * (2 * DFF / 32), I_DN = (DFF / 64) * (DM / 32);
    constexpr int NITEMS = I_IN + I_PA + 2 * I_PB + I_O + I_UP + I_DN;
    for (int it = gw; it < NITEMS; it += NGW) {
        int r = it;
        if (r < I_IN) { p0_transpose_item(w_in, INW, n1, (bf16_t*)(ws + WS_WIN), DM, 0, 0, scr, r, lane); continue; } r -= I_IN;
        if (r < I_PA) { p0_transpose_item(pa, DM, nullptr, (bf16_t*)(ws + WS_PCAT), OP, 0, 1, scr, r, lane); continue; } r -= I_PA;
        if (r < I_PB) { p0_transpose_item(pb, DM, nullptr, (bf16_t*)(ws + WS_PCAT), OP, 256, 1, scr, r, lane); continue; } r -= I_PB;
        if (r < I_PB) { p0_transpose_item(pc, DM, nullptr, (bf16_t*)(ws + WS_PCAT), OP, 768, 1, scr, r, lane); continue; } r -= I_PB;
        if (r < I_O) { p0_transpose_item(w_o, DM, nullptr, (bf16_t*)(ws + WS_WO), DM, 0, 4, scr, r, lane); continue; } r -= I_O;
        if (r < I_UP) { p0_transpose_item(w_up, 2 * DFF, n2, (bf16_t*)(ws + WS_WUP), DM, 0, 3, scr, r, lane); continue; } r -= I_UP;
        p0_transpose_item(w_dn, DM, nullptr, (bf16_t*)(ws + WS_WDN), DFF, 0, 4, scr, r, lane);
    }
}

struct MergeA {
    const bf16_t* Z; bf16_t* OB; const float* LSE; int gw, NGW, lane;
    __device__ __forceinline__ void operator()() const {
#pragma unroll 1
        for (int t2 = 4 * gw; t2 < MTOK / 2; t2 += 4 * NGW) {
            u32x4 a[4], b[4], c[4]; float l0[4], l1[4], l2[4];
            const int q = lane & 31, h = q >> 3;
#pragma unroll
            for (int k = 0; k < 4; ++k) { const int tok = 2 * (t2 + k) + (lane >> 5);
                const float* ls = LSE + (size_t)tok * 12 + h; l0[k] = ls[0]; l1[k] = ls[4]; l2[k] = ls[8];
                const int dq = 8 * (q & 7);
                a[k] = __builtin_nontemporal_load((const u32x4*)(Z + zplane(h) + (size_t)tok * ZSL + dq));
                b[k] = __builtin_nontemporal_load((const u32x4*)(Z + zplane(4 + h) + (size_t)zperm(tok, 2) * ZSL + dq));
                c[k] = __builtin_nontemporal_load((const u32x4*)(Z + zplane(8 + h) + (size_t)zperm(tok, 4) * ZSL + dq)); }
#pragma unroll
            for (int k = 0; k < 4; ++k) { const int tok = 2 * (t2 + k) + (lane >> 5);
                const float mx = fmaxf(l0[k], fmaxf(l1[k], l2[k])); float w0 = fast_exp2((l0[k] - mx) * LOG2E), w1 = fast_exp2((l1[k] - mx) * LOG2E), w2 = fast_exp2((l2[k] - mx) * LOG2E);
                const float inv = fast_rcp(w0 + w1 + w2); w0 *= inv; w1 *= inv; w2 *= inv;
                u32x4 o;
                o.x = cvt_pk_bf16(w0 * bf_lo(a[k].x) + w1 * bf_lo(b[k].x) + w2 * bf_lo(c[k].x), w0 * bf_hi(a[k].x) + w1 * bf_hi(b[k].x) + w2 * bf_hi(c[k].x));
                o.y = cvt_pk_bf16(w0 * bf_lo(a[k].y) + w1 * bf_lo(b[k].y) + w2 * bf_lo(c[k].y), w0 * bf_hi(a[k].y) + w1 * bf_hi(b[k].y) + w2 * bf_hi(c[k].y));
                o.z = cvt_pk_bf16(w0 * bf_lo(a[k].z) + w1 * bf_lo(b[k].z) + w2 * bf_lo(c[k].z), w0 * bf_hi(a[k].z) + w1 * bf_hi(b[k].z) + w2 * bf_hi(c[k].z));
                o.w = cvt_pk_bf16(w0 * bf_lo(a[k].w) + w1 * bf_lo(b[k].w) + w2 * bf_lo(c[k].w), w0 * bf_hi(a[k].w) + w1 * bf_hi(b[k].w) + w2 * bf_hi(c[k].w));
                *(u32x4*)(OB + (size_t)tok * OP + 8 * q) = o; }
        }
    }
};
__device__ __forceinline__ float block_max8(float v, LAS float* scr, int tid) {
#pragma unroll
    for (int o = 1; o < 64; o <<= 1) v = fmaxf(v, shx(v, o));
    if ((tid & 63) == 0) scr[tid >> 6] = v;
    __syncthreads();
    float r = scr[0];
#pragma unroll
    for (int i = 1; i < 8; ++i) r = fmaxf(r, scr[i]);
    __syncthreads();
    return r;
}
#ifndef ATT_DO_A
#define ATT_DO_A 1
#endif
#ifndef ATT_DO_B
#define ATT_DO_B 1
#endif
#ifndef ATT_DO_C
#define ATT_DO_C 1
#endif
#ifndef TIME_G3
#define TIME_G3 1
#endif
#ifndef TIME_A
#define TIME_A 1
#endif
#ifndef TIME_G1A
#define TIME_G1A 1
#endif
#ifndef TIME_G1B
#define TIME_G1B 1
#endif
#ifndef TIME_G2
#define TIME_G2 1
#endif
#ifndef TIME_G4
#define TIME_G4 1
#endif
#ifndef TIME_C
#define TIME_C 1
#endif
#ifndef TIME_B
#define TIME_B 1
#endif
#ifndef PHMASK
#define PHMASK 0x1FF
#endif
#define PHON(j) (((PHMASK) >> (j)) & 1)
#define OPAQUE_S(x) asm volatile("" : "+s"(x))
#define OPAQUE_V(x) asm volatile("" : "+v"(x))
__global__ void __launch_bounds__(512, 2) fwd_megakernel(Args args) {
    extern __shared__ __attribute__((aligned(16))) unsigned char lds_raw[];
    LAS unsigned char* lds = (LAS unsigned char*)lds_raw;
    volatile LAS unsigned* MISC = (volatile LAS unsigned*)(lds + MISC_OFF);
    const int G = gridDim.x; const int bx = blockIdx.x;
    { const int tid0 = threadIdx.x; for (int u = tid0; u < (STG_OFF - LDSCTL_OFF) / 4; u += 512) ((LAS unsigned*)(lds + LDSCTL_OFF))[u] = 0u; }
    __syncthreads();
    const int lo = args.ph_lo, hi = args.ph_hi;
    const bool multi = (hi - lo) > 1;
    XcdBarrier bar; bar.bar = (unsigned*)(args.ws + WS_CTL) + CW_BAR + args.li * XCD_BAR_WORDS; bar.x = 0; bar.st = nullptr;
    if (multi) bar = xcd_barrier_post((unsigned*)(args.ws + WS_CTL) + CW_BAR + args.li * XCD_BAR_WORDS, MISC + 8);
#define IN(k) (lo <= (k) && (k) < hi)
#define SEAM(k) do { if (IN(k) && IN((k) + 1)) xcd_barrier(bar); } while (0)
#define PHASE_LOCALS() unsigned zoff_ = 0u; OPAQUE_S(zoff_); unsigned char* ws = args.ws + zoff_; int tid = threadIdx.x; OPAQUE_V(tid); const int lane = tid & 63, wave = __builtin_amdgcn_readfirstlane(tid >> 6); \
    const int vcu = (G % 8 == 0) ? (bx % 8) * (G / 8) + bx / 8 : bx; const int gw = vcu * 8 + wave, NGW = G * 8; (void)lane; (void)gw; (void)NGW; (void)vcu

    if (PHON(0) && IN(0)) {
        PHASE_LOCALS();
        convert_weights(args, 0, lds, gw, NGW, wave, lane);
        float* ssq = (float*)(ws + WS_SSQ); bf16_t* XB0 = (bf16_t*)(ws + WS_XB0); const float* xin0 = args.in[0];
#pragma unroll 1
        for (int m0 = 4 * gw; m0 < MTOK; m0 += 4 * NGW) {
            f32x4 v[4][4];
#pragma unroll
            for (int rr = 0; rr < 4; ++rr) { const f32x4* xr = (const f32x4*)(xin0 + (size_t)(m0 + rr) * DM) + lane;
#pragma unroll
                for (int j = 0; j < 4; ++j) v[rr][j] = __builtin_nontemporal_load(&xr[64 * j]); }
#pragma unroll
            for (int rr = 0; rr < 4; ++rr) { float s = 0.f;
#pragma unroll
                for (int j = 0; j < 4; ++j) s += (v[rr][j].x * v[rr][j].x + v[rr][j].y * v[rr][j].y) + (v[rr][j].z * v[rr][j].z + v[rr][j].w * v[rr][j].w);
#pragma unroll
                for (int o = 1; o < 64; o <<= 1) s += shx(s, o);
                u32x2* o8 = (u32x2*)(XB0 + (size_t)(m0 + rr) * DM) + lane;
#pragma unroll
                for (int j = 0; j < 4; ++j) { u32x2 w; w.x = cvt_pk_bf16(v[rr][j].x, v[rr][j].y); w.y = cvt_pk_bf16(v[rr][j].z, v[rr][j].w); o8[64 * j] = w; }
                if (lane < 16) ssq[(size_t)(m0 + rr) * 16 + lane] = (lane == 0) ? s : 0.f; }
        }
    }
    SEAM(0);

#pragma unroll 1
    for (int l = 0; l < DEPTH; ++l) {
        const int pb = 1 + 8 * l;
        if (PHON(0) && IN(pb)) { if (l > 0) { PHASE_LOCALS(); (void)ws; convert_weights(args, l, lds, gw, NGW, wave, lane); } }
        if (l > 0) SEAM(pb);
        if (PHON(1) && IN(pb + 1)) {
            PHASE_LOCALS();
            const pg8::Order<1> S = pg8::make_order<1>((l == 0) ? (const bf16_t*)(ws + WS_XB0) : (const bf16_t*)args.out, DM, (const bf16_t*)(ws + WS_WIN), DM, MTOK, NQKV, DM, G, bx);
            EpiQKV E{(bf16_t*)(ws + WS_BIG), (const float*)(ws + WS_SSQ), args.in[4] + l * 6 * 64};
            for (int rep = 0; rep < TIME_G1A; ++rep) {
                const int fullr = S.nwg / G, tailn = S.nwg - fullr * G;
                if (2 * tailn == G) { pg8::Order<1> S2 = S; S2.maxr = fullr;
                    pg8::Unit tu; S.tile_of(fullr * G + (bx % tailn), tu);
                    pg8::gemm_phase(lds, S2, DM, DM, E, S.A + (size_t)tu.pm * S.tstepA + (size_t)(bx / tailn) * 128 * DM * 2, S.Bt + (size_t)tu.pn * S.tstepB);
                    pg8::gemm_half_phase(lds, S, fullr * G + (bx % tailn), bx / tailn, DM, DM, E, true); }
                else pg8::gemm_phase(lds, S, DM, DM, E); }
        }
        SEAM(pb + 1);
        if (PHON(2) && IN(pb + 2)) {
            PHASE_LOCALS();
            bf16_t* Z = (bf16_t*)(ws + WS_BIG); bf16_t* OB = (bf16_t*)(ws + WS_OBUF); float* LSE = (float*)(ws + WS_LSE);
            LAS char* shm = (LAS char*)lds;
            float BrefC;
            LAS float* mxscr = (LAS float*)(shm + att::LDS_TAB + 4096);
#define MK_POLA(ii, PA) const int ida_##PA = vcu * 3 + ((ii) % 3); const int bgh_##PA = ida_##PA >> 5, sub_##PA = ida_##PA & 31; const int g_##PA = (bgh_##PA % 12) >> 2; \
            const int rate_##PA = g_##PA == 0 ? 1 : (g_##PA == 1 ? 4 : 16); const int rho_##PA = g_##PA == 0 ? 0 : (g_##PA == 1 ? (sub_##PA >> 3) : (sub_##PA >> 1)); const int u_##PA = g_##PA == 0 ? sub_##PA : (g_##PA == 1 ? (sub_##PA & 7) : (sub_##PA & 1)); \
            const att::PolA PA{Z, LSE, tab, bgh_##PA / 12, g_##PA, bgh_##PA & 3, rate_##PA, rho_##PA, u_##PA, (SEQ / rate_##PA) / 64, (ii) >= 3}
            LAS float* tab = (LAS float*)(shm + att::LDS_TAB);
            LAS float* tabB = (LAS float*)(shm + att::B2_TAB);
            const float* rpb = args.in[5] + (size_t)l * 8 * 15 * 31;
            const float* rbt = args.in[1];
            int tab_gh;
            bf16x8 qnC0, qnC1, qnC2, qnC3;
            { const int id0 = vcu * 2; const int bh0 = id0 >> 5; const int b0_ = bh0 >> 3, h0_ = bh0 & 7, qb0_ = id0 & 31;
              attp::attn_prestage<ZSL>((const attp::bf16*)(Z + zplane(60 + h0_) + (size_t)(b0_ * SEQ + qb0_ * 256 + wave * 32) * ZSL), (const attp::bf16*)(Z + zplane(68 + (h0_ >> 2)) + (size_t)(b0_ * SEQ) * ZSL),
                                       (const attp::bf16*)(Z + zplane(70 + (h0_ >> 2)) + (size_t)(b0_ * SEQ) * ZSL), shm, qnC0, qnC1, qnC2, qnC3); }
            { const float* gq = args.in[4] + l * 6 * 64;
              float v[6] = {0.f, 0.f, 0.f, 0.f, 0.f, 0.f};
              if (tid < 64) {
#pragma unroll
                  for (int t = 0; t < 6; ++t) v[t] = fabsf(gq[t * 64 + tid]); }
              const int hB = (vcu >> 4) & 7;
              float bmx = 0.f;
              for (int e = tid; e < 16 * 128; e += 512) { const int dr = e >> 7, dc = (e & 127) - 48; const float tv = dr == 15 ? NEGBIG : ((dc >= 0 && dc <= 30) ? rpb[hB * 465 + dr * 31 + dc] * LOG2E : 0.f); tabB[e] = tv; if (dr != 15) bmx = fmaxf(bmx, tv); }
              const float bv = (tid < 32 * 12) ? fabsf(rbt[tid]) * LOG2E : 0.f;
              float tabv = NEGBIG;
              { MK_POLA(0, Pz); tab_gh = Pz.g * 4 + Pz.h;
                if (tid < 255) { const int d = tid - 127; tabv = (d >= -64 && d <= 64) ? rbt[att::t5_bucket(d * Pz.rate) * 12 + Pz.g * 4 + Pz.h] * LOG2E : NEGBIG; } }
              if (tid < 64) {
#pragma unroll
                  for (int o = 1; o < 64; o <<= 1)
#pragma unroll
                      for (int t = 0; t < 6; ++t) v[t] = fmaxf(v[t], shx(v[t], o));
                  if (tid == 0) {
#pragma unroll
                      for (int t = 0; t < 6; ++t) mxscr[8 + t] = v[t]; } }
              const float bmxr = block_max8(bmx, mxscr, tid);
              const float bvr = block_max8(bv, mxscr, tid);
              BrefC = 64.0f * mxscr[12] * mxscr[13] * C2 * 1.02f;
              const float BrefA0 = 64.0f * mxscr[8] * mxscr[9] * C2 * 1.02f + bvr;
              if (tid < 255) tab[tid] = tabv - BrefA0;
              if (tid == 0) { mxscr[14] = 64.0f * mxscr[10] * mxscr[11] * C2 * 1.02f + bmxr;
                              mxscr[15] = BrefA0; }
              __syncthreads(); }
#pragma unroll 1
            for (int i = 0; i < 2 * TIME_C * ATT_DO_C; ++i) { const int id = vcu * 2 + (i & 1); const int bh = id >> 5; const int b = bh >> 3, h = bh & 7, qb = id & 31;
                const bf16_t* Qw = Z + zplane(60 + h) + (size_t)(b * SEQ + qb * 256 + wave * 32) * ZSL;
                const bf16_t* Kh = Z + zplane(68 + (h >> 2)) + (size_t)(b * SEQ) * ZSL; const bf16_t* Vh = Z + zplane(70 + (h >> 2)) + (size_t)(b * SEQ) * ZSL;
                bf16_t* Ow = OB + (size_t)(b * SEQ + qb * 256 + wave * 32) * OP + 768 + 64 * h;
                const bool nxt = ((i & 1) == 0) && (i + 1 < 2 * TIME_C * ATT_DO_C);
                attp::attn_unit<8, ZSL, OP, true>((const attp::bf16*)Qw, (const attp::bf16*)Kh, (const attp::bf16*)Vh, (attp::bf16*)Ow, SEQ / 64, BrefC, shm,
                                                  (i & 1) == 1 ? 1 : ((i == 0 && ATT_PRE0) ? 2 : 0), nxt ? (const attp::bf16*)(Qw + (size_t)256 * ZSL) : (const attp::bf16*)nullptr, qnC0, qnC1, qnC2, qnC3); }
            for (int rep = 0; rep < TIME_B * ATT_DO_B; ++rep) { const int idb = vcu;
                const float BrefBu = mxscr[14];
                att::unit_b8(Z, OB, tabB, (idb >> 7) & 1, (idb >> 4) & 7, 8 * (idb & 15), BrefBu, shm); }
            const float BrefA = mxscr[15];
            bf16x8 qnA0 = {}, qnA1 = {}, qnA2 = {}, qnA3 = {};
#pragma unroll 1
            for (int i = 3 * (TIME_A - 1); i >= 0 && i < 3 * TIME_A * ATT_DO_A; i = (i == 5 ? 0 : (i == 2 ? 99 : i + 1))) { MK_POLA(i, Pc); MK_POLA((i % 3) + 1 < 3 ? i + 1 : i, Pn);
                if (Pc.g * 4 + Pc.h != tab_gh) { tab_gh = Pc.g * 4 + Pc.h;
                    if (tid < 255) { const int d = tid - 127; tab[tid] = ((d >= -64 && d <= 64) ? rbt[att::t5_bucket(d * Pc.rate) * 12 + Pc.g * 4 + Pc.h] * LOG2E : NEGBIG) - BrefA; } }
                att::unit_simple<att::PolA>(Pc, (i % 3) > 0, Pn, (i % 3) + 1 < 3, BrefA, shm, qnA0, qnA1, qnA2, qnA3); }
#undef MK_POLA
        }
        SEAM(pb + 2);
        if (PHON(3) && IN(pb + 3)) {
            PHASE_LOCALS();
            const MergeA mrg{(const bf16_t*)(ws + WS_BIG), (bf16_t*)(ws + WS_OBUF), (const float*)(ws + WS_LSE), gw, NGW, lane};
            const pg8::Order<1> S = pg8::make_order<1>((l == 0) ? (const bf16_t*)(ws + WS_XB0) : (const bf16_t*)args.out, DM, (const bf16_t*)(ws + WS_WIN) + (size_t)NQKV * DM, DM, MTOK, NGATE, DM, G, bx);
            EpiGate E{(bf16_t*)(ws + WS_BIG) + ZGOFF, (const float*)(ws + WS_SSQ)};
            for (int rep = 0; rep < TIME_G1B; ++rep) pg8::gemm_phase(lds, S, DM, DM, E, nullptr, nullptr, mrg);
        }
        SEAM(pb + 3);
        if (PHON(4) && IN(pb + 4)) {
            PHASE_LOCALS();
            const pg8::Order<3> S = pg8::make_order<3>((const bf16_t*)(ws + WS_OBUF), OP, (const bf16_t*)(ws + WS_PCAT), OP, MTOK, DM, 256, G, bx);
            EpiBranch E{(const bf16_t*)(ws + WS_BIG) + ZGOFF, (bf16_t*)(ws + WS_XB0)};
            for (int rep = 0; rep < TIME_G2; ++rep) pg8::gemm_phase(lds, S, OP, OP, E);
        }
        SEAM(pb + 4);
        if (PHON(5) && IN(pb + 5)) {
            PHASE_LOCALS();
            const pg8::Order<1> S = pg8::make_order<1>((const bf16_t*)(ws + WS_XB0), DM, (const bf16_t*)(ws + WS_WO), DM, MTOK, DM, DM, G, bx);
            if (l == 0) { EpiRes<true, false> E{(const void*)args.in[0], nullptr, (bf16_t*)(ws + WS_OBUF), (float*)(ws + WS_SSQ)}; pg8::gemm_phase(lds, S, DM, DM, E); }
            else { EpiRes<false, false> E{(const void*)args.out, nullptr, (bf16_t*)(ws + WS_OBUF), (float*)(ws + WS_SSQ)}; pg8::gemm_phase(lds, S, DM, DM, E); }
        }
        SEAM(pb + 5);
        if (PHON(6) && IN(pb + 6)) {
            PHASE_LOCALS();
            const pg8::Order<1> S = pg8::make_order<1>((const bf16_t*)(ws + WS_OBUF), DM, (const bf16_t*)(ws + WS_WUP), DM, MTOK, 2 * DFF, DM, G, bx);
            EpiSwiglu E{(bf16_t*)(ws + WS_BIG), (const float*)(ws + WS_SSQ)};
            for (int rep = 0; rep < TIME_G4; ++rep) {
                const int fullr = S.nwg / G, tailn = S.nwg - fullr * G;
                if (2 * tailn == G) { pg8::Order<1> S2 = S; S2.maxr = fullr;
                    pg8::Unit tu; S.tile_of(fullr * G + (bx % tailn), tu);
                    pg8::gemm_phase(lds, S2, DM, DM, E, S.A + (size_t)tu.pm * S.tstepA + (size_t)(bx / tailn) * 128 * DM * 2, S.Bt + (size_t)tu.pn * S.tstepB);
                    pg8::gemm_half_phase(lds, S, fullr * G + (bx % tailn), bx / tailn, DM, DM, E, true); }
                else pg8::gemm_phase(lds, S, DM, DM, E); }
        }
        SEAM(pb + 6);
        if (PHON(7) && IN(pb + 7)) {
            PHASE_LOCALS();
            const pg8::Order<1> S = pg8::make_order<1>((const bf16_t*)(ws + WS_BIG), DFF, (const bf16_t*)(ws + WS_WDN), DFF, MTOK, DM, DFF, G, bx);
            if (l + 1 < DEPTH) { EpiRes<false, false> E{(const void*)(ws + WS_OBUF), nullptr, (bf16_t*)args.out, (float*)(ws + WS_SSQ)}; pg8::gemm_phase(lds, S, DFF, DFF, E); }
            else { EpiRes<false, true> E{(const void*)(ws + WS_OBUF), args.out, nullptr, (float*)(ws + WS_SSQ)}; pg8::gemm_phase(lds, S, DFF, DFF, E); }
        }
        SEAM(pb + 7);
    }
#undef IN
#undef SEAM
}

#ifndef MK_PER_PHASE
#define MK_PER_PHASE 0
#endif
extern "C" void kernel_launch(void* const* d_in, const int* in_sizes, int n_in, void* d_out, int out_size, void* d_ws, size_t ws_size, hipStream_t stream) {
    static int grid = 0;
    if (grid == 0) {
        if (n_in != 13 || out_size != MTOK * DM || ws_size < WS_END) { fprintf(stderr, "kernel_launch: unexpected shapes (n_in %d, out %d, ws %zu)\n", n_in, out_size, ws_size); grid = -1; return; }
        int dev = 0, cus = 0, per_cu = 0;
        if (hipGetDevice(&dev) != hipSuccess || hipDeviceGetAttribute(&cus, hipDeviceAttributeMultiprocessorCount, dev) != hipSuccess) { grid = -1; return; }
        if (hipFuncSetAttribute((const void*)fwd_megakernel, hipFuncAttributeMaxDynamicSharedMemorySize, LDS_BYTES) != hipSuccess) { fprintf(stderr, "kernel_launch: hipFuncSetAttribute failed\n"); grid = -1; return; }
        if (hipOccupancyMaxActiveBlocksPerMultiprocessor(&per_cu, (const void*)fwd_megakernel, 512, LDS_BYTES) != hipSuccess || per_cu < 1) { fprintf(stderr, "kernel_launch: occupancy query says %d blocks per CU\n", per_cu); grid = -1; (void)hipGetLastError(); return; }
        (void)hipGetLastError();
        grid = cus;
        if (grid != 256) fprintf(stderr, "kernel_launch: %d CUs (built for 256)\n", grid);
    }
    if (grid < 0) return;
    if (hipMemsetAsync((char*)d_ws + WS_CTL, 0, CTL_ZERO_BYTES, stream) != hipSuccess) return;
    Args a{};
    for (int i = 0; i < 13; ++i) a.in[i] = (const float*)d_in[i];
    a.out = (float*)d_out; a.ws = (unsigned char*)d_ws;
#if MK_PER_PHASE
    for (int p = 0; p < NPHASE; ++p) { a.ph_lo = p; a.ph_hi = p + 1; a.li = 0; hipLaunchKernelGGL(fwd_megakernel, dim3(grid), dim3(512), LDS_BYTES, stream, a); }
#else
    a.ph_lo = 0; a.ph_hi = NPHASE; a.li = 0;
    hipLaunchKernelGGL(fwd_megakernel, dim3(grid), dim3(512), LDS_BYTES, stream, a);
#endif
}
```
